# Optimizing an MI355X kernel written in HIP

```python
import math
import jax, jax.numpy as jnp
from jax import lax
import numpy as np

D_MODEL = 2048
BATCH = 1
SEQ = 8192
DEPTH = 4

N_A_LAYERS = DEPTH // 2
N_B_LAYERS = DEPTH - N_A_LAYERS

N_HEADS_A = 16
HEAD_DIM_A = D_MODEL // N_HEADS_A
MOBA_BLOCK = 256
MOBA_TOPK = 3
MOBA_QCHUNK = 64

N_HEADS_B = 16
Q_LORA = 768
KV_LORA = 512
QK_NOPE = 128
QK_ROPE = 64
V_DIM = 128
ROPE_THETA = 10000.0
MLA_QCHUNK = 128

D_FF = 5632
EPS = 1e-6

kernel_name = "yoco_moba_mla_macaron_alibi"


def rmsnorm(x, g):
    xf = x.astype(jnp.float32)
    y = xf * lax.rsqrt(jnp.mean(xf * xf, axis=-1, keepdims=True) + EPS)
    return (y * g.astype(jnp.float32)).astype(x.dtype)


def swiglu(xn, w_gu, w_d):
    gate, up = jnp.split(xn @ w_gu, 2, axis=-1)
    return (jax.nn.silu(gate) * up) @ w_d


def alibi_slopes(n):
    return jnp.asarray(np.array([2.0 ** (-8.0 * (i + 1) / n) for i in range(n)], dtype=np.float32))


def rope_tables(s):
    inv = 1.0 / (ROPE_THETA ** (jnp.arange(0, QK_ROPE, 2, dtype=jnp.float32) / QK_ROPE))
    ang = jnp.arange(s, dtype=jnp.float32)[:, None] * inv[None, :]
    return jnp.cos(ang), jnp.sin(ang)


def apply_rope(x, cos, sin):
    xf = x.astype(jnp.float32)
    x1, x2 = jnp.split(xf, 2, axis=-1)
    out = jnp.concatenate([x1 * cos - x2 * sin, x1 * sin + x2 * cos], axis=-1)
    return out.astype(x.dtype)


def moba_attention(xn, w_qkv, w_o, slopes):
    B, S, _ = xn.shape
    H, dh, BS, QC = N_HEADS_A, HEAD_DIM_A, MOBA_BLOCK, MOBA_QCHUNK
    nb = -(-S // BS)
    topk = min(MOBA_TOPK, nb)
    q, k, v = jnp.split(xn @ w_qkv, 3, axis=-1)

    def heads(t):
        return t.reshape(B, S, H, dh).transpose(0, 2, 1, 3)

    q, k, v = heads(q), heads(k), heads(v)
    pad = nb * BS - S
    k_p = jnp.pad(k, ((0, 0), (0, 0), (0, pad), (0, 0)))
    v_p = jnp.pad(v, ((0, 0), (0, 0), (0, pad), (0, 0)))
    kb = k_p.reshape(B, H, nb, BS, dh)
    vb = v_p.reshape(B, H, nb, BS, dh)
    k_mean = jnp.mean(kb.astype(jnp.float32), axis=3)
    n_chunks = S // QC
    q_chunks = q.reshape(B, H, n_chunks, QC, dh).transpose(2, 0, 1, 3, 4)
    m = slopes.reshape(1, H, 1, 1)
    scale = dh ** -0.5
    gather_blocks = jax.vmap(jax.vmap(lambda tab, idx: tab[idx]))
    blk_ids = jnp.arange(nb)

    def chunk(args):
        ci, qc = args
        t0 = ci * QC
        cur = t0 // BS
        t = t0 + jnp.arange(QC)
        gate = jnp.einsum('bhqd,bhnd->bhqn', qc.astype(jnp.float32), k_mean)
        gate = jnp.where(blk_ids < cur, gate, -jnp.inf)
        _, sel = lax.top_k(gate, topk)
        sel_ok = sel < cur
        k_sel = gather_blocks(kb, sel)
        v_sel = gather_blocks(vb, sel)
        s_sel = jnp.einsum('bhqd,bhqnkd->bhqnk', qc, k_sel).astype(jnp.float32) * scale
        key_pos = sel[..., None] * BS + jnp.arange(BS)
        dist = (t[:, None, None] - key_pos).astype(jnp.float32)
        s_sel = jnp.where(sel_ok[..., None], s_sel - m[..., None] * dist, -jnp.inf)
        s_sel = s_sel.reshape(B, H, QC, topk * BS)
        k_own = lax.dynamic_slice_in_dim(k_p, cur * BS, BS, axis=2)
        v_own = lax.dynamic_slice_in_dim(v_p, cur * BS, BS, axis=2)
        own_pos = cur * BS + jnp.arange(BS)
        dist_own = (t[:, None] - own_pos[None, :]).astype(jnp.float32)
        s_own = jnp.einsum('bhqd,bhkd->bhqk', qc, k_own).astype(jnp.float32) * scale - m * dist_own
        s_own = jnp.where(dist_own >= 0, s_own, -jnp.inf)
        p = jax.nn.softmax(jnp.concatenate([s_sel, s_own], axis=-1), axis=-1).astype(v.dtype)
        p_sel = p[..., :topk * BS].reshape(B, H, QC, topk, BS)
        p_own = p[..., topk * BS:]
        return (jnp.einsum('bhqnk,bhqnkd->bhqd', p_sel, v_sel)
                + jnp.einsum('bhqk,bhkd->bhqd', p_own, v_own))

    o = lax.map(chunk, (jnp.arange(n_chunks), q_chunks))
    o = o.transpose(1, 0, 3, 2, 4).reshape(B, S, H * dh)
    return o @ w_o


def mla_shared_kv(h, kv_norm, w_dkv, ckv_norm, w_ukv, cos, sin):
    B, S, _ = h.shape
    H = N_HEADS_B
    hn = rmsnorm(h, kv_norm)
    c_kv, k_rope = jnp.split(hn @ w_dkv, [KV_LORA], axis=-1)
    c_kv = rmsnorm(c_kv, ckv_norm)
    k_rope = apply_rope(k_rope, cos, sin)
    kv = (c_kv @ w_ukv).reshape(B, S, H, QK_NOPE + V_DIM)
    k_nope, v = jnp.split(kv, [QK_NOPE], axis=-1)
    k = jnp.concatenate([k_nope, jnp.broadcast_to(k_rope[:, :, None, :], (B, S, H, QK_ROPE))], axis=-1)
    return k.transpose(0, 2, 1, 3), v.transpose(0, 2, 1, 3)


def mla_attention(xn, w_dq, cq_norm, w_uq, w_o, k, v, cos, sin):
    B, S, _ = xn.shape
    H, QC = N_HEADS_B, MLA_QCHUNK
    cq = rmsnorm(xn @ w_dq, cq_norm)
    q = (cq @ w_uq).reshape(B, S, H, QK_NOPE + QK_ROPE)
    q_nope, q_rope = jnp.split(q, [QK_NOPE], axis=-1)
    q_rope = apply_rope(q_rope, cos[:, None, :], sin[:, None, :])
    q = jnp.concatenate([q_nope, q_rope], axis=-1).transpose(0, 2, 1, 3)
    n_chunks = S // QC
    q_chunks = q.reshape(B, H, n_chunks, QC, QK_NOPE + QK_ROPE).transpose(2, 0, 1, 3, 4)
    scale = (QK_NOPE + QK_ROPE) ** -0.5
    key_pos = jnp.arange(S)

    def chunk(args):
        ci, qc = args
        t = ci * QC + jnp.arange(QC)
        s = jnp.einsum('bhqd,bhkd->bhqk', qc, k).astype(jnp.float32) * scale
        s = jnp.where(key_pos[None, :] <= t[:, None], s, -jnp.inf)
        p = jax.nn.softmax(s, axis=-1).astype(v.dtype)
        return jnp.einsum('bhqk,bhkd->bhqd', p, v)

    o = lax.map(chunk, (jnp.arange(n_chunks), q_chunks))
    o = o.transpose(1, 0, 3, 2, 4).reshape(B, S, H * V_DIM)
    return o @ w_o


def setup_inputs(seed: int = 0) -> dict:
    key = jax.random.key(seed)
    ks = jax.random.split(key, 24)
    f32 = jnp.float32

    def w(k, shape, fan_in):
        return jax.random.normal(k, shape, f32) * (fan_in ** -0.5)

    def gain(k, shape):
        return 1.0 + 0.02 * jax.random.normal(k, shape, f32)

    D, F = D_MODEL, D_FF
    return {
        "x": jax.random.normal(ks[0], (BATCH, SEQ, D), f32),
        "ln_ffn1": gain(ks[1], (DEPTH, D)),
        "ffn1_wgu": w(ks[2], (DEPTH, D, 2 * F), D),
        "ffn1_wd": w(ks[3], (DEPTH, F, D), F),
        "ln_mix": gain(ks[4], (DEPTH, D)),
        "ln_ffn2": gain(ks[5], (DEPTH, D)),
        "ffn2_wgu": w(ks[6], (DEPTH, D, 2 * F), D),
        "ffn2_wd": w(ks[7], (DEPTH, F, D), F),
        "moba_wqkv": w(ks[8], (N_A_LAYERS, D, 3 * N_HEADS_A * HEAD_DIM_A), D),
        "moba_wo": w(ks[9], (N_A_LAYERS, N_HEADS_A * HEAD_DIM_A, D), N_HEADS_A * HEAD_DIM_A),
        "kv_norm": gain(ks[10], (D,)),
        "mla_wdkv": w(ks[11], (D, KV_LORA + QK_ROPE), D),
        "ckv_norm": gain(ks[12], (KV_LORA,)),
        "mla_wukv": w(ks[13], (KV_LORA, N_HEADS_B * (QK_NOPE + V_DIM)), KV_LORA),
        "mla_wdq": w(ks[14], (N_B_LAYERS, D, Q_LORA), D),
        "cq_norm": gain(ks[15], (N_B_LAYERS, Q_LORA)),
        "mla_wuq": w(ks[16], (N_B_LAYERS, Q_LORA, N_HEADS_B * (QK_NOPE + QK_ROPE)), Q_LORA),
        "mla_wo": w(ks[17], (N_B_LAYERS, N_HEADS_B * V_DIM, D), N_HEADS_B * V_DIM),
        "final_norm": gain(ks[18], (D,)),
    }


def reference(x, ln_ffn1, ffn1_wgu, ffn1_wd, ln_mix, ln_ffn2, ffn2_wgu, ffn2_wd,
              moba_wqkv, moba_wo, kv_norm, mla_wdkv, ckv_norm, mla_wukv,
              mla_wdq, cq_norm, mla_wuq, mla_wo, final_norm):
    S = x.shape[1]
    slopes = alibi_slopes(N_HEADS_A)
    cos, sin = rope_tables(S)

    def macaron_layer(h, l, mixer):
        h = h + 0.5 * swiglu(rmsnorm(h, ln_ffn1[l]), ffn1_wgu[l], ffn1_wd[l])
        h = h + mixer(rmsnorm(h, ln_mix[l]))
        h = h + 0.5 * swiglu(rmsnorm(h, ln_ffn2[l]), ffn2_wgu[l], ffn2_wd[l])
        return h

    h = x
    for l in range(N_A_LAYERS):
        h = macaron_layer(h, l, lambda xn, l=l: moba_attention(xn, moba_wqkv[l], moba_wo[l], slopes))
    k_sh, v_sh = mla_shared_kv(h, kv_norm, mla_wdkv, ckv_norm, mla_wukv, cos, sin)
    for j in range(N_B_LAYERS):
        l = N_A_LAYERS + j
        h = macaron_layer(h, l, lambda xn, j=j: mla_attention(
            xn, mla_wdq[j], cq_norm[j], mla_wuq[j], mla_wo[j], k_sh, v_sh, cos, sin))
    return rmsnorm(h, final_norm)
```

```cpp
#include <hip/hip_runtime.h>
#include <hip/hip_bf16.h>
#include <cstdio>
#include <cstdint>
namespace pg8 {
#define PG8_LAS __attribute__((address_space(3)))
typedef unsigned short bf16_t;
typedef short bf16x8 __attribute__((ext_vector_type(8)));
typedef float f32x4 __attribute__((ext_vector_type(4)));
typedef unsigned u32x4 __attribute__((ext_vector_type(4)));
constexpr int BM = 256, BK = 64, HALF = 128, HTB = HALF * BK * 2  , STAGE_BYTES = 8 * HTB, NXCD = 8, WGM = 8;

__host__ __device__ __forceinline__ int lds_byte(int r, int c) { const int st = (r >> 4) * 2 + (c >> 5), rr = r & 15, cc = c & 31, ob = rr * 64 + cc * 2; return st * 1024 + (ob ^ (((ob >> 9) & 1) << 5)); }
__host__ __device__ __forceinline__ void stage_rc(int b, int& R, int& C) { const int st = b / 1024, sb = b % 1024, swz = sb ^ (((sb >> 9) & 1) << 5); R = (st >> 1) * 16 + swz / 64; C = (st & 1) * 32 + (swz % 64) / 2; }
__host__ __device__ __forceinline__ int perm32(int rho) { const int n = rho >> 4, i = rho & 15; return 8 * (i >> 2) + 4 * n + (i & 3); }

struct Unit { int pm, pn; };
struct Gemm { const bf16_t* A; const bf16_t* Bt; int M, N, K; };

struct StaticOrder {
    int nM, nN, nwg, G, c;
    __host__ __device__ void init(int M, int N, int G_, int c_) { nM = M / BM; nN = N / BM; nwg = nM * nN; G = G_; c = c_; }
    __host__ __device__ bool next(int i, Unit& u) const {
        const long L = (long)i * G + c; if (L >= nwg) return false;
        int wgid = (int)L; { const int q = nwg / NXCD, r = nwg % NXCD, xcd = wgid % NXCD, off = wgid / NXCD; wgid = (xcd < r ? xcd * (q + 1) : r * (q + 1) + (xcd - r) * q) + off; }
        const int nig = WGM * nN, gid = wgid / nig, fm = gid * WGM, gsz = (nM - fm) < WGM ? (nM - fm) : WGM;
        u.pm = fm + ((wgid % nig) % gsz); u.pn = (wgid % nig) / gsz; return true;
    }
    __device__ __forceinline__ void a_ready(const Unit&) const {}
    __device__ __forceinline__ void done(const Unit&) const {}
};

__device__ __forceinline__ unsigned cvt_pk_bf16(float lo, float hi) { unsigned r; asm volatile("v_cvt_pk_bf16_f32 %0, %1, %2" : "=v"(r) : "v"(lo), "v"(hi)); return r; }
typedef float f32x2 __attribute__((ext_vector_type(2)));
constexpr int SSQ_STRIDE = 32;
constexpr float RMS_EPS = 1e-6f;
__device__ __forceinline__ u32x4 pack8f(f32x4 a, f32x4 b) { u32x4 w; w.x = cvt_pk_bf16(a[0], a[1]); w.y = cvt_pk_bf16(a[2], a[3]); w.z = cvt_pk_bf16(b[0], b[1]); w.w = cvt_pk_bf16(b[2], b[3]); return w; }
template <int NP4> __device__ __forceinline__ float row_rstd(const float* ssq, int row, float inv_dim) {
    const f32x4* p = (const f32x4*)(ssq + (size_t)row * SSQ_STRIDE); float s = 0.f;
#pragma unroll
    for (int j = 0; j < NP4; ++j) { const f32x4 v = p[j]; s += (v[0] + v[1]) + (v[2] + v[3]); }
    return 1.0f / sqrtf(s * inv_dim + RMS_EPS);
}
template <int NP4> __device__ __forceinline__ void lane_rstd(float (&rs)[2][4], const float* ssq, int row0w, int fr, int fq, float inv_dim) {
    const float mine0 = row_rstd<NP4>(ssq, row0w + 16 * fq + fr, inv_dim), mine1 = row_rstd<NP4>(ssq, row0w + HALF + 16 * fq + fr, inv_dim);
#pragma unroll
    for (int m = 0; m < 4; ++m) { rs[0][m] = __shfl(mine0, fr + 16 * m); rs[1][m] = __shfl(mine1, fr + 16 * m); }
    asm volatile("" ::: "memory");
}
__device__ __forceinline__ float sumsq4(f32x4 v) { return (v[0] * v[0] + v[1] * v[1]) + (v[2] * v[2] + v[3] * v[3]); }
__device__ __forceinline__ float silu_mul(float g, float u) { return g * u * __builtin_amdgcn_rcpf(1.0f + __builtin_amdgcn_exp2f(-1.4426950408889634f * g)); }

__device__ __forceinline__ void store_scaled_tile(const f32x4 (&acc)[2][2][4][2], const float (&rs)[2][4], bf16_t* out, int ldo, int row0, int ocol0, float* ssq_out, int slot, int fq) {
#pragma unroll
    for (int ai = 0; ai < 2; ++ai)
#pragma unroll
        for (int m = 0; m < 4; ++m) { const int row = row0 + ai * HALF + m * 16; const float r = rs[ai][m]; float s = 0.f;
#pragma unroll
            for (int bj = 0; bj < 2; ++bj) { const f32x4 v0 = acc[ai][bj][m][0] * r, v1 = acc[ai][bj][m][1] * r; s += sumsq4(v0) + sumsq4(v1);
                *(u32x4*)(out + (size_t)row * ldo + ocol0 + bj * HALF) = pack8f(v0, v1); }
            if (ssq_out) { s += __shfl_xor(s, 16); s += __shfl_xor(s, 32); if (fq == 0) ssq_out[(size_t)row * SSQ_STRIDE + slot] = s; }
            asm volatile("" ::: "memory"); }
}

struct EpiUp {
    static constexpr bool PERM = true, AFTER_DRAIN = false;
    bf16_t* hid; const float* ssq; int n_ffn;
    bf16_t* ckv; float* ssq_ckv; bf16_t* kr; const float* cos_t; const float* sin_t;
    __device__ __forceinline__ void operator()(const f32x4 (&acc)[2][2][4][2], const Unit& u, int wr, int wc, int fr, int fq) const {
        const int row0 = u.pm * BM + wr * 64 + fr; float rs[2][4]; lane_rstd<8>(rs, ssq, row0 - fr, fr, fq, 1.0f / 2048.0f);
        if (u.pn < n_ffn) {
            const int col0 = u.pn * HALF + wc * 32 + 8 * fq;
#pragma unroll
            for (int ai = 0; ai < 2; ++ai)
#pragma unroll
                for (int m = 0; m < 4; ++m) { const float r = rs[ai][m]; const f32x4 g0 = acc[ai][0][m][0] * r, g1 = acc[ai][0][m][1] * r, u0 = acc[ai][1][m][0] * r, u1 = acc[ai][1][m][1] * r;
                    f32x4 h0, h1;
#pragma unroll
                    for (int e = 0; e < 4; ++e) { h0[e] = silu_mul(g0[e], u0[e]); h1[e] = silu_mul(g1[e], u1[e]); }
                    *(u32x4*)(hid + (size_t)(row0 + ai * HALF + m * 16) * 5632 + col0) = pack8f(h0, h1); asm volatile("" ::: "memory"); }
        } else if (u.pn < n_ffn + 2) {
            const int t = u.pn - n_ffn;
            store_scaled_tile(acc, rs, ckv, 512, row0, t * BM + wc * 32 + 8 * fq, ssq_ckv, t * 4 + wc, fq);
        } else if (wc == 0) {
#pragma unroll
            for (int ai = 0; ai < 2; ++ai)
#pragma unroll
                for (int m = 0; m < 4; ++m) { const int row = row0 + ai * HALF + m * 16; const float r = rs[ai][m];
                    const f32x4 c0 = *(const f32x4*)(cos_t + (size_t)row * 32 + 8 * fq), c1 = *(const f32x4*)(cos_t + (size_t)row * 32 + 8 * fq + 4);
                    const f32x4 s0 = *(const f32x4*)(sin_t + (size_t)row * 32 + 8 * fq), s1 = *(const f32x4*)(sin_t + (size_t)row * 32 + 8 * fq + 4);
                    const f32x4 a0 = acc[ai][0][m][0] * r, a1 = acc[ai][0][m][1] * r, b0 = acc[ai][1][m][0] * r, b1 = acc[ai][1][m][1] * r;
                    *(u32x4*)(kr + (size_t)row * 64 + 8 * fq) = pack8f(a0 * c0 - b0 * s0, a1 * c1 - b1 * s1);
                    *(u32x4*)(kr + (size_t)row * 64 + 32 + 8 * fq) = pack8f(a0 * s0 + b0 * c0, a1 * s1 + b1 * c1); asm volatile("" ::: "memory"); }
        }
    }
};
struct EpiRes {
    static constexpr bool PERM = true, AFTER_DRAIN = false;
    const float* res_in; float* res_out; bf16_t* hb; float* ssq; float alpha;
    __device__ __forceinline__ void operator()(const f32x4 (&acc)[2][2][4][2], const Unit& u, int wr, int wc, int fr, int fq) const {
        const int row0 = u.pm * BM + wr * 64 + fr, col0 = u.pn * BM + wc * 32 + 8 * fq;
#pragma unroll
        for (int ai = 0; ai < 2; ++ai)
#pragma unroll
            for (int m = 0; m < 4; ++m) { const int row = row0 + ai * HALF + m * 16; float s = 0.f;
#pragma unroll
                for (int bj = 0; bj < 2; ++bj) { const size_t off = (size_t)row * 2048 + col0 + bj * HALF;
                    const f32x4 r0 = *(const f32x4*)(res_in + off), r1 = *(const f32x4*)(res_in + off + 4);
                    const f32x4 v0 = r0 + acc[ai][bj][m][0] * alpha, v1 = r1 + acc[ai][bj][m][1] * alpha; s += sumsq4(v0) + sumsq4(v1);
                    *(f32x4*)(res_out + off) = v0; *(f32x4*)(res_out + off + 4) = v1; *(u32x4*)(hb + off) = pack8f(v0, v1); }
                s += __shfl_xor(s, 16); s += __shfl_xor(s, 32); if (fq == 0) ssq[(size_t)row * SSQ_STRIDE + u.pn * 4 + wc] = s;
                asm volatile("" ::: "memory"); }
    }
};
struct EpiQKV {
    static constexpr bool PERM = true, AFTER_DRAIN = false;
    bf16_t* qkv; size_t tstride; const float* ssq; float* kmean;
    __device__ __forceinline__ void operator()(const f32x4 (&acc)[2][2][4][2], const Unit& u, int wr, int wc, int fr, int fq) const {
        const int row0 = u.pm * BM + wr * 64 + fr; float rs[2][4]; lane_rstd<8>(rs, ssq, row0 - fr, fr, fq, 1.0f / 2048.0f);
        const int t = u.pn >> 3, ocol0 = (u.pn & 7) * BM + wc * 32 + 8 * fq; bf16_t* dst = qkv + (size_t)t * tstride;
        store_scaled_tile(acc, rs, dst, 2048, row0, ocol0, nullptr, 0, fq);
        if (t == 1) {
#pragma unroll
            for (int bj = 0; bj < 2; ++bj)
#pragma unroll
                for (int n = 0; n < 2; ++n)
#pragma unroll
                    for (int e = 0; e < 4; ++e) { float s = 0.f;
#pragma unroll
                        for (int ai = 0; ai < 2; ++ai)
#pragma unroll
                            for (int m = 0; m < 4; ++m) s += acc[ai][bj][m][n][e] * rs[ai][m];
                        s += __shfl_xor(s, 1); s += __shfl_xor(s, 2); s += __shfl_xor(s, 4); s += __shfl_xor(s, 8);
                        if (fr == 0) __hip_atomic_fetch_add(kmean + (size_t)u.pm * 2048 + ocol0 + bj * HALF + 4 * n + e, s, __ATOMIC_RELAXED, __HIP_MEMORY_SCOPE_AGENT); }
        }
    }
};
struct EpiScaled {
    static constexpr bool PERM = true, AFTER_DRAIN = false;
    bf16_t* out; int ldo; const float* ssq_in; float* ssq_out;
    __device__ __forceinline__ void operator()(const f32x4 (&acc)[2][2][4][2], const Unit& u, int wr, int wc, int fr, int fq) const {
        const int row0 = u.pm * BM + wr * 64 + fr; float rs[2][4]; lane_rstd<8>(rs, ssq_in, row0 - fr, fr, fq, 1.0f / 2048.0f);
        store_scaled_tile(acc, rs, out, ldo, row0, u.pn * BM + wc * 32 + 8 * fq, ssq_out, u.pn * 4 + wc, fq);
    }
};
struct EpiUQ {
    static constexpr bool PERM = true, AFTER_DRAIN = false;
    bf16_t* qn; bf16_t* qr; const float* ssq_cq; const float* cos_t; const float* sin_t;
    __device__ __forceinline__ void operator()(const f32x4 (&acc)[2][2][4][2], const Unit& u, int wr, int wc, int fr, int fq) const {
        const int row0 = u.pm * BM + wr * 64 + fr; float rs[2][4]; lane_rstd<3>(rs, ssq_cq, row0 - fr, fr, fq, 1.0f / 768.0f);
        if (u.pn < 8) { store_scaled_tile(acc, rs, qn, 2048, row0, u.pn * BM + wc * 32 + 8 * fq, nullptr, 0, fq); }
        else { const int head = (u.pn - 8) * 4 + wc;
#pragma unroll
            for (int ai = 0; ai < 2; ++ai)
#pragma unroll
                for (int m = 0; m < 4; ++m) { const int row = row0 + ai * HALF + m * 16; const float r = rs[ai][m];
                    const f32x4 c0 = *(const f32x4*)(cos_t + (size_t)row * 32 + 8 * fq), c1 = *(const f32x4*)(cos_t + (size_t)row * 32 + 8 * fq + 4);
                    const f32x4 s0 = *(const f32x4*)(sin_t + (size_t)row * 32 + 8 * fq), s1 = *(const f32x4*)(sin_t + (size_t)row * 32 + 8 * fq + 4);
                    const f32x4 a0 = acc[ai][0][m][0] * r, a1 = acc[ai][0][m][1] * r, b0 = acc[ai][1][m][0] * r, b1 = acc[ai][1][m][1] * r;
                    *(u32x4*)(qr + (size_t)row * 1024 + head * 64 + 8 * fq) = pack8f(a0 * c0 - b0 * s0, a1 * c1 - b1 * s1);
                    *(u32x4*)(qr + (size_t)row * 1024 + head * 64 + 32 + 8 * fq) = pack8f(a0 * s0 + b0 * c0, a1 * s1 + b1 * c1); asm volatile("" ::: "memory"); } }
    }
};
struct EpiUKV {
    static constexpr bool PERM = true, AFTER_DRAIN = false;
    bf16_t* kn; bf16_t* v; const float* ssq_ckv;
    __device__ __forceinline__ void operator()(const f32x4 (&acc)[2][2][4][2], const Unit& u, int wr, int wc, int fr, int fq) const {
        const int row0 = u.pm * BM + wr * 64 + fr; float rs[2][4]; lane_rstd<2>(rs, ssq_ckv, row0 - fr, fr, fq, 1.0f / 512.0f);
        const int ocol = u.pn * HALF + wc * 32 + 8 * fq;
#pragma unroll
        for (int ai = 0; ai < 2; ++ai)
#pragma unroll
            for (int m = 0; m < 4; ++m) { const size_t off = (size_t)(row0 + ai * HALF + m * 16) * 2048 + ocol; const float r = rs[ai][m];
                *(u32x4*)(kn + off) = pack8f(acc[ai][0][m][0] * r, acc[ai][0][m][1] * r); *(u32x4*)(v + off) = pack8f(acc[ai][1][m][0] * r, acc[ai][1][m][1] * r); }
    }
};

template <class Epi, class Sched, bool ALIGN_EPI = false, bool SP2 = false>
__device__ __forceinline__ void gemm_phase(PG8_LAS unsigned char* lds, const Gemm g, const Sched& S, const Epi& E) {
    int tid_ = threadIdx.x; asm volatile("" : "+v"(tid_));
    const int tid = tid_, wid = __builtin_amdgcn_readfirstlane(tid >> 6), lane = tid & 63, wr = wid >> 2, wc = wid & 3, fr = lane & 15, fq = lane >> 4;
    const int K = g.K, nt = K / BK;
    unsigned voffA[2], voffB[2];
#pragma unroll
    for (int i = 0; i < 2; ++i) { int R, C; stage_rc(tid * 16 + i * 8192, R, C); const int Rb = Epi::PERM ? ((R & ~31) + perm32(R & 31)) : R;
        voffA[i] = (unsigned)(R * K + C) * 2u; voffB[i] = (unsigned)(Rb * K + C) * 2u; }
    const size_t kstep = (size_t)(BK * 2);
    const size_t hstep = (size_t)HALF * K * 2;
    const size_t tstep = 2 * hstep;
    const unsigned ldsw = (unsigned)wid * 1024u;
    const int aoff = lds_byte(wr * 64 + fr, fq * 8), boff = lds_byte(wc * 32 + fr, fq * 8);
#define PG8_SA(b, h) (((b) * 2 + (h)) * HTB)
#define PG8_SB(b, h) ((4 + (b) * 2 + (h)) * HTB)
#define PG8_STAGE(bufoff, gbase, voff) do { _Pragma("unroll") for (int _i = 0; _i < 2; ++_i) \
        __builtin_amdgcn_global_load_lds((const unsigned*)((const char*)(gbase) + (voff)[_i]), (PG8_LAS unsigned*)(lds + (bufoff) + ldsw + _i * 8192), 16, 0, 0); } while (0)
#define PG8_LDA(dst, b, h) do { _Pragma("unroll") for (int m = 0; m < 4; ++m) _Pragma("unroll") for (int k = 0; k < 2; ++k) dst[m][k] = *(const PG8_LAS bf16x8*)(lds + PG8_SA(b, h) + aoff + m * 2048 + k * 1024); } while (0)
#define PG8_LDB(dst, b, h) do { _Pragma("unroll") for (int n = 0; n < 2; ++n) _Pragma("unroll") for (int k = 0; k < 2; ++k) dst[n][k] = *(const PG8_LAS bf16x8*)(lds + PG8_SB(b, h) + boff + n * 2048 + k * 1024); } while (0)
#define PG8_MMA(ai, bj, At, Bt) do { __builtin_amdgcn_s_setprio(1); _Pragma("unroll") for (int m = 0; m < 4; ++m) _Pragma("unroll") for (int n = 0; n < 2; ++n) _Pragma("unroll") for (int k = 0; k < 2; ++k) \
        acc[ai][bj][m][n] = __builtin_amdgcn_mfma_f32_16x16x32_bf16(Bt[n][k], At[m][k], acc[ai][bj][m][n], 0, 0, 0); __builtin_amdgcn_s_setprio(0); } while (0)
#define PG8_WAIT_V(n) asm volatile("s_waitcnt vmcnt(" #n ")" ::: "memory")
#define PG8_WAIT_L(n) asm volatile("s_waitcnt lgkmcnt(" #n ")" ::: "memory")
#define PG8_BAR __builtin_amdgcn_s_barrier()
#define PG8_SCHED __builtin_amdgcn_sched_barrier(0)
    Unit cur, nxt; int ui = 0;
    if (!S.next(0, cur)) return;
    f32x4 acc[2][2][4][2];
#pragma unroll
    for (int a = 0; a < 2; ++a)
#pragma unroll
        for (int b = 0; b < 2; ++b)
#pragma unroll
            for (int m = 0; m < 4; ++m)
#pragma unroll
                for (int n = 0; n < 2; ++n) acc[a][b][m][n] = (f32x4){0.f, 0.f, 0.f, 0.f};
    bf16x8 At[4][2], B0[2][2], B1[2][2];
    const char* cA = (const char*)g.A + (size_t)cur.pm * tstep; const char* cB = (const char*)g.Bt + (size_t)cur.pn * tstep;
    S.a_ready(cur);
    if constexpr (SP2) {
        PG8_STAGE(PG8_SB(0, 0), cB, voffB); PG8_STAGE(PG8_SB(0, 1), cB + hstep, voffB); PG8_STAGE(PG8_SA(0, 0), cA, voffA); PG8_STAGE(PG8_SA(0, 1), cA + hstep, voffA);
        if (wr == 1) PG8_BAR;
        PG8_WAIT_V(2); PG8_BAR;
        PG8_STAGE(PG8_SB(1, 0), cB + kstep, voffB); PG8_STAGE(PG8_SA(1, 0), cA + kstep, voffA); PG8_STAGE(PG8_SB(1, 1), cB + hstep + kstep, voffB);
        PG8_WAIT_V(6); PG8_BAR;
    } else {
        PG8_STAGE(PG8_SB(0, 0), cB, voffB); PG8_STAGE(PG8_SA(0, 0), cA, voffA); PG8_STAGE(PG8_SB(0, 1), cB + hstep, voffB); PG8_STAGE(PG8_SA(0, 1), cA + hstep, voffA);
        if (wr == 1) PG8_BAR;
        PG8_WAIT_V(4); PG8_BAR;
        PG8_STAGE(PG8_SB(1, 0), cB + kstep, voffB); PG8_STAGE(PG8_SA(1, 0), cA + kstep, voffA); PG8_STAGE(PG8_SB(1, 1), cB + hstep + kstep, voffB);
        PG8_WAIT_V(6); PG8_BAR;
    }
    for (;;) {
        const bool has_next = S.next(ui + 1, nxt);
        const char* nA = has_next ? (const char*)g.A + (size_t)nxt.pm * tstep : cA; const char* nB = has_next ? (const char*)g.Bt + (size_t)nxt.pn * tstep : cB;
        for (int t = 0; t < nt; t += 2) {
            const bool last = (t == nt - 2);
            const char* a1 = cA + (size_t)(t + 1) * kstep;
            const char* a2 = last ? nA : cA + (size_t)(t + 2) * kstep; const char* b2 = last ? nB : cB + (size_t)(t + 2) * kstep;
            const char* a3 = a2 + kstep; const char* b3 = b2 + kstep;
            if (last && has_next) S.a_ready(nxt);
            if constexpr (SP2) {
            PG8_LDB(B0, 0, 0); PG8_LDB(B1, 0, 1); PG8_SCHED; PG8_LDA(At, 0, 0); PG8_STAGE(PG8_SA(1, 1), a1 + hstep, voffA);
            PG8_WAIT_V(8); PG8_WAIT_L(0); PG8_BAR; PG8_MMA(0, 0, At, B0); PG8_MMA(0, 1, At, B1); PG8_BAR; PG8_SCHED;
            PG8_LDA(At, 0, 1); PG8_STAGE(PG8_SB(0, 0), b2, voffB); PG8_STAGE(PG8_SB(0, 1), b2 + hstep, voffB); PG8_STAGE(PG8_SA(0, 0), a2, voffA);
            PG8_WAIT_V(8); PG8_WAIT_L(0); PG8_BAR; PG8_MMA(1, 0, At, B0); PG8_MMA(1, 1, At, B1); PG8_BAR; PG8_SCHED;
            PG8_LDB(B0, 1, 0); PG8_LDB(B1, 1, 1); PG8_SCHED; PG8_LDA(At, 1, 0); PG8_STAGE(PG8_SA(0, 1), a2 + hstep, voffA);
            PG8_WAIT_V(8); PG8_WAIT_L(0); PG8_BAR; PG8_MMA(0, 0, At, B0); PG8_MMA(0, 1, At, B1); PG8_BAR; PG8_SCHED;
            PG8_LDA(At, 1, 1); PG8_STAGE(PG8_SB(1, 0), b3, voffB); PG8_STAGE(PG8_SB(1, 1), b3 + hstep, voffB); PG8_STAGE(PG8_SA(1, 0), a3, voffA);
            PG8_WAIT_V(8); PG8_WAIT_L(0); PG8_BAR; PG8_MMA(1, 0, At, B0); PG8_MMA(1, 1, At, B1); PG8_BAR; PG8_SCHED;
            } else {
            PG8_LDB(B0, 0, 0); PG8_SCHED; PG8_LDA(At, 0, 0); PG8_STAGE(PG8_SA(1, 1), a1 + hstep, voffA);
            PG8_WAIT_L(8); PG8_BAR; PG8_WAIT_L(0); PG8_MMA(0, 0, At, B0); PG8_BAR; PG8_SCHED;
            PG8_LDB(B1, 0, 1); PG8_STAGE(PG8_SB(0, 0), b2, voffB);
            PG8_BAR; PG8_WAIT_L(0); PG8_MMA(0, 1, At, B1); PG8_BAR;
            PG8_LDA(At, 0, 1); PG8_STAGE(PG8_SA(0, 0), a2, voffA);
            PG8_BAR; PG8_WAIT_L(0); PG8_MMA(1, 0, At, B0); PG8_BAR; PG8_SCHED;
            PG8_STAGE(PG8_SB(0, 1), b2 + hstep, voffB);
            PG8_WAIT_V(6); PG8_BAR; PG8_MMA(1, 1, At, B1); PG8_BAR;
            PG8_LDB(B0, 1, 0); PG8_SCHED; PG8_LDA(At, 1, 0); PG8_STAGE(PG8_SA(0, 1), a2 + hstep, voffA);
            PG8_WAIT_L(8); PG8_BAR; PG8_WAIT_L(0); PG8_MMA(0, 0, At, B0); PG8_BAR; PG8_SCHED;
            PG8_LDB(B1, 1, 1); PG8_STAGE(PG8_SB(1, 0), b3, voffB);
            PG8_BAR; PG8_WAIT_L(0); PG8_MMA(0, 1, At, B1); PG8_BAR;
            PG8_LDA(At, 1, 1); PG8_STAGE(PG8_SA(1, 0), a3, voffA);
            PG8_BAR; PG8_WAIT_L(0); PG8_MMA(1, 0, At, B0); PG8_BAR; PG8_SCHED;
            PG8_STAGE(PG8_SB(1, 1), b3 + hstep, voffB);
            PG8_WAIT_V(6); PG8_BAR; PG8_MMA(1, 1, At, B1); PG8_BAR;
            }
        }
        if constexpr (ALIGN_EPI) { if (wr == 0) PG8_BAR; }
        if constexpr (!Epi::AFTER_DRAIN) { E(acc, cur, wr, wc, fr, fq); S.done(cur); }
        if (!has_next) break;
#pragma unroll
        for (int a = 0; a < 2; ++a)
#pragma unroll
            for (int b = 0; b < 2; ++b)
#pragma unroll
                for (int m = 0; m < 4; ++m)
#pragma unroll
                    for (int n = 0; n < 2; ++n) acc[a][b][m][n] = (f32x4){0.f, 0.f, 0.f, 0.f};
        cur = nxt; cA = nA; cB = nB; ++ui;
        if constexpr (ALIGN_EPI) { if (wr == 1) PG8_BAR; }
    }
    PG8_WAIT_V(0);
    if constexpr (!ALIGN_EPI) { if (wr == 0) PG8_BAR; }
    PG8_BAR;
    if constexpr (Epi::AFTER_DRAIN) { E.fused(acc, cur, wr, wc, fr, fq, lds, wid, lane); S.done(cur); }
#undef PG8_SA
#undef PG8_SB
#undef PG8_STAGE
#undef PG8_LDA
#undef PG8_LDB
#undef PG8_MMA
#undef PG8_WAIT_V
#undef PG8_WAIT_L
#undef PG8_BAR
#undef PG8_SCHED
}
}
namespace att {
using bf16 = __hip_bfloat16;
typedef short bf16x8 __attribute__((ext_vector_type(8)));
typedef short s16x4 __attribute__((ext_vector_type(4)));
typedef float f32x16 __attribute__((ext_vector_type(16)));
typedef float f32x4 __attribute__((ext_vector_type(4)));
typedef unsigned u32x4 __attribute__((ext_vector_type(4)));
constexpr int NW = 8, QBLK = 32, KVBLK = 64, QB = NW * QBLK, D = 128;
constexpr int RS = 2048, RS_QR = 1024, RS_KR = 64;
constexpr int SHM_V = KVBLK * D * 2, SHM_K = KVBLK * D * 2, SHM_KR = KVBLK * 64 * 2;
constexpr int OFF_V = 0, OFF_K = 2 * SHM_V, OFF_WS = OFF_K + 2 * SHM_K, OFF_KR = OFF_WS + NW * 64 * 4, OFF_KM = OFF_KR + 2 * SHM_KR, LDS_BYTES = OFF_KM + 32 * 256;
constexpr float THR = 8.f;
template <int MODE> struct Cfg { static constexpr float SCALE = MODE == 0 ? 0.08838834764831845f : 0.07216878364870323f; static constexpr int NQ = MODE == 0 ? 8 : 12; };

#define KSWZ(row, colB) ((row) * 256 + ((colB) ^ (((row) & 7) << 4)))
#define KRSWZ(row, colB) ((row) * 128 + ((colB) ^ ((((row) >> 1) & 7) << 4)))
#define SBAR() __builtin_amdgcn_sched_barrier(0)
__device__ __forceinline__ int v_st(int k, int c) { const int kk = (k & ~0xC) | ((k & 4) << 1) | ((k & 8) >> 1); return ((kk >> 3) * 4 + (c >> 5)) * 512 + ((kk & 7) * 32 + (c & 31)) * 2; }
__device__ __forceinline__ int v_rd_base(int lane) { return ((lane & 3) << 3) | (((lane >> 2) & 3) << 6) | (((lane >> 4) & 1) << 5) | (((lane >> 5) & 1) << 8); }
constexpr int v_rd_off(int d0, int ks, int half) { return d0 * 512 + ks * 4096 + half * 2048; }
__device__ __forceinline__ int crow(int r, int hi) { return (r & 3) + 8 * (r >> 2) + 4 * hi; }
__device__ __forceinline__ unsigned cvtpk(float lo, float hi) { unsigned r; asm volatile("v_cvt_pk_bf16_f32 %0, %1, %2" : "=v"(r) : "v"(lo), "v"(hi)); return r; }
__device__ __forceinline__ bf16x8 pack8(f32x4 a, f32x4 b) { u32x4 w = {cvtpk(a[0], a[1]), cvtpk(a[2], a[3]), cvtpk(b[0], b[1]), cvtpk(b[2], b[3])}; return *reinterpret_cast<bf16x8*>(&w); }
__device__ __forceinline__ bf16x8 load8(const bf16* p) { return *reinterpret_cast<const bf16x8*>(p); }
__device__ __forceinline__ void mask_tile(f32x16& p0, f32x16& p1, int dq) {
    const float NEG = -__builtin_inff();
#pragma unroll
    for (int r = 0; r < 16; ++r) { const int c = (r & 3) + 8 * (r >> 2); if (dq - c < 0) p0[r] = NEG; if (dq - c - 32 < 0) p1[r] = NEG; }
}
template <int MODE> __device__ __forceinline__ void partialSM(f32x16& p0, f32x16& p1, float& m_reg, float& mn, float& alpha) {
    constexpr float SCALE = Cfg<MODE>::SCALE;
    float pmax = p0[0]; for (int r = 1; r < 16; ++r) pmax = fmaxf(pmax, p0[r]); for (int r = 0; r < 16; ++r) pmax = fmaxf(pmax, p1[r]);
    { auto rr = __builtin_amdgcn_permlane32_swap(__float_as_uint(pmax), __float_as_uint(pmax), false, false);
      pmax = fmaxf(__uint_as_float(rr[0]), __uint_as_float(rr[1])); }
    constexpr float C2 = 1.4426950408889634f * SCALE;
    if (__builtin_expect(__all((pmax - m_reg) * SCALE <= THR), 1)) { mn = m_reg; alpha = 1.f; }
    else { mn = fmaxf(m_reg, pmax); alpha = __builtin_amdgcn_exp2f((m_reg - mn) * C2); m_reg = mn; }
    const float mnL = -mn * C2;
    for (int r = 0; r < 16; ++r) p0[r] = fmaf(p0[r], C2, mnL); for (int r = 0; r < 16; ++r) p1[r] = fmaf(p1[r], C2, mnL);
    for (int r = 0; r < 16; ++r) p0[r] = __builtin_amdgcn_exp2f(p0[r]);
}
__device__ __forceinline__ void finishSM(f32x16& p0, f32x16& p1, float alpha, float& l_reg, bf16x8& pa0, bf16x8& pa1, bf16x8& pa2, bf16x8& pa3) {
    for (int r = 0; r < 16; ++r) p1[r] = __builtin_amdgcn_exp2f(p1[r]);
    float ps = 0; for (int r = 0; r < 16; ++r) ps += p0[r]; for (int r = 0; r < 16; ++r) ps += p1[r];
    { auto rr = __builtin_amdgcn_permlane32_swap(__float_as_uint(ps), __float_as_uint(ps), false, false);
      ps = __uint_as_float(rr[0]) + __uint_as_float(rr[1]); }
    l_reg = l_reg * alpha + ps;
#define PK4(P, B_, OUT) do { unsigned a0 = cvtpk(P[B_+0], P[B_+1]), a1 = cvtpk(P[B_+2], P[B_+3]);                          \
        unsigned b0 = cvtpk(P[B_+4], P[B_+5]), b1 = cvtpk(P[B_+6], P[B_+7]);                                             \
        auto r0 = __builtin_amdgcn_permlane32_swap(a0, b0, false, false); auto r1 = __builtin_amdgcn_permlane32_swap(a1, b1, false, false); \
        u32x4 w = {r0[0], r1[0], r0[1], r1[1]}; OUT = *reinterpret_cast<bf16x8*>(&w); } while (0)
    PK4(p0, 0, pa0); PK4(p0, 8, pa1); PK4(p1, 0, pa2); PK4(p1, 8, pa3);
#undef PK4
}
template <int MODE, int KB>
__device__ __forceinline__ void qkt(f32x16& p0, f32x16& p1, const char* K_lds, const char* KR_lds, int r32, int hi, const bf16x8* qr, float slopeP, float tb) {
    if constexpr (MODE == 0) {
#pragma unroll
        for (int r = 0; r < 16; ++r) { const int c = (r & 3) + 8 * (r >> 2); p0[r] = fmaf(slopeP, (float)c, tb); p1[r] = fmaf(slopeP, (float)(c + 32), tb); }
    } else { p0 = f32x16{}; p1 = f32x16{}; }
    const char* kb[4];
#pragma unroll
    for (int dd = 0; dd < 4; ++dd) kb[dd] = K_lds + KB * SHM_K + KSWZ(r32, (dd * 16 + hi * 8) * 2);
#pragma unroll
    for (int d0 = 0; d0 < 8; ++d0) { const char* a = kb[d0 & 3] + (d0 >> 2) * 128;
        bf16x8 b0 = *reinterpret_cast<const bf16x8*>(a);
        bf16x8 b1 = *reinterpret_cast<const bf16x8*>(a + 32 * 256);
        p0 = __builtin_amdgcn_mfma_f32_32x32x16_bf16(b0, qr[d0], p0, 0, 0, 0);
        p1 = __builtin_amdgcn_mfma_f32_32x32x16_bf16(b1, qr[d0], p1, 0, 0, 0); }
    if constexpr (MODE == 1) {
#pragma unroll
        for (int dd = 0; dd < 4; ++dd) { const char* a = KR_lds + KB * SHM_KR + KRSWZ(r32, (dd * 16 + hi * 8) * 2);
            bf16x8 b0 = *reinterpret_cast<const bf16x8*>(a);
            bf16x8 b1 = *reinterpret_cast<const bf16x8*>(a + 32 * 128);
            p0 = __builtin_amdgcn_mfma_f32_32x32x16_bf16(b0, qr[8 + dd], p0, 0, 0, 0);
            p1 = __builtin_amdgcn_mfma_f32_32x32x16_bf16(b1, qr[8 + dd], p1, 0, 0, 0); }
    }
}
template <int VB>
__device__ __forceinline__ void pv_tile(f32x16* o, int vb0, bf16x8 pa0, bf16x8 pa1, bf16x8 pa2, bf16x8 pa3) {
#define TRRD(dst, off) asm volatile("ds_read_b64_tr_b16 %0, %1 offset:%2" : "=&v"(dst) : "v"(vb0), "i"(off) : "memory")
#define PV_D0(d0) do { s16x4 l0, l1, l2, l3, h0, h1, h2, h3; constexpr int b_ = VB * SHM_V + v_rd_off(d0, 0, 0);   \
        TRRD(l0, b_); TRRD(h0, b_ + 2048); TRRD(l1, b_ + 4096); TRRD(h1, b_ + 6144); TRRD(l2, b_ + 8192); TRRD(h2, b_ + 10240); TRRD(l3, b_ + 12288); TRRD(h3, b_ + 14336); \
        asm volatile("s_waitcnt lgkmcnt(0)" ::: "memory"); SBAR();   \
        o[d0] = __builtin_amdgcn_mfma_f32_32x32x16_bf16(pa0, (bf16x8){l0[0], l0[1], l0[2], l0[3], h0[0], h0[1], h0[2], h0[3]}, o[d0], 0, 0, 0);   \
        o[d0] = __builtin_amdgcn_mfma_f32_32x32x16_bf16(pa1, (bf16x8){l1[0], l1[1], l1[2], l1[3], h1[0], h1[1], h1[2], h1[3]}, o[d0], 0, 0, 0);   \
        o[d0] = __builtin_amdgcn_mfma_f32_32x32x16_bf16(pa2, (bf16x8){l2[0], l2[1], l2[2], l2[3], h2[0], h2[1], h2[2], h2[3]}, o[d0], 0, 0, 0);   \
        o[d0] = __builtin_amdgcn_mfma_f32_32x32x16_bf16(pa3, (bf16x8){l3[0], l3[1], l3[2], l3[3], h3[0], h3[1], h3[2], h3[3]}, o[d0], 0, 0, 0); } while (0)
    PV_D0(0); PV_D0(1); PV_D0(2); PV_D0(3);
#undef PV_D0
#undef TRRD
}

struct BlockRef { const bf16* Q; const bf16* QR; const bf16* K; const bf16* V; bf16* O; int P0; int h; };
template <int MODE> struct Seam { bf16x8 qr[Cfg<MODE>::NQ]; bf16x8 st_v0, st_v1, st_k0, st_k1, st_kr; };
struct Shared { const bf16* KR; const float* kmean; };

#define ROW(p, k0, rr) ((p) + (size_t)((k0) + (rr)) * RS + sc)
#define VMW() asm volatile("s_waitcnt vmcnt(0)" ::: "memory")
#define VMWN(n) asm volatile("s_waitcnt vmcnt(%0)" :: "i"(n) : "memory")
#define SLOAD_H(Kp, Vp, k0) do { S.st_v0 = load8(ROW(Vp, k0, sr)); S.st_v1 = load8(ROW(Vp, k0, 32 + sr));              \
                         S.st_k0 = load8(ROW(Kp, k0, sr)); S.st_k1 = load8(ROW(Kp, k0, 32 + sr));                       \
                         if constexpr (MODE == 1) S.st_kr = load8(G.KR + (size_t)((k0) + krr) * RS_KR + krc); } while (0)
#define SWRITE_HK(bf) do { *(bf16x8*)(K_lds + (bf) * SHM_K + kws) = S.st_k0; *(bf16x8*)(K_lds + (bf) * SHM_K + kws + 32 * 256) = S.st_k1; \
                           if constexpr (MODE == 1) *(bf16x8*)(KR_lds + (bf) * SHM_KR + krws) = S.st_kr; } while (0)
#define SWRITE_HV(bf) do { *(bf16x8*)(V_lds + (bf) * SHM_V + vst0) = S.st_v0; *(bf16x8*)(V_lds + (bf) * SHM_V + vst1) = S.st_v1; } while (0)
#define SWRITE_H(bf) do { SWRITE_HV(bf); SWRITE_HK(bf); } while (0)
#define QLOAD(Sq, ref) do { _Pragma("unroll") for (int d0 = 0; d0 < 8; ++d0) Sq.qr[d0] = load8((ref).Q + (size_t)(wid * QBLK + r32) * RS + d0 * 16 + hi * 8);    \
        if constexpr (MODE == 1) { _Pragma("unroll") for (int d0 = 0; d0 < 4; ++d0) Sq.qr[8 + d0] = load8((ref).QR + (size_t)(wid * QBLK + r32) * RS_QR + d0 * 16 + hi * 8); } } while (0)

template <int MODE>
__device__ __forceinline__ void attn_prime(const BlockRef& cur, const Shared& G, char* lds, Seam<MODE>& S) {
    int tid_ = threadIdx.x; asm volatile("" : "+v"(tid_));
    const int tid = tid_, wid = __builtin_amdgcn_readfirstlane(tid >> 6), lane = tid & 63, r32 = lane & 31, hi = lane >> 5;
    const int sr = tid >> 4, sc = (tid & 15) * 8, vst0 = v_st(sr, sc), vst1 = v_st(32 + sr, sc), kws = KSWZ(sr, sc * 2);
    char* V_lds = lds + OFF_V; char* K_lds = lds + OFF_K; char* KR_lds = lds + OFF_KR;
    const int krr = tid >> 3, krc = (tid & 7) * 8, krws = KRSWZ(krr, krc * 2);
    QLOAD(S, cur);
    SLOAD_H(cur.K, cur.V, 0); VMW(); SWRITE_H(0);
    __syncthreads();
}
template <int MODE>
__device__ __forceinline__ void attn_block(const BlockRef& cur, const BlockRef& nxt, const Shared& G, char* lds, Seam<MODE>& S) {
    constexpr float SCALE = Cfg<MODE>::SCALE;
    int tid_ = threadIdx.x; asm volatile("" : "+v"(tid_));
    const int tid = tid_, wid = __builtin_amdgcn_readfirstlane(tid >> 6), lane = tid & 63, r32 = lane & 31, hi = lane >> 5;
    const int NT = (cur.P0 + QB) / KVBLK;
    const int qlo = cur.P0 + wid * QBLK, qm = qlo + r32 - 4 * hi;
    char* V_lds = lds + OFF_V; char* K_lds = lds + OFF_K; char* KR_lds = lds + OFF_KR;
    float* ws = (float*)(lds + OFF_WS) + wid * 64; float* li_l = ws, * al_l = ws + 32;
    float m_reg = -1e30f, l_reg = 0; f32x16 o[4] = {};
    const int sr = tid >> 4, sc = (tid & 15) * 8, vst0 = v_st(sr, sc), vst1 = v_st(32 + sr, sc), kws = KSWZ(sr, sc * 2);
    const int krr = tid >> 3, krc = (tid & 7) * 8, krws = KRSWZ(krr, krc * 2);
    const int vb0 = (int)(uintptr_t)V_lds + v_rd_base(lane);
    const bf16* Kh = cur.K; const bf16* Vh = cur.V;
    unsigned selmask = 0u; float slopeP = 0.f;
    if constexpr (MODE == 0) {
        { const int e_ = cur.h + 1; slopeP = __builtin_ldexpf((e_ & 1) ? 0.70710678118654752f : 1.0f, -(e_ >> 1)) * (1.0f / SCALE); }
        { const int row = tid >> 4, c8 = (tid & 15) * 8; const float* src = G.kmean + (size_t)row * 2048 + cur.h * 128 + c8;
          const f32x4 a = *(const f32x4*)src * (1.0f / 256.0f), b = *(const f32x4*)(src + 4) * (1.0f / 256.0f);
          *(bf16x8*)(lds + OFF_KM + KSWZ(row, c8 * 2)) = pack8(a, b); }
        __syncthreads();
        f32x16 g = {};
#pragma unroll
        for (int d0 = 0; d0 < 8; ++d0) { const bf16x8 kf = *reinterpret_cast<const bf16x8*>(lds + OFF_KM + KSWZ(r32, (d0 * 16 + hi * 8) * 2)); g = __builtin_amdgcn_mfma_f32_32x32x16_bf16(kf, S.qr[d0], g, 0, 0, 0); }
        const int qb = cur.P0 >> 8; const float NEG = -__builtin_inff();
        float gv[16];
#pragma unroll
        for (int r = 0; r < 16; ++r) gv[r] = (crow(r, hi) < qb) ? g[r] : NEG;
        float a1 = NEG, a2 = NEG, a3 = NEG;
#pragma unroll
        for (int r = 0; r < 16; ++r) a1 = fmaxf(a1, gv[r]);
#pragma unroll
        for (int r = 0; r < 16; ++r) a2 = fmaxf(a2, gv[r] < a1 ? gv[r] : NEG);
#pragma unroll
        for (int r = 0; r < 16; ++r) a3 = fmaxf(a3, gv[r] < a2 ? gv[r] : NEG);
        const float b1 = __shfl_xor(a1, 32), b2 = __shfl_xor(a2, 32), b3 = __shfl_xor(a3, 32);
        const float T = fmaxf(fmaxf(a3, b3), fmaxf(fminf(a2, b1), fminf(a1, b2)));
        unsigned msk = 0u;
#pragma unroll
        for (int r = 0; r < 16; ++r) if (gv[r] >= T && crow(r, hi) < qb) msk |= 1u << crow(r, hi);
        selmask = msk | (unsigned)__shfl_xor((int)msk, 32);
    }
#define RESC(a) do { if (__any((a) < 1.f)) { if (hi == 0) al_l[r32] = (a); asm volatile("s_waitcnt lgkmcnt(0)" ::: "memory");              \
                     for (int d_ = 0; d_ < 4; ++d_) for (int r = 0; r < 16; ++r) o[d_][r] *= al_l[crow(r, hi)]; } } while (0)
#define KBASE(t) ((t) * KVBLK)
#define TB(t) (slopeP * (float)(KBASE(t) - cur.P0 + 4 * hi))
#define MASKT(P0_, P1_, t) do { const int kb_ = KBASE(t);                                                                                     \
        if (MODE == 0 && kb_ < cur.P0) { if (!((selmask >> (kb_ >> 8)) & 1u)) { const float NEG_ = -__builtin_inff();                        \
                _Pragma("unroll") for (int r = 0; r < 16; ++r) { P0_[r] = NEG_; P1_[r] = NEG_; } } }                                          \
        else if (kb_ + KVBLK - 1 > qlo) mask_tile(P0_, P1_, qm - kb_); } while (0)
    f32x16 p0, p1; float mn, al; bf16x8 pa0, pa1, pa2, pa3;
#define TILE(t, B) do {                                                                                                       \
        const bool lastt_ = (t) + 1 >= NT;                                                                                    \
        if (!lastt_) { SLOAD_H(Kh, Vh, KBASE((t) + 1)); } else { SLOAD_H(nxt.K, nxt.V, 0); }                                  \
        SBAR(); qkt<MODE, B>(p0, p1, K_lds, KR_lds, r32, hi, S.qr, slopeP, TB(t)); SBAR();                                    \
        if (lastt_) { QLOAD(S, nxt); SBAR(); }                                                                                \
        MASKT(p0, p1, (t)); partialSM<MODE>(p0, p1, m_reg, mn, al); RESC(al);                                                 \
        finishSM(p0, p1, al, l_reg, pa0, pa1, pa2, pa3); SBAR();                                                              \
        pv_tile<B>(o, vb0, pa0, pa1, pa2, pa3); SBAR();                                                                       \
        SWRITE_H((B) ^ 1);                                                                                                    \
        __syncthreads(); } while (0)
    for (int t = 0; t < NT; t += 2) { TILE(t, 0); TILE(t + 1, 1); }
    if (hi == 0) li_l[r32] = l_reg; asm volatile("s_waitcnt lgkmcnt(0)" ::: "memory");
    float rli[16];
#pragma unroll
    for (int r = 0; r < 16; ++r) rli[r] = __builtin_amdgcn_rcpf(li_l[crow(r, hi)]);
    bf16* Ow = cur.O + (size_t)(wid * QBLK) * RS;
#pragma unroll
    for (int r = 0; r < 16; ++r) { const int orow = crow(r, hi);
#pragma unroll
        for (int d0 = 0; d0 < 4; ++d0) { const float v = o[d0][r] * rli[r]; const float vn = __shfl_xor(v, 1);
            if ((r32 & 1) == 0) *(unsigned*)(Ow + (size_t)orow * RS + d0 * 32 + r32) = cvtpk(v, vn); } }
#undef RESC
#undef KBASE
#undef TB
#undef MASKT
#undef TILE
}
#undef ROW
#undef VMW
#undef VMWN
#undef SLOAD_H
#undef SWRITE_HK
#undef SWRITE_HV
#undef SWRITE_H
#undef QLOAD

__device__ __forceinline__ BlockRef mkref(const bf16* Q, const bf16* QRp, const bf16* K, const bf16* V, bf16* O, int L_, int pass) {
    const int xcd = L_ & 7, k = L_ >> 3, h = 2 * xcd + (k >> 4), s = k & 15, qb = pass ? 31 - s : s;
    BlockRef r; r.Q = Q + (size_t)qb * QB * RS + h * 128; r.QR = QRp + (size_t)qb * QB * RS_QR + h * 64; r.K = K + h * 128; r.V = V + h * 128; r.O = O + (size_t)qb * QB * RS + h * 128; r.P0 = qb * QB; r.h = h; return r;
}
template <int MODE>
__device__ __forceinline__ void attn_phase(char* lds, const bf16* Q, const bf16* QRp, const bf16* K, const bf16* V, bf16* O, const Shared& G) {
    const int total = 256, stride = gridDim.x;
    int L = blockIdx.x; if (L >= total) return;
    int pass = 0; BlockRef cur = mkref(Q, QRp, K, V, O, L, 0);
    Seam<MODE> S;
    attn_prime<MODE>(cur, G, lds, S);
    for (;;) {
        const bool more_pass = pass == 0, more_item = L + stride < total, last = !more_pass && !more_item;
        int passn = pass + 1, Ln = L;
        if (!more_pass) { passn = 0; Ln = more_item ? L + stride : L; }
        const BlockRef nxt = last ? cur : mkref(Q, QRp, K, V, O, Ln, passn);
        attn_block<MODE>(cur, nxt, G, lds, S);
        if (last) break;
        cur = nxt; pass = passn; L = Ln;
    }
}
#undef KSWZ
#undef KRSWZ
#undef SBAR
}
#define GAS __attribute__((address_space(1)))
#define LAS __attribute__((address_space(3)))
typedef unsigned short bf16;
typedef unsigned v4u __attribute__((ext_vector_type(4)));
typedef float f32x4 __attribute__((ext_vector_type(4)));
typedef short bf16x8 __attribute__((ext_vector_type(8)));
typedef GAS unsigned gu32;
typedef GAS unsigned long long gu64;
#define RLX_AGENT __ATOMIC_RELAXED, __HIP_MEMORY_SCOPE_AGENT
#define LDS_WAIT() asm volatile("s_waitcnt lgkmcnt(0)" ::: "memory")
#define VM_WAIT() asm volatile("s_waitcnt vmcnt(0)" ::: "memory")
__device__ __forceinline__ unsigned long long rt() { return __builtin_amdgcn_s_memrealtime(); }
__device__ __forceinline__ unsigned f2bf(float f) { unsigned u = __builtin_bit_cast(unsigned, f); return (u + 0x7fffu + ((u >> 16) & 1u)) >> 16; }
__device__ __forceinline__ unsigned pk2(float lo, float hi) { return f2bf(lo) | (f2bf(hi) << 16); }

#define XB_TMO      128
#define XB_XCNT(j)  (256  + 64 * (j))
#define XB_XSUB(j)  (1280 + 64 * (j))
#define XB_XGEN(j)  (2304 + 64 * (j))
#define XB_TOP      3328
#define XB_TOPGEN   3392
#define XCD_BAR_WORDS 3456
#define XB_SPIN_CAP (1u << 18)

__device__ __forceinline__ unsigned xb_ld(unsigned* p)              { return __hip_atomic_load(p, __ATOMIC_RELAXED, __HIP_MEMORY_SCOPE_AGENT); }
__device__ __forceinline__ unsigned xb_add(unsigned* p, unsigned v) { return __hip_atomic_fetch_add(p, v, __ATOMIC_RELAXED, __HIP_MEMORY_SCOPE_AGENT); }
__device__ __forceinline__ unsigned xb_xcc_id() { return (unsigned)__builtin_amdgcn_s_getreg((3 << 11) | 20) & 0xFu; }
#define XB_SPIN(cond, bar) do { unsigned _sp = 0; while (cond) { __builtin_amdgcn_s_sleep(1); \
    if ((++_sp & 255u) == 0u) { if (xb_ld(&(bar)[XB_TMO])) break; if (_sp > XB_SPIN_CAP) { atomicAdd(&(bar)[XB_TMO], 1u); break; } } } } while (0)

struct XcdBarrier {
    unsigned* bar; unsigned x;
    volatile LAS unsigned* st;
};

__device__ __forceinline__ XcdBarrier xcd_barrier_post(unsigned* bar, volatile LAS unsigned* st) {
    XcdBarrier b; b.bar = bar; b.x = xb_xcc_id(); b.st = st;
    if (threadIdx.x == 0) (void)xb_add(&bar[XB_XCNT(b.x)], 1u);
    return b;
}
__device__ __forceinline__ void xcd_barrier_complete(unsigned* bar, unsigned x, unsigned& nloc, unsigned& nx) {
    const unsigned G = gridDim.x * gridDim.y * gridDim.z;
    unsigned sum, cnt, mine, sp = 0u;
    for (;;) {
        sum = 0u; cnt = 0u; mine = 0u;
#pragma unroll
        for (unsigned j = 0; j < 16; ++j) { const unsigned c = xb_ld(&bar[XB_XCNT(j)]); sum += c; cnt += (c > 0u) ? 1u : 0u; mine = (j == x) ? c : mine; }
        if (sum == G) break;
        __builtin_amdgcn_s_sleep(1);
        if ((++sp & 255u) == 0u) { if (xb_ld(&bar[XB_TMO])) break; if (sp > XB_SPIN_CAP) { atomicAdd(&bar[XB_TMO], 1u); break; } }
    }
    nloc = mine > 0u ? mine : 1u; nx = cnt > 0u ? cnt : 1u;
}

__device__ __forceinline__ void xcd_barrier(const XcdBarrier& b) {
    asm volatile("s_waitcnt vmcnt(0)" ::: "memory");
    __syncthreads();
    if (threadIdx.x == 0) {
        unsigned* bar = b.bar;
        __builtin_amdgcn_s_waitcnt(0);
        unsigned nloc = b.st[0], nx = b.st[1];
        if (nloc == 0u) { xcd_barrier_complete(bar, b.x, nloc, nx); b.st[0] = nloc; b.st[1] = nx; }
        const unsigned old = xb_add(&bar[XB_XSUB(b.x)], 1u);
        const unsigned gen = old / nloc;
        if (old + 1u == (gen + 1u) * nloc) {
            __builtin_amdgcn_fence(__ATOMIC_RELEASE, "agent");
            asm volatile("s_waitcnt vmcnt(0)" ::: "memory");
            const unsigned og = xb_add(&bar[XB_TOP], 1u);
            const unsigned tg = og / nx;
            if (og + 1u == (tg + 1u) * nx) xb_add(&bar[XB_TOPGEN], 1u);
            else XB_SPIN(xb_ld(&bar[XB_TOPGEN]) == tg, bar);
            __builtin_amdgcn_fence(__ATOMIC_ACQUIRE, "agent");
            xb_add(&bar[XB_XGEN(b.x)], 1u);
            asm volatile("s_waitcnt vmcnt(0)" ::: "memory");
        } else {
            XB_SPIN(xb_ld(&bar[XB_XGEN(b.x)]) == gen, bar);
            __builtin_amdgcn_fence(__ATOMIC_ACQUIRE, "agent");
            asm volatile("s_waitcnt vmcnt(0)" ::: "memory");
        }
    }
    __syncthreads();
}
constexpr int NWAVES = 8;
#ifndef MK_MULTI
#define MK_MULTI 0
#endif
constexpr int SEQ = 8192, DM = 2048, FF = 5632, NPHASES = 33;
constexpr size_t MiB = 1u << 20;
constexpr size_t WS_CTL = 0, WS_KMEAN = 1 * MiB, ZERO_BYTES = 2 * MiB;
constexpr size_t WS_SSQ = 2 * MiB, WS_SSQ_CQ = 3 * MiB, WS_SSQ_CKV = 4 * MiB, WS_COS = 5 * MiB, WS_SIN = 6 * MiB;
constexpr size_t WS_HB = 8 * MiB, WS_HID = 40 * MiB, WS_Q = 128 * MiB, WS_K = 160 * MiB, WS_V = 192 * MiB, WS_O = 224 * MiB, WS_QR = 256 * MiB, WS_KR = 272 * MiB, WS_CKV = 273 * MiB, WS_CQ = 281 * MiB;
constexpr size_t WS_FFN = 296 * MiB, FFN_SLOT = 69 * MiB, FFN_WD = 47 * MiB;
constexpr size_t WS_WQKV = 848 * MiB, WS_WO = 896 * MiB, WS_WUKV = 928 * MiB, WS_WDQ = 932 * MiB, WS_WUQ = 938 * MiB, WS_END = 948 * MiB;
constexpr int CW_BAR = 4096;
static_assert(WS_V - WS_K == WS_K - WS_Q, "q | k | v equally spaced");
constexpr int RING_OFF = 0, RING_BYTES = 131072, LDSCTL_OFF = RING_BYTES, MISC_OFF = LDSCTL_OFF + 320, LDS_BYTES = 147456;
static_assert(att::LDS_BYTES <= RING_BYTES && MISC_OFF + 128 <= LDS_BYTES, "LDS map");

__device__ __forceinline__ float wave_sum(float v) {
#pragma unroll
    for (int o = 1; o < 64; o <<= 1) v += __shfl_xor(v, o);
    return v;
}
template <int KIND> __device__ __forceinline__ int conv_src_col(int n0) {
    if constexpr (KIND == 0) return n0;
    else if constexpr (KIND == 1) { const int pn = n0 >> 8, bj = (n0 >> 7) & 1, j = n0 & 127; return bj * FF + pn * 128 + j; }
    else if constexpr (KIND == 2) { if (n0 < 2048) { const int pn = n0 >> 8, hh = (n0 >> 7) & 1, j = n0 & 127; return (2 * pn + hh) * 192 + j; }
                                    const int r = n0 - 2048, t = r >> 8, bj = (r >> 7) & 1, hh = (r >> 5) & 3; return (4 * t + hh) * 192 + 128 + 32 * bj; }
    else { if (n0 < 512) return n0; if (n0 == 512) return 512; if (n0 == 640) return 544; return -1; }
}
template <int KIND>
__device__ __forceinline__ void conv_job(const float* __restrict__ W, int K, int srcN, int N, const float* __restrict__ gain, bf16* __restrict__ WT, LAS float* scr, int gw, int NGW, int lane) {
    const int nblk = N / 32, nitems = (K / 64) * nblk;
    for (int it = gw; it < nitems; it += NGW) {
        const int kb = it / nblk, nb = it - kb * nblk, k0 = 64 * kb, n0 = 32 * nb, sc = conv_src_col<KIND>(n0);
        if (sc >= 0) {
#pragma unroll 8
            for (int i = 0; i < 32; ++i) { const int kk = 2 * i + (lane >> 5); float w = W[(size_t)(k0 + kk) * srcN + sc + (lane & 31)]; if (gain) w *= gain[k0 + kk]; scr[kk * 33 + (lane & 31)] = w; }
        } else {
#pragma unroll 8
            for (int i = 0; i < 32; ++i) { const int kk = 2 * i + (lane >> 5); scr[kk * 33 + (lane & 31)] = 0.f; }
        }
        LDS_WAIT(); asm volatile("" ::: "memory");
        const int c = lane & 7;
#pragma unroll
        for (int j = 0; j < 4; ++j) { const int n = (lane >> 3) + 8 * j; const LAS float* s = scr + (8 * c) * 33 + n;
            v4u o; o.x = pk2(s[0 * 33], s[1 * 33]); o.y = pk2(s[2 * 33], s[3 * 33]); o.z = pk2(s[4 * 33], s[5 * 33]); o.w = pk2(s[6 * 33], s[7 * 33]);
            *(GAS v4u*)(WT + (size_t)(n0 + n) * K + k0 + 8 * c) = o; }
        LDS_WAIT(); asm volatile("" ::: "memory");
    }
}

struct Args { const float* in[19]; float* out; unsigned char* ws; int ph_lo, ph_hi; };
__global__ void __launch_bounds__(NWAVES * 64, 2) yoco_fwd(Args args) {
    extern __shared__ __attribute__((aligned(16))) unsigned char lds[];
    LAS unsigned char* ldsl = (LAS unsigned char*)lds;
    const int tid = threadIdx.x, lane = tid & 63, wave = __builtin_amdgcn_readfirstlane(tid >> 6), G = gridDim.x;
    unsigned char* ws = args.ws;
    gu32* ctl = (gu32*)(ws + WS_CTL);
    for (int u = tid; u < (LDS_BYTES - LDSCTL_OFF) / 4; u += NWAVES * 64) ((LAS unsigned*)(ldsl + LDSCTL_OFF))[u] = 0u;
    __syncthreads();
    XcdBarrier bar = xcd_barrier_post((unsigned*)(ctl + CW_BAR), (volatile LAS unsigned*)(ldsl + MISC_OFF) + 8);
    const int lo = args.ph_lo, hi = args.ph_hi; int seq = 0;
#define PH_RUN (seq >= lo && seq < hi)
#define PH_END do { if (seq >= lo && seq + 1 < hi) xcd_barrier(bar); ++seq; } while (0)
    const float* x = args.in[0]; float* out = args.out;
    float* kmean = (float*)(ws + WS_KMEAN); float* ssq = (float*)(ws + WS_SSQ); float* ssq_cq = (float*)(ws + WS_SSQ_CQ); float* ssq_ckv = (float*)(ws + WS_SSQ_CKV);
    float* cos_t = (float*)(ws + WS_COS); float* sin_t = (float*)(ws + WS_SIN);
    bf16* HB = (bf16*)(ws + WS_HB); bf16* HID = (bf16*)(ws + WS_HID); bf16* QB_ = (bf16*)(ws + WS_Q); bf16* KB_ = (bf16*)(ws + WS_K); bf16* VB_ = (bf16*)(ws + WS_V); bf16* OB = (bf16*)(ws + WS_O);
    bf16* QR = (bf16*)(ws + WS_QR); bf16* KR = (bf16*)(ws + WS_KR); bf16* CKV = (bf16*)(ws + WS_CKV); bf16* CQ = (bf16*)(ws + WS_CQ);
#define WGU(f) ((bf16*)(ws + WS_FFN + (size_t)(f) * FFN_SLOT))
#define WD(f) ((bf16*)(ws + WS_FFN + (size_t)(f) * FFN_SLOT + FFN_WD))
#define WQKV(l) ((bf16*)(ws + WS_WQKV + (size_t)(l) * 24 * MiB))
#define WO(l) ((bf16*)(ws + WS_WO + (size_t)(l) * 8 * MiB))
#define WUKV ((bf16*)(ws + WS_WUKV))
#define WDQ(j) ((bf16*)(ws + WS_WDQ + (size_t)(j) * 3 * MiB))
#define WUQ(j) ((bf16*)(ws + WS_WUQ + (size_t)(j) * 5 * MiB))
    const int gw = (int)blockIdx.x * NWAVES + wave, NGW = G * NWAVES;

    if (PH_RUN) {
        LAS float* scr = (LAS float*)(ldsl + RING_OFF + wave * 16384);
#define CONV(KIND, src, K_, srcN_, N_, gain_, dst) conv_job<KIND>((src), (K_), (srcN_), (N_), (gain_), (dst), scr, gw, NGW, lane)
        for (int f = 0; f < 8; ++f) { const int l = f >> 1, w = f & 1;
            CONV(1, (w ? args.in[6] : args.in[2]) + (size_t)l * DM * 2 * FF, DM, 2 * FF, 2 * FF, (w ? args.in[5] : args.in[1]) + l * DM, WGU(f));
            CONV(0, (w ? args.in[7] : args.in[3]) + (size_t)l * FF * DM, FF, DM, DM, (const float*)nullptr, WD(f)); }
        CONV(3, args.in[11], DM, 576, 768, args.in[10], WGU(4) + (size_t)2 * FF * DM);
        for (int l = 0; l < 2; ++l) { CONV(0, args.in[8] + (size_t)l * DM * 6144, DM, 6144, 6144, args.in[4] + l * DM, WQKV(l)); CONV(0, args.in[9] + (size_t)l * DM * DM, DM, DM, DM, (const float*)nullptr, WO(l)); }
        CONV(0, args.in[13], 512, 4096, 4096, args.in[12], WUKV);
        for (int j = 0; j < 2; ++j) { CONV(0, args.in[14] + (size_t)j * DM * 768, DM, 768, 768, args.in[4] + (2 + j) * DM, WDQ(j));
            CONV(2, args.in[16] + (size_t)j * 768 * 3072, 768, 3072, 3072, args.in[15] + j * 768, WUQ(j)); CONV(0, args.in[17] + (size_t)j * DM * DM, DM, DM, DM, (const float*)nullptr, WO(2 + j)); }
#undef CONV
        for (int m = gw; m < SEQ; m += NGW) {
            const GAS f32x4* xr = (const GAS f32x4*)(x + (size_t)m * DM) + lane; GAS unsigned long long* o8 = (GAS unsigned long long*)(HB + (size_t)m * DM) + lane; float s = 0.f;
#pragma unroll
            for (int j = 0; j < 8; ++j) { const f32x4 v = xr[64 * j]; s += (v.x * v.x + v.y * v.y) + (v.z * v.z + v.w * v.w); o8[64 * j] = (unsigned long long)pk2(v.x, v.y) | ((unsigned long long)pk2(v.z, v.w) << 32); }
            s = wave_sum(s); if (lane < 32) ssq[(size_t)m * 32 + lane] = lane == 0 ? s : 0.f; }
        for (int idx = (int)blockIdx.x * 512 + tid; idx < SEQ * 32; idx += G * 512) {
            const int pos = idx >> 5, i = idx & 31;
            const float pw = (float)exp2((double)(2 * i) * (13.287712379549449 / 64.0)), inv = 1.0f / pw, ang = (float)pos * inv;
            const double a = (double)ang, q = rint(a * 0.6366197723675814), r = (a - q * 1.5707963267948966) - q * 6.123233995736766e-17, r2 = r * r;
            const double sn = r + r * r2 * (-1.0 / 6 + r2 * (1.0 / 120 + r2 * (-1.0 / 5040 + r2 * (1.0 / 362880 + r2 * (-1.0 / 39916800)))));
            const double cs = 1.0 + r2 * (-0.5 + r2 * (1.0 / 24 + r2 * (-1.0 / 720 + r2 * (1.0 / 40320 + r2 * (-1.0 / 3628800 + r2 * (1.0 / 479001600))))));
            const int qi = (int)q & 3; const double c_ = qi == 0 ? cs : qi == 1 ? -sn : qi == 2 ? -cs : sn, s_ = qi == 0 ? sn : qi == 1 ? cs : qi == 2 ? -sn : -cs;
            cos_t[idx] = (float)c_; sin_t[idx] = (float)s_; }
    }
    PH_END;

    for (int f = 0; f < 8; ++f) {
        const int l = f >> 1;
        if (PH_RUN) {
            pg8::Gemm g{(const pg8::bf16_t*)HB, (const pg8::bf16_t*)WGU(f), SEQ, f == 4 ? 2 * FF + 768 : 2 * FF, DM}; pg8::StaticOrder S; S.init(SEQ, g.N, G, (int)blockIdx.x);
            pg8::EpiUp E{(pg8::bf16_t*)HID, ssq, 44, (pg8::bf16_t*)CKV, ssq_ckv, (pg8::bf16_t*)KR, cos_t, sin_t};
            pg8::gemm_phase<pg8::EpiUp, pg8::StaticOrder, true, true>(ldsl + RING_OFF, g, S, E);
        }
        PH_END;
        if (PH_RUN) {
            pg8::Gemm g{(const pg8::bf16_t*)HID, (const pg8::bf16_t*)WD(f), SEQ, DM, FF}; pg8::StaticOrder S; S.init(SEQ, DM, G, (int)blockIdx.x);
            pg8::EpiRes E{f == 0 ? x : (const float*)out, out, (pg8::bf16_t*)HB, ssq, 0.5f};
            pg8::gemm_phase<pg8::EpiRes, pg8::StaticOrder, true, true>(ldsl + RING_OFF, g, S, E);
        }
        PH_END;
        if (f & 1) continue;
        if (l < 2) {
            if (PH_RUN) {
                pg8::Gemm g{(const pg8::bf16_t*)HB, (const pg8::bf16_t*)WQKV(l), SEQ, 6144, DM}; pg8::StaticOrder S; S.init(SEQ, 6144, G, (int)blockIdx.x);
                pg8::EpiQKV E{(pg8::bf16_t*)QB_, (size_t)(WS_K - WS_Q) / 2, ssq, kmean + (size_t)l * 32 * DM};
                pg8::gemm_phase<pg8::EpiQKV, pg8::StaticOrder, true, true>(ldsl + RING_OFF, g, S, E);
            }
            PH_END;
            if (PH_RUN) { const att::Shared GS{(const att::bf16*)KR, kmean + (size_t)l * 32 * DM};
                att::attn_phase<0>((char*)lds + RING_OFF, (const att::bf16*)QB_, (const att::bf16*)QR, (const att::bf16*)KB_, (const att::bf16*)VB_, (att::bf16*)OB, GS); }
            PH_END;
        } else {
            if (l == 2) {
                if (PH_RUN) {
                    pg8::Gemm g{(const pg8::bf16_t*)CKV, (const pg8::bf16_t*)WUKV, SEQ, 4096, 512}; pg8::StaticOrder S; S.init(SEQ, 4096, G, (int)blockIdx.x);
                    pg8::EpiUKV E{(pg8::bf16_t*)KB_, (pg8::bf16_t*)VB_, ssq_ckv};
                    pg8::gemm_phase<pg8::EpiUKV, pg8::StaticOrder, true, true>(ldsl + RING_OFF, g, S, E);
                }
                PH_END;
            }
            if (PH_RUN) {
                pg8::Gemm g{(const pg8::bf16_t*)HB, (const pg8::bf16_t*)WDQ(l - 2), SEQ, 768, DM}; pg8::StaticOrder S; S.init(SEQ, 768, G, (int)blockIdx.x);
                pg8::EpiScaled E{(pg8::bf16_t*)CQ, 768, ssq, ssq_cq};
                pg8::gemm_phase<pg8::EpiScaled, pg8::StaticOrder, true, true>(ldsl + RING_OFF, g, S, E);
            }
            PH_END;
            if (PH_RUN) {
                pg8::Gemm g{(const pg8::bf16_t*)CQ, (const pg8::bf16_t*)WUQ(l - 2), SEQ, 3072, 768}; pg8::StaticOrder S; S.init(SEQ, 3072, G, (int)blockIdx.x);
                pg8::EpiUQ E{(pg8::bf16_t*)QB_, (pg8::bf16_t*)QR, ssq_cq, cos_t, sin_t};
                pg8::gemm_phase<pg8::EpiUQ, pg8::StaticOrder, true, true>(ldsl + RING_OFF, g, S, E);
            }
            PH_END;
            if (PH_RUN) { const att::Shared GS{(const att::bf16*)KR, kmean};
                att::attn_phase<1>((char*)lds + RING_OFF, (const att::bf16*)QB_, (const att::bf16*)QR, (const att::bf16*)KB_, (const att::bf16*)VB_, (att::bf16*)OB, GS); }
            PH_END;
        }
        if (PH_RUN) {
            pg8::Gemm g{(const pg8::bf16_t*)OB, (const pg8::bf16_t*)WO(l), SEQ, DM, DM}; pg8::StaticOrder S; S.init(SEQ, DM, G, (int)blockIdx.x);
            pg8::EpiRes E{(const float*)out, out, (pg8::bf16_t*)HB, ssq, 1.0f};
            pg8::gemm_phase<pg8::EpiRes, pg8::StaticOrder, true, true>(ldsl + RING_OFF, g, S, E);
        }
        PH_END;
    }
    if (PH_RUN) {
        const bool bad = xb_ld((unsigned*)(ctl + CW_BAR) + XB_TMO) != 0u; const float poison = bad ? __builtin_nanf("") : 1.0f;
        int t2 = threadIdx.x; asm volatile("" : "+v"(t2)); const int ln = t2 & 63;
        const GAS f32x4* fn = (const GAS f32x4*)args.in[18] + ln;
        for (int m = gw; m < SEQ; m += NGW) { const float rs = pg8::row_rstd<8>(ssq, m, 1.0f / 2048.0f) * poison; GAS f32x4* o = (GAS f32x4*)(out + (size_t)m * DM) + ln;
#pragma unroll
            for (int j = 0; j < 8; ++j) { const f32x4 v = o[64 * j], gn = fn[64 * j]; o[64 * j] = v * rs * gn; } }
    }
#undef PH_RUN
#undef PH_END
}

extern "C" void kernel_launch(void* const* d_in, const int* in_sizes, int n_in, void* d_out, int out_size, void* d_ws, size_t ws_size, hipStream_t stream) {
    static int grid = 0;
    if (grid == 0) {
        if (n_in != 19 || in_sizes[0] != SEQ * DM || out_size != SEQ * DM || ws_size < WS_END) { fprintf(stderr, "kernel_launch: unexpected shapes (n_in %d, in0 %d, out %d, ws %zu)\n", n_in, n_in > 0 ? in_sizes[0] : -1, out_size, ws_size); grid = -1; return; }
        int dev = 0, cus = 0, per_cu = 0;
        if (hipGetDevice(&dev) != hipSuccess || hipDeviceGetAttribute(&cus, hipDeviceAttributeMultiprocessorCount, dev) != hipSuccess) { grid = -1; return; }
        if (hipFuncSetAttribute((const void*)yoco_fwd, hipFuncAttributeMaxDynamicSharedMemorySize, LDS_BYTES) != hipSuccess) { fprintf(stderr, "kernel_launch: hipFuncSetAttribute failed\n"); grid = -1; return; }
        if (hipOccupancyMaxActiveBlocksPerMultiprocessor(&per_cu, (const void*)yoco_fwd, NWAVES * 64, LDS_BYTES) != hipSuccess || per_cu < 1) { fprintf(stderr, "kernel_launch: occupancy query reports %d workgroups per CU\n", per_cu); per_cu = 1; }
        (void)hipGetLastError();
        grid = cus;
    }
    if (grid < 0) return;
    if (hipMemsetAsync((char*)d_ws + WS_CTL, 0, ZERO_BYTES, stream) != hipSuccess) return;
    Args a{};
    for (int i = 0; i < 19; ++i) a.in[i] = (const float*)d_in[i];
    a.out = (float*)d_out; a.ws = (unsigned char*)d_ws;
#if MK_MULTI
    for (int k = 0; k < NPHASES; ++k) { a.ph_lo = k; a.ph_hi = k + 1; hipLaunchKernelGGL(yoco_fwd, dim3(grid), dim3(NWAVES * 64), LDS_BYTES, stream, a); }
#else
    a.ph_lo = 0; a.ph_hi = NPHASES;
    hipLaunchKernelGGL(yoco_fwd, dim3(grid), dim3(NWAVES * 64), LDS_BYTES, stream, a);
#endif
    const hipError_t le = hipPeekAtLastError();
    if (le != hipSuccess) fprintf(stderr, "kernel_launch: launch failed: %s\n", hipGetErrorName(le));
}
```

```cpp
#include <hip/hip_runtime.h>
#include <hip/hip_bf16.h>
#include <cstdio>
#include <cstdint>
namespace pg8 {
#define PG8_LAS __attribute__((address_space(3)))
typedef unsigned short bf16_t;
typedef short bf16x8 __attribute__((ext_vector_type(8)));
typedef float f32x4 __attribute__((ext_vector_type(4)));
typedef unsigned u32x4 __attribute__((ext_vector_type(4)));
typedef int i32x4 __attribute__((ext_vector_type(4)));
constexpr int BM = 256, BK = 64, HALF = 128, HTB = HALF * BK * 2  , STAGE_BYTES = 8 * HTB, NXCD = 8, WGM = 8;

__host__ __device__ __forceinline__ int lds_byte(int r, int c) { const int st = (r >> 4) * 2 + (c >> 5), rr = r & 15, cc = c & 31, ob = rr * 64 + cc * 2; return st * 1024 + (ob ^ (((ob >> 9) & 1) << 5)); }
__host__ __device__ __forceinline__ void stage_rc(int b, int& R, int& C) { const int st = b / 1024, sb = b % 1024, swz = sb ^ (((sb >> 9) & 1) << 5); R = (st >> 1) * 16 + swz / 64; C = (st & 1) * 32 + (swz % 64) / 2; }
__host__ __device__ __forceinline__ int perm32(int rho) { const int n = rho >> 4, i = rho & 15; return 8 * (i >> 2) + 4 * n + (i & 3); }

struct Unit { int pm, pn; };
struct Gemm { const bf16_t* A; const bf16_t* Bt; int M, N, K; };

struct StaticOrder {
    int nM, nN, nwg, G, c;
    __host__ __device__ void init(int M, int N, int G_, int c_) { nM = M / BM; nN = N / BM; nwg = nM * nN; G = G_; c = c_; }
    __host__ __device__ __forceinline__ bool next(int i, Unit& u) const {
        const long L = (long)i * G + c; if (L >= nwg) return false;
        int wgid = (int)L; { const int q = nwg / NXCD, r = nwg % NXCD, xcd = wgid % NXCD, off = wgid / NXCD; wgid = (xcd < r ? xcd * (q + 1) : r * (q + 1) + (xcd - r) * q) + off; }
        const int nig = WGM * nN, gid = wgid / nig, fm = gid * WGM, gsz = (nM - fm) < WGM ? (nM - fm) : WGM;
        u.pm = fm + ((wgid % nig) % gsz); u.pn = (wgid % nig) / gsz; return true;
    }
    __device__ __forceinline__ void a_ready(const Unit&) const {}
    __device__ __forceinline__ void done(const Unit&) const {}
};

__device__ __forceinline__ unsigned cvt_pk_bf16(float lo, float hi) { unsigned r; asm volatile("v_cvt_pk_bf16_f32 %0, %1, %2" : "=v"(r) : "v"(lo), "v"(hi)); return r; }
__device__ __forceinline__ unsigned cvt_pk_bf16_nv(float lo, float hi) { unsigned r; asm("v_cvt_pk_bf16_f32 %0, %1, %2" : "=v"(r) : "v"(lo), "v"(hi)); return r; }
__device__ __forceinline__ float smul(float a, float b) { float r; asm("v_mul_f32 %0, %1, %2" : "=v"(r) : "v"(a), "v"(b)); return r; }
__device__ __forceinline__ void smul4t(float (&r)[4], const float (&a)[4], const float (&t)[4]) {
    asm("s_nop 0\n\tv_mul_f32 %0, %4, %8\n\tv_mul_f32 %1, %5, %9\n\tv_mul_f32 %2, %6, %10\n\tv_mul_f32 %3, %7, %11"
        : "=&v"(r[0]), "=&v"(r[1]), "=&v"(r[2]), "=&v"(r[3]) : "v"(a[0]), "v"(a[1]), "v"(a[2]), "v"(a[3]), "v"(t[0]), "v"(t[1]), "v"(t[2]), "v"(t[3]));
}
__device__ __forceinline__ f32x4 smul4(f32x4 v, float r) { return (f32x4){smul(v[0], r), smul(v[1], r), smul(v[2], r), smul(v[3], r)}; }
typedef float f32x2 __attribute__((ext_vector_type(2)));
constexpr int SSQ_STRIDE = 32;
constexpr float RMS_EPS = 1e-6f;
__device__ __forceinline__ u32x4 pack8f(f32x4 a, f32x4 b) { u32x4 w; w.x = cvt_pk_bf16(a[0], a[1]); w.y = cvt_pk_bf16(a[2], a[3]); w.z = cvt_pk_bf16(b[0], b[1]); w.w = cvt_pk_bf16(b[2], b[3]); return w; }
template <int NP4> __device__ __forceinline__ float row_rstd(const float* ssq, int row, float inv_dim) {
    const f32x4* p = (const f32x4*)(ssq + (size_t)row * SSQ_STRIDE); float s = 0.f;
#pragma unroll
    for (int j = 0; j < NP4; ++j) { const f32x4 v = p[j]; s += (v[0] + v[1]) + (v[2] + v[3]); }
    return 1.0f / sqrtf(s * inv_dim + RMS_EPS);
}
template <int NP4> __device__ __forceinline__ void lane_rstd(float (&rs)[2][4], const float* ssq, int row0w, int fr, int fq, float inv_dim) {
    const float mine0 = row_rstd<NP4>(ssq, row0w + 16 * fq + fr, inv_dim), mine1 = row_rstd<NP4>(ssq, row0w + HALF + 16 * fq + fr, inv_dim);
#pragma unroll
    for (int m = 0; m < 4; ++m) { rs[0][m] = __shfl(mine0, fr + 16 * m); rs[1][m] = __shfl(mine1, fr + 16 * m); }
    asm volatile("" ::: "memory");
}
__device__ __forceinline__ void lane_rstd_tab(float (&rs)[2][4], const PG8_LAS float* tab, int rloc  ) {
#pragma unroll
    for (int ai = 0; ai < 2; ++ai)
#pragma unroll
        for (int m = 0; m < 4; ++m) rs[ai][m] = tab[rloc + ai * HALF + m * 16];
}
__device__ __forceinline__ float sumsq4(f32x4 v) { return (v[0] * v[0] + v[1] * v[1]) + (v[2] * v[2] + v[3] * v[3]); }
__device__ __forceinline__ float silu_mul(float g, float u) { return g * u * __builtin_amdgcn_rcpf(1.0f + __builtin_amdgcn_exp2f(-1.4426950408889634f * g)); }

__device__ __forceinline__ void store_scaled_tile(const f32x4 (&acc)[2][2][4][2], const float (&rs)[2][4], bf16_t* out, int ldo, int row0, int ocol0, float* ssq_out, int slot, int fq) {
#pragma unroll
    for (int ai = 0; ai < 2; ++ai)
#pragma unroll
        for (int m = 0; m < 4; ++m) { const int row = row0 + ai * HALF + m * 16; const float r = rs[ai][m]; float s = 0.f;
#pragma unroll
            for (int bj = 0; bj < 2; ++bj) { const f32x4 v0 = smul4(acc[ai][bj][m][0], r), v1 = smul4(acc[ai][bj][m][1], r); s += sumsq4(v0) + sumsq4(v1);
                *(u32x4*)(out + (size_t)row * ldo + ocol0 + bj * HALF) = pack8f(v0, v1); }
            if (ssq_out) { s += __shfl_xor(s, 16); s += __shfl_xor(s, 32); if (fq == 0) ssq_out[(size_t)row * SSQ_STRIDE + slot] = s; }
            asm volatile("" ::: "memory"); }
}

struct EpiUp {
    static constexpr bool PERM = true, AFTER_DRAIN = false, HAS_INIT = false, I8 = true;
    bf16_t* hid; const PG8_LAS float* rtab; int n_ffn;
    bf16_t* ckv; float* ssq_ckv; bf16_t* kr; const float* cos_t; const float* sin_t; const PG8_LAS float* wtab; int pn0;
    __device__ __forceinline__ void operator()(f32x4 (&acc)[2][2][4][2], const Unit& u, int wr, int wc, int fr, int fq) const {
        const int row0 = u.pm * BM + wr * 64 + fr; float rs[2][4]; lane_rstd_tab(rs, rtab, (u.pm & 7) * BM + wr * 64 + fr);
#pragma unroll
        for (int bj = 0; bj < 2; ++bj)
#pragma unroll
            for (int n = 0; n < 2; ++n) { const f32x4 wf = *(const PG8_LAS f32x4*)(wtab + ((u.pn - pn0) >> 2) * BM + bj * HALF + wc * 32 + 8 * fq + 4 * n);
#pragma unroll
                for (int ai = 0; ai < 2; ++ai)
#pragma unroll
                    for (int m = 0; m < 4; ++m) { const i32x4 iv = __builtin_bit_cast(i32x4, acc[ai][bj][m][n]); acc[ai][bj][m][n] = (f32x4){smul((float)iv.x, wf[0]), smul((float)iv.y, wf[1]), smul((float)iv.z, wf[2]), smul((float)iv.w, wf[3])}; } }
        if (u.pn < n_ffn) {
            const int col0 = u.pn * HALF + wc * 32 + 8 * fq;
#pragma unroll
            for (int ai = 0; ai < 2; ++ai)
#pragma unroll
                for (int m = 0; m < 4; ++m) { const float r = rs[ai][m], rn = r * -1.4426950408889634f, r2 = r * r;
                    f32x4 h[2];
#pragma unroll
                    for (int n = 0; n < 2; ++n) {
                        const f32x4 xg = acc[ai][0][m][n], xu = acc[ai][1][m][n]; float e[4], rc[4];
#pragma unroll
                        for (int k = 0; k < 4; ++k) e[k] = __builtin_amdgcn_exp2f(smul(xg[k], rn));
#pragma unroll
                        for (int k = 0; k < 4; ++k) rc[k] = __builtin_amdgcn_rcpf(e[k] + 1.0f);
                        float p2[4], hh[4];
#pragma unroll
                        for (int k = 0; k < 4; ++k) p2[k] = smul(smul(xg[k], xu[k]), r2);
                        smul4t(hh, p2, rc);
#pragma unroll
                        for (int k = 0; k < 4; ++k) h[n][k] = hh[k];
                    }
                    u32x4 w; w.x = cvt_pk_bf16_nv(h[0][0], h[0][1]); w.y = cvt_pk_bf16_nv(h[0][2], h[0][3]); w.z = cvt_pk_bf16_nv(h[1][0], h[1][1]); w.w = cvt_pk_bf16_nv(h[1][2], h[1][3]);
                    *(u32x4*)(hid + (size_t)(row0 + ai * HALF + m * 16) * 5632 + col0) = w; asm volatile("" ::: "memory"); __builtin_amdgcn_sched_barrier(0); }
        } else if (u.pn < n_ffn + 2) {
            const int t = u.pn - n_ffn;
            store_scaled_tile(acc, rs, ckv, 512, row0, t * BM + wc * 32 + 8 * fq, ssq_ckv, t * 4 + wc, fq);
        } else if (wc == 0) {
#pragma unroll
            for (int ai = 0; ai < 2; ++ai)
#pragma unroll
                for (int m = 0; m < 4; ++m) { const int row = row0 + ai * HALF + m * 16; const float r = rs[ai][m];
                    const f32x4 c0 = *(const f32x4*)(cos_t + (size_t)row * 32 + 8 * fq), c1 = *(const f32x4*)(cos_t + (size_t)row * 32 + 8 * fq + 4);
                    const f32x4 s0 = *(const f32x4*)(sin_t + (size_t)row * 32 + 8 * fq), s1 = *(const f32x4*)(sin_t + (size_t)row * 32 + 8 * fq + 4);
                    const f32x4 a0 = acc[ai][0][m][0] * r, a1 = acc[ai][0][m][1] * r, b0 = acc[ai][1][m][0] * r, b1 = acc[ai][1][m][1] * r;
                    *(u32x4*)(kr + (size_t)row * 64 + 8 * fq) = pack8f(a0 * c0 - b0 * s0, a1 * c1 - b1 * s1);
                    *(u32x4*)(kr + (size_t)row * 64 + 32 + 8 * fq) = pack8f(a0 * s0 + b0 * c0, a1 * s1 + b1 * c1); asm volatile("" ::: "memory"); }
        }
    }
};
template <int HALF_STEP, bool FIN = false> struct EpiResT {
    static constexpr bool PERM = true, AFTER_DRAIN = false, HAS_INIT = true, I8 = false;
    static constexpr float alpha = HALF_STEP ? 0.5f : 1.0f, inv_alpha = HALF_STEP ? 2.0f : 1.0f;
    static __device__ __forceinline__ f32x4 sa(f32x4 v) { if constexpr (HALF_STEP) return (f32x4){__builtin_ldexpf(v[0], -1), __builtin_ldexpf(v[1], -1), __builtin_ldexpf(v[2], -1), __builtin_ldexpf(v[3], -1)}; else return v; }
    static __device__ __forceinline__ f32x4 si(f32x4 v) { if constexpr (HALF_STEP) return (f32x4){__builtin_ldexpf(v[0], 1), __builtin_ldexpf(v[1], 1), __builtin_ldexpf(v[2], 1), __builtin_ldexpf(v[3], 1)}; else return v; }
    unsigned char* wsb;
    PG8_LAS float* sm;
    float* out; const float* gain;
    unsigned target;
    static constexpr long QF_MiB = 1l << 20, QF_HB = 8 * QF_MiB, QF_SSQ = 2 * QF_MiB, QF_AMX = 1073 * QF_MiB, QF_ASC = 1072 * QF_MiB, QF_AQ = 1056 * QF_MiB  , QF_PCNT = 8448, QF_TMO = 4096 + 128  ;
    __device__ __forceinline__ void init(f32x4 (&acc)[2][2][4][2], const Unit& u, int wr, int wc, int fr, int fq) const {
        const int row0 = u.pm * BM + wr * 64 + fr, col0 = u.pn * BM + wc * 32 + 8 * fq;
#pragma unroll
        for (int ai = 0; ai < 2; ++ai)
#pragma unroll
            for (int m = 0; m < 4; ++m)
#pragma unroll
                for (int bj = 0; bj < 2; ++bj) { const u32x4 rb = *(const u32x4*)((const bf16_t*)(wsb + QF_HB) + (size_t)(row0 + ai * HALF + m * 16) * 2048 + col0 + bj * HALF);
                    acc[ai][bj][m][0] = si((f32x4){__uint_as_float(rb.x << 16), __uint_as_float(rb.x & 0xffff0000u), __uint_as_float(rb.y << 16), __uint_as_float(rb.y & 0xffff0000u)});
                    acc[ai][bj][m][1] = si((f32x4){__uint_as_float(rb.z << 16), __uint_as_float(rb.z & 0xffff0000u), __uint_as_float(rb.w << 16), __uint_as_float(rb.w & 0xffff0000u)}); }
    }
    static __device__ __forceinline__ float absmax8(u32x4 w) {
        float a = fmaxf(fabsf(__uint_as_float(w.x << 16)), fabsf(__uint_as_float(w.x & 0xffff0000u)));
        a = fmaxf(a, fmaxf(fabsf(__uint_as_float(w.y << 16)), fabsf(__uint_as_float(w.y & 0xffff0000u))));
        a = fmaxf(a, fmaxf(fabsf(__uint_as_float(w.z << 16)), fabsf(__uint_as_float(w.z & 0xffff0000u))));
        return fmaxf(a, fmaxf(fabsf(__uint_as_float(w.w << 16)), fabsf(__uint_as_float(w.w & 0xffff0000u))));
    }
    static __device__ __forceinline__ unsigned q2(unsigned u, float sc) {
        const int a0 = (int)__builtin_rintf(__uint_as_float(u << 16) * sc), a1 = (int)__builtin_rintf(__uint_as_float(u & 0xffff0000u) * sc);
        return ((unsigned)a0 & 0xffu) | (((unsigned)a1 & 0xffu) << 8);
    }
    __device__ __forceinline__ void operator()(const f32x4 (&acc)[2][2][4][2], const Unit& u, int wr, int wc, int fr, int fq) const {
        const int row0 = u.pm * BM + wr * 64 + fr, col0 = u.pn * BM + wc * 32 + 8 * fq;
        const bool fuse = target != 0u; constexpr bool last = FIN;
        bf16_t* hb = (bf16_t*)(wsb + QF_HB); float* ssq = (float*)(wsb + QF_SSQ);
#pragma unroll
        for (int ai = 0; ai < 2; ++ai)
#pragma unroll
            for (int m = 0; m < 4; ++m) { const int row = row0 + ai * HALF + m * 16; float s = 0.f, mxa = 0.f;
#pragma unroll
                for (int bj = 0; bj < 2; ++bj) { const f32x4 v0 = sa(acc[ai][bj][m][0]), v1 = sa(acc[ai][bj][m][1]); s += sumsq4(v0) + sumsq4(v1);
                    const u32x4 w = pack8f(v0, v1); mxa = fmaxf(mxa, absmax8(w));
                    if (!last) *(u32x4*)(hb + (size_t)row * 2048 + col0 + bj * HALF) = w; }
                s += __shfl_xor(s, 16); s += __shfl_xor(s, 32); if (fq == 0) ssq[(size_t)row * SSQ_STRIDE + u.pn * 4 + wc] = s;
                if (fuse) { mxa = fmaxf(mxa, __shfl_xor(mxa, 16)); mxa = fmaxf(mxa, __shfl_xor(mxa, 32));
                    if (fq == 0) sm[wc * BM + wr * 64 + ai * HALF + m * 16 + fr] = last ? s : mxa; } }
        if (!fuse) return;
        __syncthreads();
        int tq = threadIdx.x; asm volatile("" : "+v"(tq));
        float* amx = (float*)(wsb + QF_AMX);
        unsigned* tmo = (unsigned*)wsb + QF_TMO;
        if (tq < 64) {
            f32x4 a = *(const PG8_LAS f32x4*)(sm + 4 * tq);
#pragma unroll
            for (int w = 1; w < 4; ++w) { const f32x4 v = *(const PG8_LAS f32x4*)(sm + w * BM + 4 * tq);
                if constexpr (last) a = a + v; else { a[0] = fmaxf(a[0], v[0]); a[1] = fmaxf(a[1], v[1]); a[2] = fmaxf(a[2], v[2]); a[3] = fmaxf(a[3], v[3]); } }
            float* dst = amx + (size_t)(u.pm * 8 + u.pn) * BM + 4 * tq;
            asm volatile("global_store_dwordx4 %0, %1, off sc1\n\ts_nop 1" :: "v"(dst), "v"(a) : "memory");
            asm volatile("s_waitcnt vmcnt(0)" ::: "memory");
            if (tq == 0) { unsigned* pc = (unsigned*)wsb + QF_PCNT + u.pm * 16;
                (void)__hip_atomic_fetch_add(pc, 1u, __ATOMIC_RELAXED, __HIP_MEMORY_SCOPE_AGENT);
                unsigned sp = 0u;
                while (__hip_atomic_load(pc, __ATOMIC_RELAXED, __HIP_MEMORY_SCOPE_AGENT) < target) { __builtin_amdgcn_s_sleep(1);
                    if ((++sp & 255u) == 0u) { if (__hip_atomic_load(tmo, __ATOMIC_RELAXED, __HIP_MEMORY_SCOPE_AGENT)) break; if (sp > (1u << 18)) { atomicAdd(tmo, 1u); break; } } }
                __builtin_amdgcn_fence(__ATOMIC_ACQUIRE, "agent");
                asm volatile("s_waitcnt vmcnt(0)" ::: "memory"); } }
        __syncthreads();
        { const f32x4 v = *(const f32x4*)(amx + (size_t)(u.pm * 8 + (tq >> 6)) * BM + 4 * (tq & 63)); *(PG8_LAS f32x4*)(sm + (tq >> 6) * BM + 4 * (tq & 63)) = v; }
        __syncthreads();
        if (tq < BM) { float a = sm[tq];
#pragma unroll
            for (int t = 1; t < 8; ++t) { if constexpr (last) a += sm[t * BM + tq]; else a = fmaxf(a, sm[t * BM + tq]); }
            if constexpr (last) { a = 1.0f / sqrtf(a * (1.0f / 2048.0f) + RMS_EPS);
                if (__hip_atomic_load(tmo, __ATOMIC_RELAXED, __HIP_MEMORY_SCOPE_AGENT) != 0u) a = __builtin_nanf(""); }
            else if (u.pn == 0) ((float*)(wsb + QF_ASC))[u.pm * BM + tq] = a * (1.0f / 127.0f);
            sm[8 * BM + tq] = a; }
        __syncthreads();
        if (!last) {
            signed char* aq = (signed char*)(wsb + QF_AQ);
#pragma unroll
            for (int ai = 0; ai < 2; ++ai)
#pragma unroll
                for (int m = 0; m < 4; ++m) { const int row = row0 + ai * HALF + m * 16; const float rm = sm[8 * BM + wr * 64 + ai * HALF + m * 16 + fr], sc = rm > 0.f ? 127.0f / rm : 0.f;
                    unsigned d[2][2];
#pragma unroll
                    for (int bj = 0; bj < 2; ++bj) { const u32x4 w = pack8f(sa(acc[ai][bj][m][0]), sa(acc[ai][bj][m][1])); d[bj][0] = q2(w.x, sc) | (q2(w.y, sc) << 16); d[bj][1] = q2(w.z, sc) | (q2(w.w, sc) << 16); }
                    const bool odd = (fq & 1) != 0;
                    const unsigned r0 = (unsigned)__builtin_amdgcn_ds_swizzle((int)(odd ? d[0][0] : d[1][0]), 0x401F), r1 = (unsigned)__builtin_amdgcn_ds_swizzle((int)(odd ? d[0][1] : d[1][1]), 0x401F);
                    const u32x4 o4 = odd ? (u32x4){r0, r1, d[1][0], d[1][1]} : (u32x4){d[0][0], d[0][1], r0, r1};
                    *(u32x4*)(aq + (size_t)row * 2048 + (odd ? col0 - 8 + HALF : col0)) = o4; }
        } else {
#pragma unroll
            for (int bj = 0; bj < 2; ++bj) { const f32x4 g0 = *(const f32x4*)(gain + col0 + bj * HALF), g1 = *(const f32x4*)(gain + col0 + bj * HALF + 4);
#pragma unroll
                for (int ai = 0; ai < 2; ++ai)
#pragma unroll
                    for (int m = 0; m < 4; ++m) { const int row = row0 + ai * HALF + m * 16; const float rs = sm[8 * BM + wr * 64 + ai * HALF + m * 16 + fr] * alpha;
                        float* o = out + (size_t)row * 2048 + col0 + bj * HALF;
                        const f32x4 a0 = smul4(acc[ai][bj][m][0], rs), a1 = smul4(acc[ai][bj][m][1], rs);
                        __builtin_nontemporal_store((f32x4){smul(a0[0], g0[0]), smul(a0[1], g0[1]), smul(a0[2], g0[2]), smul(a0[3], g0[3])}, (f32x4*)o); __builtin_nontemporal_store((f32x4){smul(a1[0], g1[0]), smul(a1[1], g1[1]), smul(a1[2], g1[2]), smul(a1[3], g1[3])}, (f32x4*)(o + 4)); asm volatile("" ::: "memory"); } }
        }
    }
};
typedef EpiResT<1> EpiRes;
struct EpiQKV {
    static constexpr bool PERM = true, AFTER_DRAIN = false, HAS_INIT = false, I8 = true;
    bf16_t* qkv; size_t tstride; const PG8_LAS float* rtab; float* kmean; const PG8_LAS float* wtab; int pn0;
    __device__ __forceinline__ void operator()(f32x4 (&acc)[2][2][4][2], const Unit& u, int wr, int wc, int fr, int fq) const {
        const int row0 = u.pm * BM + wr * 64 + fr; float rs[2][4]; lane_rstd_tab(rs, rtab, (u.pm & 7) * BM + wr * 64 + fr);
#pragma unroll
        for (int bj = 0; bj < 2; ++bj)
#pragma unroll
            for (int n = 0; n < 2; ++n) { const f32x4 wf = *(const PG8_LAS f32x4*)(wtab + ((u.pn - pn0) >> 2) * BM + bj * HALF + wc * 32 + 8 * fq + 4 * n);
#pragma unroll
                for (int ai = 0; ai < 2; ++ai)
#pragma unroll
                    for (int m = 0; m < 4; ++m) { const i32x4 iv = __builtin_bit_cast(i32x4, acc[ai][bj][m][n]); acc[ai][bj][m][n] = (f32x4){smul((float)iv.x, wf[0]), smul((float)iv.y, wf[1]), smul((float)iv.z, wf[2]), smul((float)iv.w, wf[3])}; } }
        const int t = u.pn >> 3, ocol0 = (u.pn & 7) * BM + wc * 32 + 8 * fq; bf16_t* dst = qkv + (size_t)t * tstride;
        store_scaled_tile(acc, rs, dst, 2048, row0, ocol0, nullptr, 0, fq);
        if (t == 1) {
#pragma unroll
            for (int bj = 0; bj < 2; ++bj)
#pragma unroll
                for (int n = 0; n < 2; ++n)
#pragma unroll
                    for (int e = 0; e < 4; ++e) { float s = 0.f;
#pragma unroll
                        for (int ai = 0; ai < 2; ++ai)
#pragma unroll
                            for (int m = 0; m < 4; ++m) s += acc[ai][bj][m][n][e] * rs[ai][m];
                        s += __shfl_xor(s, 1); s += __shfl_xor(s, 2); s += __shfl_xor(s, 4); s += __shfl_xor(s, 8);
                        if (fr == 0) __hip_atomic_fetch_add(kmean + (size_t)u.pm * 2048 + ocol0 + bj * HALF + 4 * n + e, s, __ATOMIC_RELAXED, __HIP_MEMORY_SCOPE_AGENT); }
        }
    }
};
struct EpiScaled {
    static constexpr bool PERM = true, AFTER_DRAIN = false, HAS_INIT = false, I8 = false;
    bf16_t* out; int ldo; const PG8_LAS float* rtab; float* ssq_out;
    __device__ __forceinline__ void operator()(const f32x4 (&acc)[2][2][4][2], const Unit& u, int wr, int wc, int fr, int fq) const {
        const int row0 = u.pm * BM + wr * 64 + fr; float rs[2][4]; lane_rstd_tab(rs, rtab, (u.pm & 7) * BM + wr * 64 + fr);
        store_scaled_tile(acc, rs, out, ldo, row0, u.pn * BM + wc * 32 + 8 * fq, ssq_out, u.pn * 4 + wc, fq);
    }
};
struct EpiUQ {
    static constexpr bool PERM = true, AFTER_DRAIN = false, HAS_INIT = false, I8 = false;
    bf16_t* qn; bf16_t* qr; const float* ssq_cq; const float* cos_t; const float* sin_t;
    __device__ __forceinline__ void operator()(const f32x4 (&acc)[2][2][4][2], const Unit& u, int wr, int wc, int fr, int fq) const {
        const int row0 = u.pm * BM + wr * 64 + fr; float rs[2][4]; lane_rstd<3>(rs, ssq_cq, row0 - fr, fr, fq, 1.0f / 768.0f);
        if (u.pn < 8) { store_scaled_tile(acc, rs, qn, 2048, row0, u.pn * BM + wc * 32 + 8 * fq, nullptr, 0, fq); }
        else { const int head = (u.pn - 8) * 4 + wc;
#pragma unroll
            for (int ai = 0; ai < 2; ++ai)
#pragma unroll
                for (int m = 0; m < 4; ++m) { const int row = row0 + ai * HALF + m * 16; const float r = rs[ai][m];
                    const f32x4 c0 = *(const f32x4*)(cos_t + (size_t)row * 32 + 8 * fq), c1 = *(const f32x4*)(cos_t + (size_t)row * 32 + 8 * fq + 4);
                    const f32x4 s0 = *(const f32x4*)(sin_t + (size_t)row * 32 + 8 * fq), s1 = *(const f32x4*)(sin_t + (size_t)row * 32 + 8 * fq + 4);
                    const f32x4 a0 = acc[ai][0][m][0] * r, a1 = acc[ai][0][m][1] * r, b0 = acc[ai][1][m][0] * r, b1 = acc[ai][1][m][1] * r;
                    *(u32x4*)(qr + (size_t)row * 1024 + head * 64 + 8 * fq) = pack8f(a0 * c0 - b0 * s0, a1 * c1 - b1 * s1);
                    *(u32x4*)(qr + (size_t)row * 1024 + head * 64 + 32 + 8 * fq) = pack8f(a0 * s0 + b0 * c0, a1 * s1 + b1 * c1); asm volatile("" ::: "memory"); } }
    }
};
struct EpiNull { static constexpr bool PERM = true, AFTER_DRAIN = false, HAS_INIT = false, I8 = false;
    __device__ __forceinline__ void operator()(const f32x4 (&acc)[2][2][4][2], const Unit&, int, int, int, int) const {
#pragma unroll
        for (int a = 0; a < 2; ++a)
#pragma unroll
            for (int b = 0; b < 2; ++b)
#pragma unroll
                for (int m = 0; m < 4; ++m)
#pragma unroll
                    for (int n = 0; n < 2; ++n) asm volatile("" :: "v"(acc[a][b][m][n])); } };
struct EpiUKV {
    static constexpr bool PERM = true, AFTER_DRAIN = false, HAS_INIT = false, I8 = false;
    bf16_t* kn; bf16_t* v; const float* ssq_ckv;
    __device__ __forceinline__ void operator()(const f32x4 (&acc)[2][2][4][2], const Unit& u, int wr, int wc, int fr, int fq) const {
        const int row0 = u.pm * BM + wr * 64 + fr; float rs[2][4]; lane_rstd<2>(rs, ssq_ckv, row0 - fr, fr, fq, 1.0f / 512.0f);
        const int ocol = u.pn * HALF + wc * 32 + 8 * fq;
#pragma unroll
        for (int ai = 0; ai < 2; ++ai)
#pragma unroll
            for (int m = 0; m < 4; ++m) { const size_t off = (size_t)(row0 + ai * HALF + m * 16) * 2048 + ocol; const float r = rs[ai][m];
                *(u32x4*)(kn + off) = pack8f(acc[ai][0][m][0] * r, acc[ai][0][m][1] * r); *(u32x4*)(v + off) = pack8f(acc[ai][1][m][0] * r, acc[ai][1][m][1] * r); }
    }
};

template <class Epi, class Sched, bool ALIGN_EPI = false, bool SP2 = false>
__device__ __forceinline__ void gemm_phase(PG8_LAS unsigned char* lds, const Gemm g, const Sched& S, const Epi& E) {
    int tid_ = threadIdx.x; asm volatile("" : "+v"(tid_));
    const int tid = tid_, wid = __builtin_amdgcn_readfirstlane(tid >> 6), lane = tid & 63, wr = wid >> 2, wc = wid & 3, fr = lane & 15, fq = lane >> 4;
    const int K = g.K, nt = K / BK;
    unsigned voffA[2], voffB[2];
#pragma unroll
    for (int i = 0; i < 2; ++i) { int R, C; stage_rc(tid * 16 + i * 8192, R, C); const int Rb = Epi::PERM ? ((R & ~31) + perm32(R & 31)) : R;
        voffA[i] = (unsigned)(R * K + C) * 2u; voffB[i] = (unsigned)(Rb * K + C) * 2u; }
    const size_t kstep = (size_t)(BK * 2);
    const size_t hstep = (size_t)HALF * K * 2;
    const size_t tstep = 2 * hstep;
    const unsigned ldsw = (unsigned)wid * 1024u;
    const int aoff = lds_byte(wr * 64 + fr, fq * 8), boff = lds_byte(wc * 32 + fr, fq * 8);
#define PG8_SA(b, h) (((b) * 2 + (h)) * HTB)
#define PG8_SB(b, h) ((4 + (b) * 2 + (h)) * HTB)
#define PG8_STAGE(bufoff, gbase, voff) do { _Pragma("unroll") for (int _i = 0; _i < 2; ++_i) \
        __builtin_amdgcn_global_load_lds((const unsigned*)((const char*)(gbase) + (voff)[_i]), (PG8_LAS unsigned*)(lds + (bufoff) + ldsw + _i * 8192), 16, 0, 0); } while (0)
#define PG8_LDA(dst, b, h) do { _Pragma("unroll") for (int m = 0; m < 4; ++m) _Pragma("unroll") for (int k = 0; k < 2; ++k) dst[m][k] = *(const PG8_LAS bf16x8*)(lds + PG8_SA(b, h) + aoff + m * 2048 + k * 1024); } while (0)
#define PG8_LDB(dst, b, h) do { _Pragma("unroll") for (int n = 0; n < 2; ++n) _Pragma("unroll") for (int k = 0; k < 2; ++k) dst[n][k] = *(const PG8_LAS bf16x8*)(lds + PG8_SB(b, h) + boff + n * 2048 + k * 1024); } while (0)
#define PG8_MMA(ai, bj, At, Bt) do { __builtin_amdgcn_s_setprio(1); _Pragma("unroll") for (int m = 0; m < 4; ++m) _Pragma("unroll") for (int n = 0; n < 2; ++n) _Pragma("unroll") for (int k = 0; k < 2; ++k) { \
        if constexpr (Epi::I8) acc[ai][bj][m][n] = __builtin_bit_cast(f32x4, __builtin_amdgcn_mfma_i32_16x16x64_i8(__builtin_bit_cast(i32x4, Bt[n][k]), __builtin_bit_cast(i32x4, At[m][k]), __builtin_bit_cast(i32x4, acc[ai][bj][m][n]), 0, 0, 0)); \
        else acc[ai][bj][m][n] = __builtin_amdgcn_mfma_f32_16x16x32_bf16(Bt[n][k], At[m][k], acc[ai][bj][m][n], 0, 0, 0); } __builtin_amdgcn_s_setprio(0); } while (0)
#define PG8_WAIT_V(n) asm volatile("s_waitcnt vmcnt(" #n ")" ::: "memory")
#define PG8_WAIT_L(n) asm volatile("s_waitcnt lgkmcnt(" #n ")" ::: "memory")
#define PG8_BAR __builtin_amdgcn_s_barrier()
#define PG8_SCHED __builtin_amdgcn_sched_barrier(0)
#define PG8_INIT(unit_) do { if constexpr (Epi::HAS_INIT) { E.init(acc, (unit_), wr, wc, fr, fq); } else { _Pragma("unroll") for (int a_ = 0; a_ < 2; ++a_) _Pragma("unroll") for (int b_ = 0; b_ < 2; ++b_) _Pragma("unroll") for (int m_ = 0; m_ < 4; ++m_) _Pragma("unroll") for (int n_ = 0; n_ < 2; ++n_) acc[a_][b_][m_][n_] = (f32x4){0.f, 0.f, 0.f, 0.f}; } } while (0)
    Unit cur, nxt; int ui = 0;
    if (!S.next(0, cur)) return;
    f32x4 acc[2][2][4][2];
    bf16x8 At[4][2], B0[2][2], B1[2][2];
    const char* cA = (const char*)g.A + (size_t)cur.pm * tstep; const char* cB = (const char*)g.Bt + (size_t)cur.pn * tstep;
    S.a_ready(cur);
    if constexpr (SP2) {
        PG8_STAGE(PG8_SB(0, 0), cB, voffB); PG8_STAGE(PG8_SB(0, 1), cB + hstep, voffB); PG8_STAGE(PG8_SA(0, 0), cA, voffA); PG8_STAGE(PG8_SA(0, 1), cA + hstep, voffA);
        PG8_INIT(cur);
        if (wr == 1) PG8_BAR;
        PG8_WAIT_V(2); PG8_BAR;
        PG8_STAGE(PG8_SB(1, 0), cB + kstep, voffB); PG8_STAGE(PG8_SA(1, 0), cA + kstep, voffA); PG8_STAGE(PG8_SB(1, 1), cB + hstep + kstep, voffB);
        PG8_WAIT_V(6); PG8_BAR;
    } else {
        PG8_STAGE(PG8_SB(0, 0), cB, voffB); PG8_STAGE(PG8_SA(0, 0), cA, voffA); PG8_STAGE(PG8_SB(0, 1), cB + hstep, voffB); PG8_STAGE(PG8_SA(0, 1), cA + hstep, voffA);
        PG8_INIT(cur);
        if (wr == 1) PG8_BAR;
        PG8_WAIT_V(4); PG8_BAR;
        PG8_STAGE(PG8_SB(1, 0), cB + kstep, voffB); PG8_STAGE(PG8_SA(1, 0), cA + kstep, voffA); PG8_STAGE(PG8_SB(1, 1), cB + hstep + kstep, voffB);
        PG8_WAIT_V(6); PG8_BAR;
    }
    for (;;) {
        const bool has_next = S.next(ui + 1, nxt);
        const char* nA = has_next ? (const char*)g.A + (size_t)nxt.pm * tstep : cA; const char* nB = has_next ? (const char*)g.Bt + (size_t)nxt.pn * tstep : cB;
        for (int t = 0; t < nt; t += 2) {
            const bool last = (t == nt - 2);
            const char* a1 = cA + (size_t)(t + 1) * kstep;
            const char* a2 = last ? nA : cA + (size_t)(t + 2) * kstep; const char* b2 = last ? nB : cB + (size_t)(t + 2) * kstep;
            const char* a3 = a2 + kstep; const char* b3 = b2 + kstep;
            if (last && has_next) S.a_ready(nxt);
            if constexpr (SP2) {
            PG8_LDB(B0, 0, 0); PG8_LDB(B1, 0, 1); PG8_SCHED; PG8_LDA(At, 0, 0); PG8_STAGE(PG8_SA(1, 1), a1 + hstep, voffA);
            PG8_WAIT_V(8); PG8_WAIT_L(0); PG8_BAR; PG8_MMA(0, 0, At, B0); PG8_MMA(0, 1, At, B1); PG8_BAR; PG8_SCHED;
            PG8_LDA(At, 0, 1); PG8_STAGE(PG8_SB(0, 0), b2, voffB); PG8_STAGE(PG8_SB(0, 1), b2 + hstep, voffB); PG8_STAGE(PG8_SA(0, 0), a2, voffA);
            PG8_WAIT_V(8); PG8_WAIT_L(0); PG8_BAR; PG8_MMA(1, 0, At, B0); PG8_MMA(1, 1, At, B1); PG8_BAR; PG8_SCHED;
            PG8_LDB(B0, 1, 0); PG8_LDB(B1, 1, 1); PG8_SCHED; PG8_LDA(At, 1, 0); PG8_STAGE(PG8_SA(0, 1), a2 + hstep, voffA);
            PG8_WAIT_V(8); PG8_WAIT_L(0); PG8_BAR; PG8_MMA(0, 0, At, B0); PG8_MMA(0, 1, At, B1); PG8_BAR; PG8_SCHED;
            PG8_LDA(At, 1, 1); PG8_STAGE(PG8_SB(1, 0), b3, voffB); PG8_STAGE(PG8_SB(1, 1), b3 + hstep, voffB); PG8_STAGE(PG8_SA(1, 0), a3, voffA);
            PG8_WAIT_V(8); PG8_WAIT_L(0); PG8_BAR; PG8_MMA(1, 0, At, B0); PG8_MMA(1, 1, At, B1); PG8_BAR; PG8_SCHED;
            } else {
            PG8_LDB(B0, 0, 0); PG8_SCHED; PG8_LDA(At, 0, 0); PG8_STAGE(PG8_SA(1, 1), a1 + hstep, voffA);
            PG8_WAIT_L(8); PG8_BAR; PG8_WAIT_L(0); PG8_MMA(0, 0, At, B0); PG8_BAR; PG8_SCHED;
            PG8_LDB(B1, 0, 1); PG8_STAGE(PG8_SB(0, 0), b2, voffB);
            PG8_BAR; PG8_WAIT_L(0); PG8_MMA(0, 1, At, B1); PG8_BAR;
            PG8_LDA(At, 0, 1); PG8_STAGE(PG8_SA(0, 0), a2, voffA);
            PG8_BAR; PG8_WAIT_L(0); PG8_MMA(1, 0, At, B0); PG8_BAR; PG8_SCHED;
            PG8_STAGE(PG8_SB(0, 1), b2 + hstep, voffB);
            PG8_WAIT_V(6); PG8_BAR; PG8_MMA(1, 1, At, B1); PG8_BAR;
            PG8_LDB(B0, 1, 0); PG8_SCHED; PG8_LDA(At, 1, 0); PG8_STAGE(PG8_SA(0, 1), a2 + hstep, voffA);
            PG8_WAIT_L(8); PG8_BAR; PG8_WAIT_L(0); PG8_MMA(0, 0, At, B0); PG8_BAR; PG8_SCHED;
            PG8_LDB(B1, 1, 1); PG8_STAGE(PG8_SB(1, 0), b3, voffB);
            PG8_BAR; PG8_WAIT_L(0); PG8_MMA(0, 1, At, B1); PG8_BAR;
            PG8_LDA(At, 1, 1); PG8_STAGE(PG8_SA(1, 0), a3, voffA);
            PG8_BAR; PG8_WAIT_L(0); PG8_MMA(1, 0, At, B0); PG8_BAR; PG8_SCHED;
            PG8_STAGE(PG8_SB(1, 1), b3 + hstep, voffB);
            PG8_WAIT_V(6); PG8_BAR; PG8_MMA(1, 1, At, B1); PG8_BAR;
            }
        }
        if constexpr (ALIGN_EPI) { if (wr == 0) PG8_BAR; }
        if constexpr (!Epi::AFTER_DRAIN) { E(acc, cur, wr, wc, fr, fq); S.done(cur); }
        if (!has_next) break;
        PG8_INIT(nxt);
        cur = nxt; cA = nA; cB = nB; ++ui;
        if constexpr (ALIGN_EPI) { if (wr == 1) PG8_BAR; }
    }
    PG8_WAIT_V(0);
    if constexpr (!ALIGN_EPI) { if (wr == 0) PG8_BAR; }
    PG8_BAR;
    if constexpr (Epi::AFTER_DRAIN) { E.fused(acc, cur, wr, wc, fr, fq, lds, wid, lane); S.done(cur); }
#undef PG8_SA
#undef PG8_SB
#undef PG8_STAGE
#undef PG8_LDA
#undef PG8_LDB
#undef PG8_MMA
#undef PG8_WAIT_V
#undef PG8_WAIT_L
#undef PG8_BAR
#undef PG8_SCHED
#undef PG8_INIT
}
}
namespace att {
using bf16 = __hip_bfloat16;
typedef short bf16x8 __attribute__((ext_vector_type(8)));
typedef short s16x4 __attribute__((ext_vector_type(4)));
typedef float f32x16 __attribute__((ext_vector_type(16)));
typedef float f32x4 __attribute__((ext_vector_type(4)));
typedef unsigned u32x4 __attribute__((ext_vector_type(4)));
constexpr int NW = 8, QBLK = 32, KVBLK = 64, QB = NW * QBLK, D = 128;
constexpr int RS = 2048, RS_QR = 1024, RS_KR = 64;
constexpr int SHM_V = KVBLK * D * 2, SHM_K = KVBLK * D * 2, SHM_KR = KVBLK * 64 * 2;
constexpr int OFF_V = 0, OFF_K = 2 * SHM_V, OFF_WS = OFF_K + 2 * SHM_K, OFF_KR = OFF_WS + NW * 64 * 4, OFF_KM = OFF_KR + 2 * SHM_KR, LDS_BYTES = OFF_KM + 32 * 256;
constexpr float THR = 8.f;
template <int MODE> struct Cfg { static constexpr float SCALE = MODE == 0 ? 0.08838834764831845f : 0.07216878364870323f; static constexpr int NQ = MODE == 0 ? 8 : 12; };

#define KSWZ(row, colB) ((row) * 256 + ((colB) ^ (((row) & 7) << 4)))
#define KRSWZ(row, colB) ((row) * 128 + ((colB) ^ ((((row) >> 1) & 7) << 4)))
#define SBAR() __builtin_amdgcn_sched_barrier(0)
__device__ __forceinline__ int v_st(int k, int c) { const int kk = (k & ~0xC) | ((k & 4) << 1) | ((k & 8) >> 1); return ((kk >> 3) * 4 + (c >> 5)) * 512 + ((kk & 7) * 32 + (c & 31)) * 2; }
__device__ __forceinline__ int v_rd_base(int lane) { return ((lane & 3) << 3) | (((lane >> 2) & 3) << 6) | (((lane >> 4) & 1) << 5) | (((lane >> 5) & 1) << 8); }
constexpr int v_rd_off(int d0, int ks, int half) { return d0 * 512 + ks * 4096 + half * 2048; }
__device__ __forceinline__ int crow(int r, int hi) { return (r & 3) + 8 * (r >> 2) + 4 * hi; }
__device__ __forceinline__ unsigned cvtpk(float lo, float hi) { unsigned r; asm volatile("v_cvt_pk_bf16_f32 %0, %1, %2" : "=v"(r) : "v"(lo), "v"(hi)); return r; }
__device__ __forceinline__ bf16x8 pack8(f32x4 a, f32x4 b) { u32x4 w = {cvtpk(a[0], a[1]), cvtpk(a[2], a[3]), cvtpk(b[0], b[1]), cvtpk(b[2], b[3])}; return *reinterpret_cast<bf16x8*>(&w); }
__device__ __forceinline__ bf16x8 load8(const bf16* p) { return *reinterpret_cast<const bf16x8*>(p); }
__device__ __forceinline__ void mask_tile(f32x16& p0, f32x16& p1, int dq) {
    const float NEG = -__builtin_inff();
#pragma unroll
    for (int r = 0; r < 16; ++r) { const int c = (r & 3) + 8 * (r >> 2); if (dq - c < 0) p0[r] = NEG; if (dq - c - 32 < 0) p1[r] = NEG; }
}
template <int MODE, bool PERROW = false> __device__ __forceinline__ void partialSM(f32x16& p0, f32x16& p1, float& m_reg, float& mn, float& alpha) {
    constexpr float SCALE = Cfg<MODE>::SCALE;
    float pmax = p0[0]; for (int r = 1; r < 16; ++r) pmax = fmaxf(pmax, p0[r]); for (int r = 0; r < 16; ++r) pmax = fmaxf(pmax, p1[r]);
    { auto rr = __builtin_amdgcn_permlane32_swap(__float_as_uint(pmax), __float_as_uint(pmax), false, false);
      pmax = fmaxf(__uint_as_float(rr[0]), __uint_as_float(rr[1])); }
    constexpr float C2 = 1.4426950408889634f * SCALE;
    if constexpr (PERROW) {
        const bool keep = (pmax - m_reg) * SCALE <= THR; mn = keep ? m_reg : fmaxf(m_reg, pmax); alpha = keep ? 1.f : __builtin_amdgcn_exp2f((m_reg - mn) * C2); m_reg = mn; }
    else if (__builtin_expect(__all((pmax - m_reg) * SCALE <= THR), 1)) { mn = m_reg; alpha = 1.f; }
    else { mn = fmaxf(m_reg, pmax); alpha = __builtin_amdgcn_exp2f((m_reg - mn) * C2); m_reg = mn; }
    const float mnL = -mn * C2;
    for (int r = 0; r < 16; ++r) p0[r] = fmaf(p0[r], C2, mnL); for (int r = 0; r < 16; ++r) p1[r] = fmaf(p1[r], C2, mnL);
    for (int r = 0; r < 16; ++r) p0[r] = __builtin_amdgcn_exp2f(p0[r]);
}
__device__ __forceinline__ void finishSM(f32x16& p0, f32x16& p1, float alpha, float& l_reg, bf16x8& pa0, bf16x8& pa1, bf16x8& pa2, bf16x8& pa3) {
    for (int r = 0; r < 16; ++r) p1[r] = __builtin_amdgcn_exp2f(p1[r]);
    float ps = 0; for (int r = 0; r < 16; ++r) ps += p0[r]; for (int r = 0; r < 16; ++r) ps += p1[r];
    { auto rr = __builtin_amdgcn_permlane32_swap(__float_as_uint(ps), __float_as_uint(ps), false, false);
      ps = __uint_as_float(rr[0]) + __uint_as_float(rr[1]); }
    l_reg = l_reg * alpha + ps;
#define PK4(P, B_, OUT) do { unsigned a0 = cvtpk(P[B_+0], P[B_+1]), a1 = cvtpk(P[B_+2], P[B_+3]);                          \
        unsigned b0 = cvtpk(P[B_+4], P[B_+5]), b1 = cvtpk(P[B_+6], P[B_+7]);                                             \
        auto r0 = __builtin_amdgcn_permlane32_swap(a0, b0, false, false); auto r1 = __builtin_amdgcn_permlane32_swap(a1, b1, false, false); \
        u32x4 w = {r0[0], r1[0], r0[1], r1[1]}; OUT = *reinterpret_cast<bf16x8*>(&w); } while (0)
    PK4(p0, 0, pa0); PK4(p0, 8, pa1); PK4(p1, 0, pa2); PK4(p1, 8, pa3);
#undef PK4
}
template <int MODE, int KB>
__device__ __forceinline__ void qkt(f32x16& p0, f32x16& p1, const char* K_lds, const char* KR_lds, int r32, int hi, const bf16x8* qr, float slopeP, float tb) {
    if constexpr (MODE == 0) {
#pragma unroll
        for (int r = 0; r < 16; ++r) { const int c = (r & 3) + 8 * (r >> 2); p0[r] = fmaf(slopeP, (float)c, tb); p1[r] = fmaf(slopeP, (float)(c + 32), tb); }
    } else { p0 = f32x16{}; p1 = f32x16{}; }
    const char* kb[4];
#pragma unroll
    for (int dd = 0; dd < 4; ++dd) kb[dd] = K_lds + KB * SHM_K + KSWZ(r32, (dd * 16 + hi * 8) * 2);
    constexpr int NS = MODE == 1 ? 12 : 8;
    bf16x8 f0[2], f1[2];
#define QK_RD(d, s_) do { if ((d) < 8) { const char* a_ = kb[(d) & 3] + ((d) >> 2) * 128; f0[s_] = *reinterpret_cast<const bf16x8*>(a_); f1[s_] = *reinterpret_cast<const bf16x8*>(a_ + 32 * 256); }   \
        else { const char* a_ = KR_lds + KB * SHM_KR + KRSWZ(r32, ((((d) - 8) & 3) * 16 + hi * 8) * 2); f0[s_] = *reinterpret_cast<const bf16x8*>(a_); f1[s_] = *reinterpret_cast<const bf16x8*>(a_ + 32 * 128); } } while (0)
    QK_RD(0, 0);
#pragma unroll
    for (int d = 0; d < NS; ++d) {
        if (d + 1 < NS) QK_RD(d + 1, (d + 1) & 1);
        SBAR();
        p0 = __builtin_amdgcn_mfma_f32_32x32x16_bf16(f0[d & 1], qr[d], p0, 0, 0, 0);
        p1 = __builtin_amdgcn_mfma_f32_32x32x16_bf16(f1[d & 1], qr[d], p1, 0, 0, 0);
        SBAR();
    }
#undef QK_RD
}
template <int VB>
__device__ __forceinline__ void pv_tile(f32x16* o, int vb0, bf16x8 pa0, bf16x8 pa1, bf16x8 pa2, bf16x8 pa3) {
#define TRRD(dst, off) asm volatile("ds_read_b64_tr_b16 %0, %1 offset:%2" : "=&v"(dst) : "v"(vb0), "i"(off) : "memory")
#define PV_D0(d0) do { s16x4 l0, l1, l2, l3, h0, h1, h2, h3; constexpr int b_ = VB * SHM_V + v_rd_off(d0, 0, 0);   \
        TRRD(l0, b_); TRRD(h0, b_ + 2048); TRRD(l1, b_ + 4096); TRRD(h1, b_ + 6144); TRRD(l2, b_ + 8192); TRRD(h2, b_ + 10240); TRRD(l3, b_ + 12288); TRRD(h3, b_ + 14336); \
        asm volatile("s_waitcnt lgkmcnt(0)" ::: "memory"); SBAR();   \
        o[d0] = __builtin_amdgcn_mfma_f32_32x32x16_bf16(pa0, (bf16x8){l0[0], l0[1], l0[2], l0[3], h0[0], h0[1], h0[2], h0[3]}, o[d0], 0, 0, 0);   \
        o[d0] = __builtin_amdgcn_mfma_f32_32x32x16_bf16(pa1, (bf16x8){l1[0], l1[1], l1[2], l1[3], h1[0], h1[1], h1[2], h1[3]}, o[d0], 0, 0, 0);   \
        o[d0] = __builtin_amdgcn_mfma_f32_32x32x16_bf16(pa2, (bf16x8){l2[0], l2[1], l2[2], l2[3], h2[0], h2[1], h2[2], h2[3]}, o[d0], 0, 0, 0);   \
        o[d0] = __builtin_amdgcn_mfma_f32_32x32x16_bf16(pa3, (bf16x8){l3[0], l3[1], l3[2], l3[3], h3[0], h3[1], h3[2], h3[3]}, o[d0], 0, 0, 0); } while (0)
    PV_D0(0); PV_D0(1); PV_D0(2); PV_D0(3);
#undef PV_D0
#undef TRRD
}

__device__ __forceinline__ void store_o_rows(const f32x16* o, char* stg, bf16* Ow, size_t ldo, int lane, int r32, int hi) {
#pragma unroll
    for (int p = 0; p < 2; ++p) {
#pragma unroll
        for (int rr = 0; rr < 8; ++rr) { const int r = 8 * p + rr, lrow = (rr & 3) + 8 * (rr >> 2) + 4 * hi;
#pragma unroll
            for (int d0 = 0; d0 < 4; ++d0) *(unsigned short*)(stg + lrow * 256 + (d0 * 32 + r32) * 2) = (unsigned short)cvtpk(o[d0][r], 0.f); }
        asm volatile("s_waitcnt lgkmcnt(0)" ::: "memory");
#pragma unroll
        for (int i = 0; i < 4; ++i) { const int row = 4 * i + (lane >> 4), ch = lane & 15; const u32x4 v = *(const u32x4*)(stg + row * 256 + ch * 16);
            *(u32x4*)(Ow + (size_t)(16 * p + row) * ldo + ch * 8) = v; }
        asm volatile("s_waitcnt lgkmcnt(0)" ::: "memory");
    }
}
struct BlockRef { const bf16* Q; const bf16* QR; const bf16* K; const bf16* V; bf16* O; int P0; int h; };
template <int MODE> struct Seam { bf16x8 qr[Cfg<MODE>::NQ]; bf16x8 st_v0, st_v1, st_k0, st_k1, st_kr; };
struct Shared { const bf16* KR; const float* kmean; };

#define ROW(p, k0, rr) ((p) + (size_t)((k0) + (rr)) * RS + sc)
#define VMW() asm volatile("s_waitcnt vmcnt(0)" ::: "memory")
#define VMWN(n) asm volatile("s_waitcnt vmcnt(%0)" :: "i"(n) : "memory")
#define SLOAD_H(Kp, Vp, k0) do { S.st_v0 = load8(ROW(Vp, k0, sr)); S.st_v1 = load8(ROW(Vp, k0, 32 + sr));              \
                         S.st_k0 = load8(ROW(Kp, k0, sr)); S.st_k1 = load8(ROW(Kp, k0, 32 + sr));                       \
                         if constexpr (MODE == 1) S.st_kr = load8(G.KR + (size_t)((k0) + krr) * RS_KR + krc); } while (0)
#define SWRITE_HK(bf) do { *(bf16x8*)(K_lds + (bf) * SHM_K + kws) = S.st_k0; *(bf16x8*)(K_lds + (bf) * SHM_K + kws + 32 * 256) = S.st_k1; \
                           if constexpr (MODE == 1) *(bf16x8*)(KR_lds + (bf) * SHM_KR + krws) = S.st_kr; } while (0)
#define SWRITE_HV(bf) do { *(bf16x8*)(V_lds + (bf) * SHM_V + vst0) = S.st_v0; *(bf16x8*)(V_lds + (bf) * SHM_V + vst1) = S.st_v1; } while (0)
#define SWRITE_H(bf) do { SWRITE_HV(bf); SWRITE_HK(bf); } while (0)
#define QLOAD(Sq, ref) do { _Pragma("unroll") for (int d0 = 0; d0 < 8; ++d0) Sq.qr[d0] = load8((ref).Q + (size_t)(wid * QBLK + r32) * RS + d0 * 16 + hi * 8);    \
        if constexpr (MODE == 1) { _Pragma("unroll") for (int d0 = 0; d0 < 4; ++d0) Sq.qr[8 + d0] = load8((ref).QR + (size_t)(wid * QBLK + r32) * RS_QR + d0 * 16 + hi * 8); } } while (0)

template <int MODE>
__device__ __forceinline__ void attn_prime(const BlockRef& cur, const Shared& G, char* lds, Seam<MODE>& S) {
    int tid_ = threadIdx.x; asm volatile("" : "+v"(tid_));
    const int tid = tid_, wid = __builtin_amdgcn_readfirstlane(tid >> 6), lane = tid & 63, r32 = lane & 31, hi = lane >> 5;
    const int sr = tid >> 4, sc = (tid & 15) * 8, vst0 = v_st(sr, sc), vst1 = v_st(32 + sr, sc), kws = KSWZ(sr, sc * 2);
    char* V_lds = lds + OFF_V; char* K_lds = lds + OFF_K; char* KR_lds = lds + OFF_KR;
    const int krr = tid >> 3, krc = (tid & 7) * 8, krws = KRSWZ(krr, krc * 2);
    QLOAD(S, cur);
    SLOAD_H(cur.K, cur.V, 0); VMW(); SWRITE_H(0);
    __syncthreads();
}
template <int MODE>
__device__ __forceinline__ void attn_block(const BlockRef& cur, const BlockRef& nxt, const Shared& G, char* lds, Seam<MODE>& S) {
    constexpr float SCALE = Cfg<MODE>::SCALE;
    int tid_ = threadIdx.x; asm volatile("" : "+v"(tid_));
    const int tid = tid_, wid = __builtin_amdgcn_readfirstlane(tid >> 6), lane = tid & 63, r32 = lane & 31, hi = lane >> 5;
    const int NT = (cur.P0 + QB) / KVBLK;
    const int qlo = cur.P0 + wid * QBLK, qm = qlo + r32 - 4 * hi;
    char* V_lds = lds + OFF_V; char* K_lds = lds + OFF_K; char* KR_lds = lds + OFF_KR;
    float* ws = (float*)(lds + OFF_WS) + wid * 64; float* li_l = ws, * al_l = ws + 32;
    float m_reg = -1e30f, l_reg = 0; f32x16 o[4] = {};
    const int sr = tid >> 4, sc = (tid & 15) * 8, vst0 = v_st(sr, sc), vst1 = v_st(32 + sr, sc), kws = KSWZ(sr, sc * 2);
    const int krr = tid >> 3, krc = (tid & 7) * 8, krws = KRSWZ(krr, krc * 2);
    const int vb0 = (int)(uintptr_t)V_lds + v_rd_base(lane);
    const bf16* Kh = cur.K; const bf16* Vh = cur.V;
    unsigned selmask = 0u; float slopeP = 0.f;
    if constexpr (MODE == 0) {
        { const int e_ = cur.h + 1; slopeP = __builtin_ldexpf((e_ & 1) ? 0.70710678118654752f : 1.0f, -(e_ >> 1)) * (1.0f / SCALE); }
        { const int row = tid >> 4, c8 = (tid & 15) * 8; const float* src = G.kmean + (size_t)row * 2048 + cur.h * 128 + c8;
          const f32x4 a = *(const f32x4*)src * (1.0f / 256.0f), b = *(const f32x4*)(src + 4) * (1.0f / 256.0f);
          *(bf16x8*)(lds + OFF_KM + KSWZ(row, c8 * 2)) = pack8(a, b); }
        __syncthreads();
        f32x16 g = {};
#pragma unroll
        for (int d0 = 0; d0 < 8; ++d0) { const bf16x8 kf = *reinterpret_cast<const bf16x8*>(lds + OFF_KM + KSWZ(r32, (d0 * 16 + hi * 8) * 2)); g = __builtin_amdgcn_mfma_f32_32x32x16_bf16(kf, S.qr[d0], g, 0, 0, 0); }
        const int qb = cur.P0 >> 8; const float NEG = -__builtin_inff();
        float gv[16];
#pragma unroll
        for (int r = 0; r < 16; ++r) gv[r] = (crow(r, hi) < qb) ? g[r] : NEG;
        float a1 = NEG, a2 = NEG, a3 = NEG;
#pragma unroll
        for (int r = 0; r < 16; ++r) a1 = fmaxf(a1, gv[r]);
#pragma unroll
        for (int r = 0; r < 16; ++r) a2 = fmaxf(a2, gv[r] < a1 ? gv[r] : NEG);
#pragma unroll
        for (int r = 0; r < 16; ++r) a3 = fmaxf(a3, gv[r] < a2 ? gv[r] : NEG);
        const float b1 = __shfl_xor(a1, 32), b2 = __shfl_xor(a2, 32), b3 = __shfl_xor(a3, 32);
        const float T = fmaxf(fmaxf(a3, b3), fmaxf(fminf(a2, b1), fminf(a1, b2)));
        unsigned msk = 0u;
#pragma unroll
        for (int r = 0; r < 16; ++r) if (gv[r] >= T && crow(r, hi) < qb) msk |= 1u << crow(r, hi);
        selmask = msk | (unsigned)__shfl_xor((int)msk, 32);
    }
#define RESC(a) do { if (__any((a) < 1.f)) { if (hi == 0) al_l[r32] = (a); asm volatile("s_waitcnt lgkmcnt(0)" ::: "memory");              \
                     for (int d_ = 0; d_ < 4; ++d_) for (int r = 0; r < 16; ++r) o[d_][r] *= al_l[crow(r, hi)]; } } while (0)
#define KBASE(t) ((t) * KVBLK)
#define TB(t) (slopeP * (float)(KBASE(t) - cur.P0 + 4 * hi))
#define MASKT(P0_, P1_, t) do { const int kb_ = KBASE(t);                                                                                     \
        if (MODE == 0 && kb_ < cur.P0) { if (!((selmask >> (kb_ >> 8)) & 1u)) { const float NEG_ = -__builtin_inff();                        \
                _Pragma("unroll") for (int r = 0; r < 16; ++r) { P0_[r] = NEG_; P1_[r] = NEG_; } } }                                          \
        else if (kb_ + KVBLK - 1 > qlo) mask_tile(P0_, P1_, qm - kb_); } while (0)
    f32x16 p0, p1; float mn, al; bf16x8 pa0, pa1, pa2, pa3;
#define TILE(t, B) do {                                                                                                       \
        const bool lastt_ = (t) + 1 >= NT;                                                                                    \
        if (!lastt_) { SLOAD_H(Kh, Vh, KBASE((t) + 1)); } else { SLOAD_H(nxt.K, nxt.V, 0); }                                  \
        SBAR(); qkt<MODE, B>(p0, p1, K_lds, KR_lds, r32, hi, S.qr, slopeP, TB(t)); SBAR();                                    \
        if (lastt_) { QLOAD(S, nxt); SBAR(); }                                                                                \
        MASKT(p0, p1, (t)); partialSM<MODE>(p0, p1, m_reg, mn, al); RESC(al);                                                 \
        finishSM(p0, p1, al, l_reg, pa0, pa1, pa2, pa3); SBAR();                                                              \
        pv_tile<B>(o, vb0, pa0, pa1, pa2, pa3); SBAR();                                                                       \
        SWRITE_H((B) ^ 1);                                                                                                    \
        __syncthreads(); } while (0)
    for (int t = 0; t < NT; t += 2) { TILE(t, 0); TILE(t + 1, 1); }
    if (hi == 0) li_l[r32] = l_reg; asm volatile("s_waitcnt lgkmcnt(0)" ::: "memory");
    float rli[16];
#pragma unroll
    for (int r = 0; r < 16; ++r) rli[r] = __builtin_amdgcn_rcpf(li_l[crow(r, hi)]);
#pragma unroll
    for (int r = 0; r < 16; ++r)
#pragma unroll
        for (int d0 = 0; d0 < 4; ++d0) o[d0][r] *= rli[r];
    store_o_rows(o, lds + (wid < 4 ? OFF_V + SHM_V + wid * 4096 : OFF_K + SHM_K + (wid - 4) * 4096), cur.O + (size_t)(wid * QBLK) * RS, RS, lane, r32, hi);
    __syncthreads();
#undef RESC
#undef KBASE
#undef TB
#undef MASKT
#undef TILE
}
#undef ROW
#undef VMW
#undef VMWN
#undef SLOAD_H
#undef SWRITE_HK
#undef SWRITE_HV
#undef SWRITE_H
#undef QLOAD

__device__ __forceinline__ BlockRef mkref(const bf16* Q, const bf16* QRp, const bf16* K, const bf16* V, bf16* O, int L_, int pass) {
    const int xcd = L_ & 7, k = L_ >> 3, h = 2 * xcd + (k >> 4), s = k & 15, qb = pass ? 31 - s : s;
    BlockRef r; r.Q = Q + (size_t)qb * QB * RS + h * 128; r.QR = QRp + (size_t)qb * QB * RS_QR + h * 64; r.K = K + h * 128; r.V = V + h * 128; r.O = O + (size_t)qb * QB * RS + h * 128; r.P0 = qb * QB; r.h = h; return r;
}
template <int MODE>
__device__ __forceinline__ void attn_phase(char* lds, const bf16* Q, const bf16* QRp, const bf16* K, const bf16* V, bf16* O, const Shared& G) {
    const int total = 256, stride = gridDim.x;
    int L = blockIdx.x; if (L >= total) return;
    int pass = 0; BlockRef cur = mkref(Q, QRp, K, V, O, L, 0);
    Seam<MODE> S;
    attn_prime<MODE>(cur, G, lds, S);
    for (;;) {
        const bool more_pass = pass == 0, more_item = L + stride < total, last = !more_pass && !more_item;
        int passn = pass + 1, Ln = L;
        if (!more_pass) { passn = 0; Ln = more_item ? L + stride : L; }
        const BlockRef nxt = last ? cur : mkref(Q, QRp, K, V, O, Ln, passn);
        attn_block<MODE>(cur, nxt, G, lds, S);
        if (last) break;
        cur = nxt; pass = passn; L = Ln;
    }
}
struct MobaBufs { unsigned* cnt; unsigned short* list; bf16* po; float* pml; };
constexpr int OFF_SCAN = OFF_KM;
constexpr int OFF_X = OFF_KM + 4096;

__device__ __forceinline__ unsigned moba_top3(const f32x16& g, int qb, int hi) {
    const float NEG = -__builtin_inff(); int hi_g = hi; asm volatile("" : "+v"(hi_g));
    float gv[16];
#pragma unroll
    for (int r = 0; r < 16; ++r) gv[r] = (crow(r, hi_g) < qb) ? g[r] : NEG;
    float a1 = NEG, a2 = NEG, a3 = NEG;
#pragma unroll
    for (int r = 0; r < 16; ++r) a1 = fmaxf(a1, gv[r]);
#pragma unroll
    for (int r = 0; r < 16; ++r) a2 = fmaxf(a2, gv[r] < a1 ? gv[r] : NEG);
#pragma unroll
    for (int r = 0; r < 16; ++r) a3 = fmaxf(a3, gv[r] < a2 ? gv[r] : NEG);
    const float b1 = __shfl_xor(a1, 32), b2 = __shfl_xor(a2, 32), b3 = __shfl_xor(a3, 32);
    const float T = fmaxf(fmaxf(a3, b3), fmaxf(fminf(a2, b1), fminf(a1, b2)));
    unsigned msk = 0u;
#pragma unroll
    for (int r = 0; r < 16; ++r) if (gv[r] >= T && crow(r, hi_g) < qb) msk |= 1u << crow(r, hi_g);
    return msk | (unsigned)__shfl_xor((int)msk, 32);
}
__device__ __forceinline__ void moba_gate_phase(char* lds, const bf16* Q, const float* kmean, const MobaBufs& B) {
    int tid_ = threadIdx.x; asm volatile("" : "+v"(tid_));
    const int tid = tid_, wid = __builtin_amdgcn_readfirstlane(tid >> 6), lane = tid & 63, r32 = lane & 31, hi = lane >> 5;
    for (int item = blockIdx.x; item < 512; item += gridDim.x) {
        const int h = item >> 5, qb = item & 31;
        { const int row = tid >> 4, c8 = (tid & 15) * 8; const float* src = kmean + (size_t)row * 2048 + h * 128 + c8;
          const f32x4 a = *(const f32x4*)src * (1.0f / 256.0f), b = *(const f32x4*)(src + 4) * (1.0f / 256.0f);
          *(bf16x8*)(lds + OFF_KM + KSWZ(row, c8 * 2)) = pack8(a, b); }
        __syncthreads();
        const int q = qb * QB + wid * QBLK + r32; const bf16* Qw = Q + (size_t)q * RS + h * 128;
        f32x16 g = {};
#pragma unroll
        for (int d0 = 0; d0 < 8; ++d0) { const bf16x8 kf = *reinterpret_cast<const bf16x8*>(lds + OFF_KM + KSWZ(r32, (d0 * 16 + hi * 8) * 2)); g = __builtin_amdgcn_mfma_f32_32x32x16_bf16(kf, load8(Qw + d0 * 16 + hi * 8), g, 0, 0, 0); }
        const unsigned m = moba_top3(g, qb, hi);
        unsigned* lcnt = (unsigned*)(lds + OFF_WS); unsigned* gbase = lcnt + 32;
        if (tid < 32) lcnt[tid] = 0u;
        __syncthreads();
        unsigned pk[3] = {0u, 0u, 0u}; int npk = 0;
        if (hi == 0) { unsigned mm = m;
#pragma unroll
            for (int jj = 0; jj < 3; ++jj) if (mm) { const int n = __builtin_ctz(mm); mm &= mm - 1u; const unsigned lr = __hip_atomic_fetch_add(lcnt + n, 1u, __ATOMIC_RELAXED, __HIP_MEMORY_SCOPE_WORKGROUP); pk[jj] = (unsigned)n | (lr << 8); npk = jj + 1; } }
        __syncthreads();
        if (tid < 32) { const unsigned c = lcnt[tid]; gbase[tid] = c ? __hip_atomic_fetch_add(B.cnt + h * 32 + tid, c, __ATOMIC_RELAXED, __HIP_MEMORY_SCOPE_AGENT) : 0u; }
        __syncthreads();
        if (hi == 0) {
            float* pm = B.pml + ((size_t)(h * 8192 + q) * 3) * 2;
            float ninf_ = -1e30f, zero_ = 0.f; asm volatile("" : "+v"(ninf_), "+v"(zero_));
#pragma unroll
            for (int jj = 0; jj < 3; ++jj) { pm[2 * jj] = ninf_; pm[2 * jj + 1] = zero_; }
#pragma unroll
            for (int jj = 0; jj < 3; ++jj) if (jj < npk) { const int n = pk[jj] & 31u; B.list[(size_t)(h * 32 + n) * 8192 + gbase[n] + (pk[jj] >> 8)] = (unsigned short)(q | (jj << 13)); }
        }
        __syncthreads();
    }
}
template <bool CAUSAL>
__device__ __forceinline__ void moba_blk4(char* lds, const bf16* Kb, const bf16* Vb, const bf16x8* qr, float slopeP, int kabs0, int qpos, int qlo, float& m_reg, float& l_reg, f32x16* o,
                                          int tid, int wid, int lane, int r32, int hi) {
    char* V_lds = lds + OFF_V; char* K_lds = lds + OFF_K; float* al_l = (float*)(lds + OFF_WS) + wid * 64 + 32;
    const int sr = tid >> 4, sc = (tid & 15) * 8, vst0 = v_st(sr, sc), vst1 = v_st(32 + sr, sc), kws = KSWZ(sr, sc * 2);
    const unsigned soff0 = (unsigned)(sr * RS + sc), soff1 = soff0 + 32u * RS;
    const int vb0 = (int)(uintptr_t)V_lds + v_rd_base(lane);
    const float tb0 = slopeP * (float)(kabs0 + 4 * hi - qpos); const int qm = qpos - 4 * hi;
    bf16x8 st_v0, st_v1, st_k0, st_k1; f32x16 p0, p1; float mn, al; bf16x8 pa0, pa1, pa2, pa3;
#define LOADT(t) do { const bf16* kb_ = Kb + (size_t)((t) * KVBLK) * RS; const bf16* vb_ = Vb + (size_t)((t) * KVBLK) * RS; st_v0 = load8(vb_ + soff0); st_v1 = load8(vb_ + soff1); st_k0 = load8(kb_ + soff0); st_k1 = load8(kb_ + soff1); } while (0)
#define WRITET(bf) do { *(bf16x8*)(V_lds + (bf) * SHM_V + vst0) = st_v0; *(bf16x8*)(V_lds + (bf) * SHM_V + vst1) = st_v1; *(bf16x8*)(K_lds + (bf) * SHM_K + kws) = st_k0; *(bf16x8*)(K_lds + (bf) * SHM_K + kws + 32 * 256) = st_k1; } while (0)
#define RESC4(a) do { if (__any((a) < 1.f)) { if (hi == 0) al_l[r32] = (a); asm volatile("s_waitcnt lgkmcnt(0)" ::: "memory"); int hi_r = hi; asm volatile("" : "+v"(hi_r));   \
                      for (int d_ = 0; d_ < 4; ++d_) for (int r = 0; r < 16; ++r) o[d_][r] *= al_l[crow(r, hi_r)]; } } while (0)
#define T4(t, Bf) do { if ((t) < 3) LOADT((t) + 1);                                                                                           \
        SBAR(); qkt<0, Bf>(p0, p1, K_lds, K_lds, r32, hi, qr, slopeP, tb0 + slopeP * (float)((t) * KVBLK)); SBAR();                           \
        if (CAUSAL) { const int kb_ = kabs0 + (t) * KVBLK; if (kb_ + KVBLK - 1 > qlo) mask_tile(p0, p1, qm - kb_); }                          \
        partialSM<0, true>(p0, p1, m_reg, mn, al); RESC4(al); finishSM(p0, p1, al, l_reg, pa0, pa1, pa2, pa3); SBAR();                              \
        pv_tile<Bf>(o, vb0, pa0, pa1, pa2, pa3); SBAR();                                                                                      \
        if ((t) < 3) WRITET((Bf) ^ 1);                                                                                                        \
        __syncthreads(); } while (0)
    LOADT(0); WRITET(0); __syncthreads();
    T4(0, 0); T4(1, 1); T4(2, 0); T4(3, 1);
#undef LOADT
#undef WRITET
#undef RESC4
#undef T4
}
__device__ __forceinline__ float moba_slope(int h) { const int e_ = h + 1; return __builtin_ldexpf((e_ & 1) ? 0.70710678118654752f : 1.0f, -(e_ >> 1)) * (1.0f / Cfg<0>::SCALE); }
__device__ __forceinline__ void moba_sel_phase(char* lds, const bf16* Q, const bf16* K, const bf16* V, const MobaBufs& B) {
    int tid_ = threadIdx.x; asm volatile("" : "+v"(tid_));
    const int tid = tid_, wid = __builtin_amdgcn_readfirstlane(tid >> 6), lane = tid & 63, r32 = lane & 31, hi = lane >> 5;
    unsigned* pre = (unsigned*)(lds + OFF_SCAN);
    { unsigned v = (B.cnt[tid] + 255u) >> 8;
#pragma unroll
      for (int o_ = 1; o_ < 64; o_ <<= 1) { const unsigned t = (unsigned)__shfl_up((int)v, o_); if (lane >= o_) v += t; }
      if (lane == 63) pre[512 + wid] = v;
      __syncthreads();
      unsigned off = 0u;
#pragma unroll
      for (int w = 0; w < 8; ++w) off += (w < wid) ? pre[512 + w] : 0u;
      pre[tid] = v + off; __syncthreads(); }
    const unsigned U = pre[511];
    float* ws = (float*)(lds + OFF_WS) + wid * 64; float* li_l = ws; unsigned* ent_l = (unsigned*)(lds + OFF_X) + wid * 64;
    for (unsigned u = blockIdx.x; u < U; u += gridDim.x) {
        int lo_ = 0, hi_ = 511; while (lo_ < hi_) { const int mid = (lo_ + hi_) >> 1; if (pre[mid] > u) hi_ = mid; else lo_ = mid + 1; }
        const int b = __builtin_amdgcn_readfirstlane(lo_), h = b >> 5, n = b & 31, slice = (int)(u - (b ? pre[b - 1] : 0u));
        const int cntb = (int)B.cnt[b]; int valid = cntb - slice * 256; if (valid > 256) valid = 256;
        const int e = wid * QBLK + r32; const unsigned ent = B.list[(size_t)b * 8192 + slice * 256 + (e < valid ? e : valid - 1)];
        const int q = ent & 8191; const bool rowvalid = e < valid;
        bf16x8 qr[8];
#pragma unroll
        for (int d0 = 0; d0 < 8; ++d0) qr[d0] = load8(Q + (size_t)q * RS + h * 128 + d0 * 16 + hi * 8);
        float m_reg = -1e30f, l_reg = 0.f; f32x16 o[4] = {};
        moba_blk4<false>(lds, K + (size_t)(n * 256) * RS + h * 128, V + (size_t)(n * 256) * RS + h * 128, qr, moba_slope(h), n * 256, q, 0, m_reg, l_reg, o, tid, wid, lane, r32, hi);
        if (hi == 0) { li_l[r32] = l_reg; ent_l[r32] = ent | (rowvalid ? 0x8000u : 0u); } asm volatile("s_waitcnt lgkmcnt(0)" ::: "memory");
        int hi_e = hi; asm volatile("" : "+v"(hi_e));
#pragma unroll
        for (int r = 0; r < 16; ++r) { const int row = crow(r, hi_e); const float rl = __builtin_amdgcn_rcpf(li_l[row]); const unsigned er = ent_l[row];
            bf16* pb = B.po + ((size_t)(h * 8192 + (int)(er & 8191u)) * 3 + ((er >> 13) & 3u)) * 128;
            typedef unsigned u32x2 __attribute__((ext_vector_type(2)));
            const u32x2 w = {cvtpk(o[0][r] * rl, o[1][r] * rl), cvtpk(o[2][r] * rl, o[3][r] * rl)};
            if (er & 0x8000u) __builtin_nontemporal_store(w, (u32x2*)(pb + r32 * 4)); }
        if (hi == 0 && rowvalid) { float* pm = B.pml + ((size_t)(h * 8192 + q) * 3 + (ent >> 13)) * 2; pm[0] = m_reg; pm[1] = l_reg; }
    }
}
__device__ __forceinline__ void moba_own_phase(char* lds, const bf16* Q, const bf16* K, const bf16* V, bf16* O, const MobaBufs& B) {
    int tid_ = threadIdx.x; asm volatile("" : "+v"(tid_));
    const int tid = tid_, wid = __builtin_amdgcn_readfirstlane(tid >> 6), lane = tid & 63, r32 = lane & 31, hi = lane >> 5;
    constexpr float C2 = 1.4426950408889634f * Cfg<0>::SCALE;
    float* ws = (float*)(lds + OFF_WS) + wid * 64; float* li_l = ws; float* mi_l = (float*)(lds + OFF_X) + wid * 64;
    for (int item = blockIdx.x; item < 512; item += gridDim.x) {
        const int xcd = item & 7, k_ = item >> 3, h = 2 * xcd + (k_ >> 5), qb = k_ & 31, P0 = qb * QB, qpos = P0 + wid * QBLK + r32;
        bf16x8 qr[8];
#pragma unroll
        for (int d0 = 0; d0 < 8; ++d0) qr[d0] = load8(Q + (size_t)qpos * RS + h * 128 + d0 * 16 + hi * 8);
        float m_reg = -1e30f, l_reg = 0.f; f32x16 o[4] = {};
        moba_blk4<true>(lds, K + (size_t)P0 * RS + h * 128, V + (size_t)P0 * RS + h * 128, qr, moba_slope(h), P0, qpos, P0 + wid * QBLK, m_reg, l_reg, o, tid, wid, lane, r32, hi);
        if (hi == 0) { li_l[r32] = l_reg; mi_l[r32] = m_reg; } asm volatile("s_waitcnt lgkmcnt(0)" ::: "memory");
        int hi_e = hi; asm volatile("" : "+v"(hi_e));
        bf16* Ow = O + (size_t)(P0 + wid * QBLK) * RS + h * 128;
#pragma unroll
        for (int r = 0; r < 16; ++r) { const int row = crow(r, hi_e); const float l0 = li_l[row], m0 = mi_l[row];
            const size_t slot0 = (size_t)(h * 8192 + P0 + wid * QBLK + row) * 3; const float* pm = B.pml + slot0 * 2;
            const float m1 = pm[0], l1 = pm[1], m2 = pm[2], l2 = pm[3], m3 = pm[4], l3 = pm[5];
            const float M = fmaxf(fmaxf(m0, m1), fmaxf(m2, m3));
            const float e0 = __builtin_amdgcn_exp2f((m0 - M) * C2), e1 = l1 * __builtin_amdgcn_exp2f((m1 - M) * C2), e2 = l2 * __builtin_amdgcn_exp2f((m2 - M) * C2), e3 = l3 * __builtin_amdgcn_exp2f((m3 - M) * C2);
            const float rden = __builtin_amdgcn_rcpf(e0 * l0 + e1 + e2 + e3);
            typedef unsigned u32x2 __attribute__((ext_vector_type(2)));
            const u32x2* pb = (const u32x2*)(B.po + slot0 * 128) + r32;
            const u32x2 w1 = __builtin_nontemporal_load(pb), w2 = __builtin_nontemporal_load(pb + 32), w3 = __builtin_nontemporal_load(pb + 64);
            const float z1 = l1 > 0.f ? e1 : 0.f, z2 = l2 > 0.f ? e2 : 0.f, z3 = l3 > 0.f ? e3 : 0.f;
            const unsigned k1 = l1 > 0.f ? 0xffffffffu : 0u, k2 = l2 > 0.f ? 0xffffffffu : 0u, k3 = l3 > 0.f ? 0xffffffffu : 0u;
            float val[4];
#pragma unroll
            for (int d0 = 0; d0 < 4; ++d0) { float a = e0 * o[d0][r];
                const unsigned a1 = (d0 < 2 ? w1.x : w1.y) & k1, a2 = (d0 < 2 ? w2.x : w2.y) & k2, a3 = (d0 < 2 ? w3.x : w3.y) & k3;
                const float x1 = __uint_as_float((d0 & 1) ? (a1 & 0xffff0000u) : (a1 << 16)), x2 = __uint_as_float((d0 & 1) ? (a2 & 0xffff0000u) : (a2 << 16)), x3 = __uint_as_float((d0 & 1) ? (a3 & 0xffff0000u) : (a3 << 16));
                a = fmaf(z1, x1, a); a = fmaf(z2, x2, a); a = fmaf(z3, x3, a); val[d0] = a * rden; }
#pragma unroll
            for (int d0 = 0; d0 < 4; ++d0) o[d0][r] = val[d0]; }
        store_o_rows(o, lds + (wid < 4 ? OFF_V + SHM_V + wid * 4096 : OFF_K + SHM_K + (wid - 4) * 4096), Ow, RS, lane, r32, hi);
    }
}
#undef KSWZ
#undef KRSWZ
#undef SBAR
}
#define GAS __attribute__((address_space(1)))
#define LAS __attribute__((address_space(3)))
typedef unsigned short bf16;
typedef unsigned v4u __attribute__((ext_vector_type(4)));
typedef float f32x4 __attribute__((ext_vector_type(4)));
typedef short bf16x8 __attribute__((ext_vector_type(8)));
typedef GAS unsigned gu32;
typedef GAS unsigned long long gu64;
#define RLX_AGENT __ATOMIC_RELAXED, __HIP_MEMORY_SCOPE_AGENT
#define LDS_WAIT() asm volatile("s_waitcnt lgkmcnt(0)" ::: "memory")
#define VM_WAIT() asm volatile("s_waitcnt vmcnt(0)" ::: "memory")
__device__ __forceinline__ unsigned long long rt() { return __builtin_amdgcn_s_memrealtime(); }
__device__ __forceinline__ unsigned f2bf(float f) { unsigned u = __builtin_bit_cast(unsigned, f); return (u + 0x7fffu + ((u >> 16) & 1u)) >> 16; }
__device__ __forceinline__ unsigned pk2(float lo, float hi) { return f2bf(lo) | (f2bf(hi) << 16); }

#define XB_TMO      128
#define XB_XCNT(j)  (256  + 64 * (j))
#define XB_XSUB(j)  (1280 + 64 * (j))
#define XB_XGEN(j)  (2304 + 64 * (j))
#define XB_TOP      3328
#define XB_TOPGEN   3392
#define XCD_BAR_WORDS 3456
#define XB_SPIN_CAP (1u << 18)

__device__ __forceinline__ unsigned xb_ld(unsigned* p)              { return __hip_atomic_load(p, __ATOMIC_RELAXED, __HIP_MEMORY_SCOPE_AGENT); }
__device__ __forceinline__ unsigned xb_add(unsigned* p, unsigned v) { return __hip_atomic_fetch_add(p, v, __ATOMIC_RELAXED, __HIP_MEMORY_SCOPE_AGENT); }
__device__ __forceinline__ unsigned xb_xcc_id() { return (unsigned)__builtin_amdgcn_s_getreg((3 << 11) | 20) & 0xFu; }
#define XB_SPIN(cond, bar) do { unsigned _sp = 0; while (cond) { __builtin_amdgcn_s_sleep(1); \
    if ((++_sp & 255u) == 0u) { if (xb_ld(&(bar)[XB_TMO])) break; if (_sp > XB_SPIN_CAP) { atomicAdd(&(bar)[XB_TMO], 1u); break; } } } } while (0)

struct XcdBarrier {
    unsigned* bar; unsigned x;
    volatile LAS unsigned* st;
};

__device__ __forceinline__ XcdBarrier xcd_barrier_post(unsigned* bar, volatile LAS unsigned* st) {
    XcdBarrier b; b.bar = bar; b.x = xb_xcc_id(); b.st = st;
    if (threadIdx.x == 0) (void)xb_add(&bar[XB_XCNT(b.x)], 1u);
    return b;
}
__device__ __forceinline__ void xcd_barrier_complete(unsigned* bar, unsigned x, unsigned& nloc, unsigned& nx) {
    const unsigned G = gridDim.x * gridDim.y * gridDim.z;
    unsigned sum, cnt, mine, sp = 0u;
    for (;;) {
        sum = 0u; cnt = 0u; mine = 0u;
#pragma unroll
        for (unsigned j = 0; j < 16; ++j) { const unsigned c = xb_ld(&bar[XB_XCNT(j)]); sum += c; cnt += (c > 0u) ? 1u : 0u; mine = (j == x) ? c : mine; }
        if (sum == G) break;
        __builtin_amdgcn_s_sleep(1);
        if ((++sp & 255u) == 0u) { if (xb_ld(&bar[XB_TMO])) break; if (sp > XB_SPIN_CAP) { atomicAdd(&bar[XB_TMO], 1u); break; } }
    }
    nloc = mine > 0u ? mine : 1u; nx = cnt > 0u ? cnt : 1u;
}

__device__ __forceinline__ void xcd_barrier(const XcdBarrier& b) {
    asm volatile("s_waitcnt vmcnt(0)" ::: "memory");
    __syncthreads();
    if (threadIdx.x == 0) {
        unsigned* bar = b.bar;
        __builtin_amdgcn_s_waitcnt(0);
        unsigned nloc = b.st[0], nx = b.st[1];
        if (nloc == 0u) { xcd_barrier_complete(bar, b.x, nloc, nx); b.st[0] = nloc; b.st[1] = nx; }
        const unsigned old = xb_add(&bar[XB_XSUB(b.x)], 1u);
        const unsigned gen = old / nloc;
        if (old + 1u == (gen + 1u) * nloc) {
            __builtin_amdgcn_fence(__ATOMIC_RELEASE, "agent");
            asm volatile("s_waitcnt vmcnt(0)" ::: "memory");
            const unsigned og = xb_add(&bar[XB_TOP], 1u);
            const unsigned tg = og / nx;
            if (og + 1u == (tg + 1u) * nx) xb_add(&bar[XB_TOPGEN], 1u);
            else XB_SPIN(xb_ld(&bar[XB_TOPGEN]) == tg, bar);
            __builtin_amdgcn_fence(__ATOMIC_ACQUIRE, "agent");
            xb_add(&bar[XB_XGEN(b.x)], 1u);
            asm volatile("s_waitcnt vmcnt(0)" ::: "memory");
        } else {
            XB_SPIN(xb_ld(&bar[XB_XGEN(b.x)]) == gen, bar);
            __builtin_amdgcn_fence(__ATOMIC_ACQUIRE, "agent");
            asm volatile("s_waitcnt vmcnt(0)" ::: "memory");
        }
    }
    __syncthreads();
}
constexpr int NWAVES = 8;
#ifndef CONV_WAVES
#define CONV_WAVES 2
#endif
#ifndef FUSED_QUANT
#define FUSED_QUANT 1
#endif
#ifndef PROBE_REP
#define PROBE_REP 0
#endif
#define REPS(k) _Pragma("unroll 1") for (int rep_ = 0; rep_ < (PROBE_REP == (k) ? 2 : 1); ++rep_)
#ifndef MK_MULTI
#define MK_MULTI 0
#endif
#ifndef MOBA_GATHER
#define MOBA_GATHER 1
#endif
constexpr int SEQ = 8192, DM = 2048, FF = 5632, NPHASES = MOBA_GATHER ? 45 : 41;
constexpr size_t MiB = 1u << 20;
constexpr size_t WS_CTL = 0, WS_KMEAN = 1 * MiB, ZERO_BYTES = 2 * MiB;
constexpr size_t WS_SSQ = 2 * MiB, WS_SSQ_CQ = 3 * MiB, WS_SSQ_CKV = 4 * MiB, WS_COS = 5 * MiB, WS_SIN = 6 * MiB;
constexpr size_t WS_HB = 8 * MiB, WS_HID = 40 * MiB, WS_Q = 128 * MiB, WS_K = 160 * MiB, WS_V = 192 * MiB, WS_O = 224 * MiB, WS_QR = 256 * MiB, WS_KR = 272 * MiB, WS_CKV = 273 * MiB, WS_CQ = 281 * MiB;
constexpr size_t WS_FFN = 296 * MiB, FFN_SLOT = 69 * MiB, FFN_WD = 47 * MiB;
constexpr size_t WS_WQKV = 848 * MiB, WS_WO = 896 * MiB, WS_WUKV = 928 * MiB, WS_WDQ = 932 * MiB, WS_WUQ = 938 * MiB, WS_PO = 948 * MiB, WS_PML = 1044 * MiB, WS_LIST = 1048 * MiB, WS_END = 1056 * MiB;
constexpr size_t WS_AQ = 1056 * MiB, WS_ASC = 1072 * MiB, WS_AMX = 1073 * MiB, WS_END2 = 1074 * MiB;
static_assert((long)WS_AMX == pg8::EpiRes::QF_AMX && (long)WS_ASC == pg8::EpiRes::QF_ASC && (long)WS_AQ == pg8::EpiRes::QF_AQ && (long)WS_HB == pg8::EpiRes::QF_HB && (long)WS_SSQ == pg8::EpiRes::QF_SSQ && WS_CTL == 0, "fused quantisation offsets");
constexpr size_t WS_WAMAX = 256 * 1024;
constexpr size_t WS_MCNT = WS_KMEAN + 768 * 1024;
constexpr int CW_BAR = 4096, CW_CONV = 8192, CW_STRIP = 8256, CW_PCNT = 8448  ;
static_assert(CW_PCNT == pg8::EpiRes::QF_PCNT && CW_BAR + XB_TMO == pg8::EpiRes::QF_TMO && CW_PCNT + 32 * 16 <= 65536, "fused quantisation control words");
static_assert(WS_V - WS_K == WS_K - WS_Q, "q | k | v equally spaced");
constexpr int RING_OFF = 0, RING_BYTES = 131072, LDSCTL_OFF = RING_BYTES, MISC_OFF = LDSCTL_OFF + 320, RSTD_OFF = RING_BYTES + 1024, WTAB_OFF = RSTD_OFF + 8192, LDS_BYTES = 147456;
static_assert(att::LDS_BYTES <= RING_BYTES && MISC_OFF + 128 <= RSTD_OFF && WTAB_OFF + 6144 <= LDS_BYTES, "LDS map");

__device__ __forceinline__ float wave_sum(float v) {
#pragma unroll
    for (int o = 1; o < 64; o <<= 1) v += __shfl_xor(v, o);
    return v;
}
__device__ __forceinline__ int conv_src_col(int kind, int n0) {
    if (kind == 0) return n0;
    if (kind == 1) { const int pn = n0 >> 8, bj = (n0 >> 7) & 1, j = n0 & 127; return bj * FF + pn * 128 + j; }
    if (kind == 2) { if (n0 < 2048) { const int pn = n0 >> 8, hh = (n0 >> 7) & 1, j = n0 & 127; return (2 * pn + hh) * 192 + j; }
                     const int r = n0 - 2048, t = r >> 8, bj = (r >> 7) & 1, hh = (r >> 5) & 3; return (4 * t + hh) * 192 + 128 + 32 * bj; }
    if (n0 < 512) return n0; if (n0 == 512) return 512; if (n0 == 640) return 544; return -1;
}
__device__ __forceinline__ void conv_tile(const float* __restrict__ W, int K, int srcN, int N, const float* __restrict__ gain, bf16* __restrict__ WT, int kind, LAS unsigned char* wl, int lane, int it, const unsigned* __restrict__ wamax) {
    const int ngrp = N / 64, nkc = K / 128, c = lane & 15, q = lane >> 4;
    const int gs = (ngrp & 7) ? 4 : 8, g8 = it / gs, w8 = it - g8 * gs, b = g8 / nkc, kc = g8 - b * nkc, ng = ((b + kc) % (ngrp / gs)) * gs + w8;
    const int nd = ng * 64 + 4 * c, scg = conv_src_col(kind, nd & ~31);
    const bool valid = scg >= 0;
    const float* src = W + (size_t)(kc * 128 + 8 * q) * srcN + (valid ? scg + (nd & 31) : 0);
    f32x4 v[4][8], gv[4][2];
    if (gain) {
#pragma unroll
        for (int t = 0; t < 4; ++t) { gv[t][0] = *(const GAS f32x4*)(gain + kc * 128 + 8 * (q + 4 * t)); gv[t][1] = *(const GAS f32x4*)(gain + kc * 128 + 8 * (q + 4 * t) + 4); } }
#pragma unroll
    for (int t = 0; t < 4; ++t)
#pragma unroll
        for (int j = 0; j < 8; ++j) v[t][j] = __builtin_nontemporal_load((const GAS f32x4*)(src + (size_t)(32 * t + j) * srcN));
    if (kind == 3) { const float z = valid ? 1.f : 0.f;
#pragma unroll
        for (int t = 0; t < 4; ++t)
#pragma unroll
            for (int j = 0; j < 8; ++j) v[t][j] = v[t][j] * z; }
    if (gain) {
#pragma unroll
        for (int t = 0; t < 4; ++t) { const f32x4 g0 = gv[t][0], g1 = gv[t][1];
#pragma unroll
            for (int j = 0; j < 4; ++j) { v[t][j] = v[t][j] * g0[j]; v[t][4 + j] = v[t][4 + j] * g1[j]; } } }
    if (wamax) {
        const v4u ab = *(const v4u*)(wamax + nd); f32x4 sc;
#pragma unroll
        for (int i = 0; i < 4; ++i) { const float a = __uint_as_float(ab[i]); sc[i] = a > 0.f ? 127.0f / a : 0.f; }
#pragma unroll
        for (int t = 0; t < 4; ++t) { const int chunk = q + 4 * t;
#pragma unroll
            for (int i = 0; i < 4; ++i) { unsigned lo = 0u, hi2 = 0u;
#pragma unroll
                for (int j = 0; j < 4; ++j) { const int a0 = (int)__builtin_rintf(v[t][j][i] * sc[i]), a1 = (int)__builtin_rintf(v[t][4 + j][i] * sc[i]); lo |= ((unsigned)a0 & 0xffu) << (8 * j); hi2 |= ((unsigned)a1 & 0xffu) << (8 * j); }
                typedef unsigned u32x2 __attribute__((ext_vector_type(2)));
                *(LAS u32x2*)(wl + (4 * c + i) * 128 + 8 * (chunk ^ (2 * (c & 7)))) = (u32x2){lo, hi2}; } }
        LDS_WAIT(); asm volatile("" ::: "memory");
        unsigned char* dst = (unsigned char*)WT + (size_t)(ng * 64 + (lane >> 3)) * K + kc * 128 + 16 * (lane & 7); v4u ov[8];
#pragma unroll
        for (int st = 0; st < 8; ++st) { const int r = (lane >> 3) + 8 * st; ov[st] = *(const LAS v4u*)(wl + r * 128 + 8 * ((2 * (lane & 7)) ^ (2 * ((r >> 2) & 7)))); }
        LDS_WAIT(); asm volatile("" ::: "memory");
#pragma unroll
        for (int st = 0; st < 8; ++st) *(GAS v4u*)(dst + (size_t)(8 * st) * K) = ov[st];
        return;
    }
#pragma unroll
    for (int t = 0; t < 4; ++t) { const int chunk = q + 4 * t;
#pragma unroll
        for (int i = 0; i < 4; ++i) { v4u o; o.x = pg8::cvt_pk_bf16(v[t][0][i], v[t][1][i]); o.y = pg8::cvt_pk_bf16(v[t][2][i], v[t][3][i]); o.z = pg8::cvt_pk_bf16(v[t][4][i], v[t][5][i]); o.w = pg8::cvt_pk_bf16(v[t][6][i], v[t][7][i]);
            *(LAS v4u*)(wl + (4 * c + i) * 256 + 16 * (chunk ^ (c & 7))) = o; } }
    LDS_WAIT(); asm volatile("" ::: "memory");
    bf16* dst = WT + (size_t)(ng * 64 + q) * K + kc * 128 + 8 * c; v4u ov[16];
#pragma unroll
    for (int st = 0; st < 16; ++st) ov[st] = *(const LAS v4u*)(wl + (4 * st + q) * 256 + 16 * (c ^ (st & 7)));
    LDS_WAIT(); asm volatile("" ::: "memory");
#pragma unroll
    for (int st = 0; st < 16; ++st) *(GAS v4u*)(dst + (size_t)(4 * st) * K) = ov[st];
}
constexpr int IT_GU = 0, IT_D = 1408, IT_QKV = 0, IT_O = 512, IT_DKV = 0, IT_UKV = 256, IT_DQ = 192, IT_UQ = 288;
constexpr int IT_LA = 2 * IT_GU + 2 * IT_D + IT_QKV + IT_O;
constexpr int IT_L2 = 2 * IT_GU + 2 * IT_D + IT_DKV + IT_UKV + IT_DQ + IT_UQ + IT_O;
constexpr int IT_L3 = 2 * IT_GU + 2 * IT_D + IT_DQ + IT_UQ + IT_O;
constexpr int IT_B2 = 2 * IT_LA, IT_B3 = IT_B2 + IT_L2, IT_TOTAL = IT_B3 + IT_L3;
static_assert(IT_TOTAL == 40320 - 8 * 2816 - 192 - 2 * 1536, "conversion item count");
__device__ __forceinline__ int req_gu(int f) { const int l = f >> 1, w = f & 1; if (l < 2) return l * IT_LA + (w ? 2 * IT_GU + IT_D + IT_QKV + IT_O : IT_GU);
    if (l == 2) return IT_B2 + (w ? 2 * IT_GU + IT_DKV + IT_D + IT_UKV + IT_DQ + IT_UQ + IT_O : IT_GU + IT_DKV); return IT_B3 + (w ? 2 * IT_GU + IT_D + IT_DQ + IT_UQ + IT_O : IT_GU); }
__device__ __forceinline__ int req_d(int f) { return req_gu(f) + IT_D; }
__device__ __forceinline__ int req_qkv(int l) { return l * IT_LA + IT_GU + IT_D + IT_QKV; }
__device__ __forceinline__ int req_ukv() { return IT_B2 + IT_GU + IT_DKV + IT_D + IT_UKV; }
__device__ __forceinline__ int req_dq(int l) { return l == 2 ? req_ukv() + IT_DQ : IT_B3 + IT_GU + IT_D + IT_DQ; }
__device__ __forceinline__ int req_uq(int l) { return req_dq(l) + IT_UQ; }
__device__ __forceinline__ int req_o(int l) { return l < 2 ? req_qkv(l) + IT_O : req_uq(l) + IT_O; }

__device__ __forceinline__ void rstd_table_fill(LAS float* tab, const float* ssq, int fm, int tid, const float* rowfac = nullptr) {
#pragma unroll
    for (int j = 0; j < 4; ++j) { const int r = tid + 512 * j; float v = pg8::row_rstd<8>(ssq, fm * 256 + r, 1.0f / 2048.0f); if (rowfac) v *= rowfac[fm * 256 + r]; tab[r] = v; }
    __syncthreads();
}
__device__ __forceinline__ void quant_rows(const bf16* HB, signed char* AQ, float* asc, int gw, int NGW, int lane) {
    for (int m0 = gw * 4; m0 < SEQ; m0 += NGW * 4) {
        v4u w[4][4]; float mx[4];
#pragma unroll
        for (int r = 0; r < 4; ++r) { const GAS v4u* hr = (const GAS v4u*)(HB + (size_t)(m0 + r) * DM) + lane;
#pragma unroll
            for (int j = 0; j < 4; ++j) w[r][j] = hr[64 * j]; }
#pragma unroll
        for (int r = 0; r < 4; ++r) { float a = 0.f;
#pragma unroll
            for (int j = 0; j < 4; ++j)
#pragma unroll
                for (int e = 0; e < 4; ++e) { const unsigned u = w[r][j][e]; a = fmaxf(a, fmaxf(fabsf(__uint_as_float(u << 16)), fabsf(__uint_as_float(u & 0xffff0000u)))); }
            mx[r] = a; }
#pragma unroll
        for (int o = 1; o < 64; o <<= 1)
#pragma unroll
            for (int r = 0; r < 4; ++r) mx[r] = fmaxf(mx[r], __shfl_xor(mx[r], o));
#pragma unroll
        for (int r = 0; r < 4; ++r) { const float sc = mx[r] > 0.f ? 127.0f / mx[r] : 0.f;
            if (lane == 0) asc[m0 + r] = mx[r] * (1.0f / 127.0f);
            GAS unsigned long long* qo = (GAS unsigned long long*)(AQ + (size_t)(m0 + r) * DM) + lane;
#pragma unroll
            for (int j = 0; j < 4; ++j) { unsigned long long pk = 0ull;
#pragma unroll
                for (int e = 0; e < 4; ++e) { const unsigned u = w[r][j][e]; const int a0 = (int)__builtin_rintf(__uint_as_float(u << 16) * sc), a1 = (int)__builtin_rintf(__uint_as_float(u & 0xffff0000u) * sc);
                    pk |= (unsigned long long)(((unsigned)a0 & 0xffu) | (((unsigned)a1 & 0xffu) << 8)) << (16 * e); }
                qo[64 * j] = pk; } }
    }
}
__device__ __forceinline__ void wamax_job(const float* __restrict__ W, int srcN, int ncols, const float* __restrict__ gain, int kind, unsigned* __restrict__ amax, int gw, int NGW, int lane, int& rot) {
    const int ngrp = (ncols + 255) / 256, nitems = ngrp * (DM / 64);
    int w0 = gw - rot; if (w0 < 0) w0 += NGW; rot = (rot + nitems) % NGW;
    for (int it = w0; it < nitems; it += NGW) { const int kc = it / ngrp, ng = it - kc * ngrp, col = ng * 256 + 4 * lane;
        f32x4 mx = {0.f, 0.f, 0.f, 0.f};
        if (col >= ncols) continue;
#pragma unroll 8
        for (int j = 0; j < 64; ++j) { const f32x4 v = *(const GAS f32x4*)(W + (size_t)(kc * 64 + j) * srcN + col); const float g = gain[kc * 64 + j];
            mx[0] = fmaxf(mx[0], fabsf(v[0] * g)); mx[1] = fmaxf(mx[1], fabsf(v[1] * g)); mx[2] = fmaxf(mx[2], fabsf(v[2] * g)); mx[3] = fmaxf(mx[3], fabsf(v[3] * g)); }
#pragma unroll
        for (int e = 0; e < 4; ++e) { const int c = col + e; int n;
            if (kind == 1) { const int up = c >= FF, cc = up ? c - FF : c; n = (cc >> 7) * 256 + up * 128 + (cc & 127); } else { n = c < 512 ? c : 512 + ((c - 512) >> 5) * 128 + ((c - 512) & 31); }
            __hip_atomic_fetch_max(amax + n, __float_as_uint(mx[e]), __ATOMIC_RELAXED, __HIP_MEMORY_SCOPE_AGENT); } }
}
__device__ __forceinline__ void conv_strip(const float* __restrict__ W, int srcN, const float* __restrict__ gain, int kind, signed char* __restrict__ WQ, unsigned* __restrict__ wamax, int strip,
                                           LAS unsigned char* tile, LAS unsigned* mx, int tid) {
    const int c16 = tid & 15, kr = tid >> 4, nd = strip * 64 + 4 * c16, scg = conv_src_col(kind, nd & ~31);
    const bool valid = scg >= 0; const float z = valid ? 1.f : 0.f;
    const float* src = W + (size_t)(8 * kr) * srcN + (valid ? scg + (nd & 31) : 0);
    if (tid < 64) mx[tid] = 0u;
    __syncthreads();
    unsigned pk[8][4][4]; f32x4 mxl = {0.f, 0.f, 0.f, 0.f};
#pragma unroll
    for (int t = 0; t < 8; ++t) { f32x4 v[8];
        const f32x4 g0 = *(const GAS f32x4*)(gain + 8 * (kr + 32 * t)), g1 = *(const GAS f32x4*)(gain + 8 * (kr + 32 * t) + 4);
#pragma unroll
        for (int j = 0; j < 8; ++j) v[j] = __builtin_nontemporal_load((const GAS f32x4*)(src + (size_t)(256 * t + j) * srcN));
#pragma unroll
        for (int j = 0; j < 8; ++j) { v[j] = v[j] * ((j < 4 ? g0[j & 3] : g1[j & 3]) * z);
#pragma unroll
            for (int i = 0; i < 4; ++i) mxl[i] = fmaxf(mxl[i], fabsf(v[j][i])); }
#pragma unroll
        for (int jp = 0; jp < 4; ++jp)
#pragma unroll
            for (int i = 0; i < 4; ++i) pk[t][jp][i] = pg8::cvt_pk_bf16(v[2 * jp][i], v[2 * jp + 1][i]); }
#pragma unroll
    for (int i = 0; i < 4; ++i) __hip_atomic_fetch_max(mx + 4 * c16 + i, __float_as_uint(mxl[i]), __ATOMIC_RELAXED, __HIP_MEMORY_SCOPE_WORKGROUP);
    __syncthreads();
    f32x4 sc;
#pragma unroll
    for (int i = 0; i < 4; ++i) { const float a = __uint_as_float(mx[4 * c16 + i]); sc[i] = a > 0.f ? 127.0f / a : 0.f; }
    if (tid < 64) wamax[strip * 64 + tid] = mx[tid];
#pragma unroll
    for (int t = 0; t < 8; ++t)
#pragma unroll
        for (int i = 0; i < 4; ++i) { unsigned lo = 0u, hi2 = 0u;
#pragma unroll
            for (int jp = 0; jp < 4; ++jp) { const unsigned u = pk[t][jp][i]; const int a0 = (int)__builtin_rintf(__uint_as_float(u << 16) * sc[i]), a1 = (int)__builtin_rintf(__uint_as_float(u & 0xffff0000u) * sc[i]);
                const unsigned two = ((unsigned)a0 & 0xffu) | (((unsigned)a1 & 0xffu) << 8); if (jp < 2) lo |= two << (16 * jp); else hi2 |= two << (16 * (jp - 2)); }
            typedef unsigned u32x2 __attribute__((ext_vector_type(2)));
            *(LAS u32x2*)(tile + (4 * c16 + i) * 2048 + 8 * ((kr + 32 * t) ^ (2 * c16))) = (u32x2){lo, hi2}; }
    __syncthreads();
#pragma unroll 4
    for (int it = 0; it < 16; ++it) { const int id = it * 512 + tid, row = id >> 7, g = id & 127;
        const v4u o = *(const LAS v4u*)(tile + row * 2048 + 8 * ((2 * g) ^ (2 * ((row >> 2) & 15))));
        *(GAS v4u*)(WQ + (size_t)(strip * 64 + row) * 2048 + 16 * g) = o; }
    __syncthreads();
}
constexpr int ST_GU = 176, ST_DKV = 12, ST_QKV = 96, ST_TOTAL = 8 * ST_GU + ST_DKV + 2 * ST_QKV;
constexpr int SB_GU0 = 0, SB_QKV0 = SB_GU0 + ST_GU, SB_GU1 = SB_QKV0 + ST_QKV, SB_GU2 = SB_GU1 + ST_GU, SB_QKV1 = SB_GU2 + ST_GU, SB_GU3 = SB_QKV1 + ST_QKV, SB_GU4 = SB_GU3 + ST_GU, SB_DKV = SB_GU4 + ST_GU,
              SB_GU5 = SB_DKV + ST_DKV, SB_GU6 = SB_GU5 + ST_GU, SB_GU7 = SB_GU6 + ST_GU;
static_assert(SB_GU7 + ST_GU == ST_TOTAL, "strip list");
__device__ __forceinline__ int req_strip_after_up(int f) { return f == 0 ? SB_GU2 : f == 1 ? SB_QKV1 : f == 2 ? SB_GU4 : f == 3 ? SB_GU5 : f == 4 ? SB_GU6 : f == 5 ? SB_GU7 : ST_TOTAL; }
constexpr int WAMAX_QKV = 8 * 12032;
struct Args { const float* in[19]; float* out; unsigned char* ws; int ph_lo, ph_hi; };
#define WGU(f) ((bf16*)(ws + WS_FFN + (size_t)(f) * FFN_SLOT))
#define WD(f) ((bf16*)(ws + WS_FFN + (size_t)(f) * FFN_SLOT + FFN_WD))
#define WQKV(l) ((bf16*)(ws + WS_WQKV + (size_t)(l) * 24 * MiB))
#define WO(l) ((bf16*)(ws + WS_WO + (size_t)(l) * 8 * MiB))
#define WUKV ((bf16*)(ws + WS_WUKV))
#define WDQ(j) ((bf16*)(ws + WS_WDQ + (size_t)(j) * 3 * MiB))
#define WUQ(j) ((bf16*)(ws + WS_WUQ + (size_t)(j) * 5 * MiB))
__device__ __forceinline__ void conv_item(const Args& args, unsigned char* ws, LAS unsigned char* wl, int lane, int idx) {
    int i = idx, K, sN, N, kind = 0; const float* src; const float* gain = nullptr; bf16* dst; const unsigned* wam = nullptr;
#define SET_GU(f_) do { const int l_ = (f_) >> 1, w_ = (f_) & 1; src = (w_ ? args.in[6] : args.in[2]) + (size_t)l_ * DM * 2 * FF; gain = (w_ ? args.in[5] : args.in[1]) + l_ * DM; dst = WGU(f_); K = DM; sN = 2 * FF; N = 2 * FF; kind = 1; wam = (const unsigned*)(ws + WS_WAMAX) + (f_) * 12032; } while (0)
#define SET_D(f_) do { const int l_ = (f_) >> 1, w_ = (f_) & 1; src = (w_ ? args.in[7] : args.in[3]) + (size_t)l_ * FF * DM; dst = WD(f_); K = FF; sN = DM; N = DM; } while (0)
#define SET_QKV(l_) do { src = args.in[8] + (size_t)(l_) * DM * 6144; gain = args.in[4] + (l_) * DM; dst = WQKV(l_); K = DM; sN = 6144; N = 6144; } while (0)
#define SET_O(l_) do { src = (l_) < 2 ? args.in[9] + (size_t)(l_) * DM * DM : args.in[17] + (size_t)((l_) - 2) * DM * DM; dst = WO(l_); K = DM; sN = DM; N = DM; } while (0)
#define SET_DKV() do { src = args.in[11]; gain = args.in[10]; dst = (bf16*)((unsigned char*)WGU(4) + (size_t)2 * FF * DM); K = DM; sN = 576; N = 768; kind = 3; wam = (const unsigned*)(ws + WS_WAMAX) + 4 * 12032 + 2 * FF; } while (0)
#define SET_UKV() do { src = args.in[13]; gain = args.in[12]; dst = WUKV; K = 512; sN = 4096; N = 4096; } while (0)
#define SET_DQ(j_) do { src = args.in[14] + (size_t)(j_) * DM * 768; gain = args.in[4] + (2 + (j_)) * DM; dst = WDQ(j_); K = DM; sN = 768; N = 768; } while (0)
#define SET_UQ(j_) do { src = args.in[16] + (size_t)(j_) * 768 * 3072; gain = args.in[15] + (j_) * 768; dst = WUQ(j_); K = 768; sN = 3072; N = 3072; kind = 2; } while (0)
    if (i < IT_B2) { const int l = i >= IT_LA ? 1 : 0; i -= l * IT_LA;
        if (i < IT_GU) SET_GU(2 * l); else if ((i -= IT_GU) < IT_D) SET_D(2 * l); else if ((i -= IT_D) < IT_QKV) SET_QKV(l); else if ((i -= IT_QKV) < IT_O) SET_O(l);
        else if ((i -= IT_O) < IT_GU) SET_GU(2 * l + 1); else { i -= IT_GU; SET_D(2 * l + 1); } }
    else if (i < IT_B3) { i -= IT_B2;
        if (i < IT_GU) SET_GU(4); else if ((i -= IT_GU) < IT_DKV) SET_DKV(); else if ((i -= IT_DKV) < IT_D) SET_D(4); else if ((i -= IT_D) < IT_UKV) SET_UKV(); else if ((i -= IT_UKV) < IT_DQ) SET_DQ(0);
        else if ((i -= IT_DQ) < IT_UQ) SET_UQ(0); else if ((i -= IT_UQ) < IT_O) SET_O(2); else if ((i -= IT_O) < IT_GU) SET_GU(5); else { i -= IT_GU; SET_D(5); } }
    else { i -= IT_B3;
        if (i < IT_GU) SET_GU(6); else if ((i -= IT_GU) < IT_D) SET_D(6); else if ((i -= IT_D) < IT_DQ) SET_DQ(1); else if ((i -= IT_DQ) < IT_UQ) SET_UQ(1); else if ((i -= IT_UQ) < IT_O) SET_O(3);
        else if ((i -= IT_O) < IT_GU) SET_GU(7); else { i -= IT_GU; SET_D(7); } }
#undef SET_GU
#undef SET_D
#undef SET_QKV
#undef SET_O
#undef SET_DKV
#undef SET_UKV
#undef SET_DQ
#undef SET_UQ
    conv_tile(src, K, sN, N, gain, dst, kind, wl, lane, i, wam);
}
__global__ void __launch_bounds__(NWAVES * 64, 2) yoco_fwd(Args args) {
    extern __shared__ __attribute__((aligned(16))) unsigned char lds[];
    LAS unsigned char* ldsl = (LAS unsigned char*)lds;
    const int tid = threadIdx.x, lane = tid & 63, wave = __builtin_amdgcn_readfirstlane(tid >> 6), G = gridDim.x;
    unsigned char* ws = args.ws;
    gu32* ctl = (gu32*)(ws + WS_CTL);
    for (int u = tid; u < (LDS_BYTES - LDSCTL_OFF) / 4; u += NWAVES * 64) ((LAS unsigned*)(ldsl + LDSCTL_OFF))[u] = 0u;
    __syncthreads();
    XcdBarrier bar = xcd_barrier_post((unsigned*)(ctl + CW_BAR), (volatile LAS unsigned*)(ldsl + MISC_OFF) + 8);
    const int lo = args.ph_lo, hi = args.ph_hi; int seq = 0;
#define PH_RUN (seq >= lo && seq < hi)
#define PH_END do { if (seq >= lo && seq + 1 < hi) { xcd_barrier(bar); if (PROBE_REP == 8) xcd_barrier(bar); } ++seq; } while (0)
#define STRIP_DRAIN(R_, SOFT_) do { const int RS__ = (R_), RSOFT__ = (SOFT_); gu32* sc_ = ctl + CW_STRIP; volatile LAS int* sidx_ = (volatile LAS int*)(ldsl + RSTD_OFF + 512); int tq_ = threadIdx.x; asm volatile("" : "+v"(tq_)); \
        for (int nth_ = 0;; ++nth_) { const int lim_ = nth_ == 0 ? RSOFT__ : RS__;     \
            if (tq_ == 0) { int v_ = 1 << 30; if ((int)__hip_atomic_load(sc_, RLX_AGENT) < lim_) v_ = (int)__hip_atomic_fetch_add(sc_, 1u, RLX_AGENT); *sidx_ = v_; } __syncthreads(); const int si_ = *sidx_; __syncthreads(); \
            if (si_ < ST_TOTAL) { unsigned* wab_ = (unsigned*)(ws + WS_WAMAX); LAS unsigned char* tl2_ = ldsl + RING_OFF; LAS unsigned* mx_ = (LAS unsigned*)(ldsl + RSTD_OFF); \
                if ((si_ >= SB_QKV0 && si_ < SB_GU1) || (si_ >= SB_QKV1 && si_ < SB_GU3)) { const int l_ = si_ >= SB_QKV1 ? 1 : 0, ls_ = si_ - (l_ ? SB_QKV1 : SB_QKV0); \
                    conv_strip(args.in[8] + (size_t)l_ * DM * 6144, 6144, args.in[4] + l_ * DM, 0, (signed char*)WQKV(l_), wab_ + WAMAX_QKV + l_ * 6144, ls_, tl2_, mx_, tq_); } \
                else if (si_ >= SB_DKV && si_ < SB_GU5) { conv_strip(args.in[11], 576, args.in[10], 3, (signed char*)WGU(4) + (size_t)2 * FF * DM, wab_ + 4 * 12032 + 2 * FF, si_ - SB_DKV, tl2_, mx_, tq_); } \
                else { const int f_ = si_ < SB_QKV0 ? 0 : si_ < SB_GU2 ? 1 : si_ < SB_QKV1 ? 2 : si_ < SB_GU4 ? 3 : si_ < SB_DKV ? 4 : si_ < SB_GU6 ? 5 : si_ < SB_GU7 ? 6 : 7; \
                    const int base_ = f_ == 0 ? SB_GU0 : f_ == 1 ? SB_GU1 : f_ == 2 ? SB_GU2 : f_ == 3 ? SB_GU3 : f_ == 4 ? SB_GU4 : f_ == 5 ? SB_GU5 : f_ == 6 ? SB_GU6 : SB_GU7, l_ = f_ >> 1, w_ = f_ & 1; \
                    conv_strip((w_ ? args.in[6] : args.in[2]) + (size_t)l_ * DM * 2 * FF, 2 * FF, (w_ ? args.in[5] : args.in[1]) + l_ * DM, 1, (signed char*)WGU(f_), wab_ + f_ * 12032, si_ - base_, tl2_, mx_, tq_); } } \
            if (si_ + 1 >= RS__) break; } } while (0)
#define CONV_DRAIN(R_) CONV_DRAIN_W(R_, CONV_WAVES)
#define CONV_DRAIN_W(R_, NW_) do { const int R__ = (R_); gu32* cc_ = ctl + CW_CONV; LAS unsigned char* wl_ = ldsl + RING_OFF + wave * 16384; int tl_ = threadIdx.x; asm volatile("" : "+v"(tl_)); const int ln_ = tl_ & 63; \
        if (wave < (NW_) && (int)__builtin_amdgcn_readfirstlane(__hip_atomic_load(cc_, RLX_AGENT)) < R__) { for (;;) { int idx_ = 0; if (ln_ == 0) idx_ = (int)__hip_atomic_fetch_add(cc_, 1u, RLX_AGENT); idx_ = __builtin_amdgcn_readfirstlane(idx_); \
            if (idx_ < IT_TOTAL) conv_item(args, ws, wl_, ln_, idx_); if (idx_ + 1 >= R__) break; } } } while (0)
    const float* x = args.in[0]; float* out = args.out;
    float* kmean = (float*)(ws + WS_KMEAN); float* ssq = (float*)(ws + WS_SSQ); float* ssq_cq = (float*)(ws + WS_SSQ_CQ); float* ssq_ckv = (float*)(ws + WS_SSQ_CKV);
    float* cos_t = (float*)(ws + WS_COS); float* sin_t = (float*)(ws + WS_SIN);
    bf16* HB = (bf16*)(ws + WS_HB); bf16* HID = (bf16*)(ws + WS_HID); bf16* QB_ = (bf16*)(ws + WS_Q); bf16* KB_ = (bf16*)(ws + WS_K); bf16* VB_ = (bf16*)(ws + WS_V); bf16* OB = (bf16*)(ws + WS_O);
    bf16* QR = (bf16*)(ws + WS_QR); bf16* KR = (bf16*)(ws + WS_KR); bf16* CKV = (bf16*)(ws + WS_CKV); bf16* CQ = (bf16*)(ws + WS_CQ);
    const int gw = (int)blockIdx.x * NWAVES + wave, NGW = G * NWAVES;

    if (PH_RUN) REPS(1) {
        STRIP_DRAIN(SB_QKV0, req_strip_after_up(0));
        for (int m = gw; m < SEQ; m += NGW) {
            const GAS f32x4* xr = (const GAS f32x4*)(x + (size_t)m * DM) + lane; GAS unsigned long long* o8 = (GAS unsigned long long*)(HB + (size_t)m * DM) + lane; float s = 0.f, mxa = 0.f; unsigned long long hb[8];
#pragma unroll
            for (int j = 0; j < 8; ++j) { const f32x4 v = __builtin_nontemporal_load(xr + 64 * j); s += (v.x * v.x + v.y * v.y) + (v.z * v.z + v.w * v.w); const unsigned p0_ = pk2(v.x, v.y), p1_ = pk2(v.z, v.w); hb[j] = (unsigned long long)p0_ | ((unsigned long long)p1_ << 32); o8[64 * j] = hb[j];
                mxa = fmaxf(fmaxf(mxa, fmaxf(fabsf(__uint_as_float(p0_ << 16)), fabsf(__uint_as_float(p0_ & 0xffff0000u)))), fmaxf(fabsf(__uint_as_float(p1_ << 16)), fabsf(__uint_as_float(p1_ & 0xffff0000u)))); }
            s = wave_sum(s); if (lane < 32) ssq[(size_t)m * 32 + lane] = lane == 0 ? s : 0.f;
#pragma unroll
            for (int o = 1; o < 64; o <<= 1) mxa = fmaxf(mxa, __shfl_xor(mxa, o));
            const float qs = mxa > 0.f ? 127.0f / mxa : 0.f; if (lane == 0) ((float*)(ws + WS_ASC))[m] = mxa * (1.0f / 127.0f);
            GAS unsigned* q4 = (GAS unsigned*)((signed char*)(ws + WS_AQ) + (size_t)m * DM) + lane;
#pragma unroll
            for (int j = 0; j < 8; ++j) { const unsigned p0_ = (unsigned)hb[j], p1_ = (unsigned)(hb[j] >> 32);
                const int a0 = (int)__builtin_rintf(__uint_as_float(p0_ << 16) * qs), a1 = (int)__builtin_rintf(__uint_as_float(p0_ & 0xffff0000u) * qs), a2 = (int)__builtin_rintf(__uint_as_float(p1_ << 16) * qs), a3 = (int)__builtin_rintf(__uint_as_float(p1_ & 0xffff0000u) * qs);
                q4[64 * j] = ((unsigned)a0 & 0xffu) | (((unsigned)a1 & 0xffu) << 8) | (((unsigned)a2 & 0xffu) << 16) | (((unsigned)a3 & 0xffu) << 24); } }
        for (int idx = (int)blockIdx.x * 512 + tid; idx < SEQ * 32; idx += G * 512) {
            const int pos = idx >> 5, i = idx & 31;
            const float pw = (float)exp2((double)(2 * i) * (13.287712379549449 / 64.0)), inv = 1.0f / pw, ang = (float)pos * inv;
            const double a = (double)ang, q = rint(a * 0.6366197723675814), r = (a - q * 1.5707963267948966) - q * 6.123233995736766e-17, r2 = r * r;
            const double sn = r + r * r2 * (-1.0 / 6 + r2 * (1.0 / 120 + r2 * (-1.0 / 5040 + r2 * (1.0 / 362880 + r2 * (-1.0 / 39916800)))));
            const double cs = 1.0 + r2 * (-0.5 + r2 * (1.0 / 24 + r2 * (-1.0 / 720 + r2 * (1.0 / 40320 + r2 * (-1.0 / 3628800 + r2 * (1.0 / 479001600))))));
            const int qi = (int)q & 3; const double c_ = qi == 0 ? cs : qi == 1 ? -sn : qi == 2 ? -cs : sn, s_ = qi == 0 ? sn : qi == 1 ? cs : qi == 2 ? -sn : -cs;
            cos_t[idx] = (float)c_; sin_t[idx] = (float)s_; }
    }
    PH_END;
    signed char* AQ = (signed char*)(ws + WS_AQ); float* asc = (float*)(ws + WS_ASC);
    const bool fuseq = FUSED_QUANT && G == 256; unsigned qk = 0u;

    for (int f = 0; f < 8; ++f) {
        const int l = f >> 1;
        if (f > 0 && !fuseq) { if (PH_RUN) { int t4 = threadIdx.x; asm volatile("" : "+v"(t4)); quant_rows(HB, AQ, asc, gw, NGW, t4 & 63); } PH_END; }
        if (PH_RUN) REPS(4) {
            pg8::Gemm g{(const pg8::bf16_t*)AQ, (const pg8::bf16_t*)WGU(f), SEQ, f == 4 ? 2 * FF + 768 : 2 * FF, DM / 2}; pg8::StaticOrder S; S.init(SEQ, g.N, G, (int)blockIdx.x);
            LAS float* rtab = (LAS float*)(ldsl + RSTD_OFF); LAS float* wtab = (LAS float*)(ldsl + WTAB_OFF); int pn0 = 0;
            { pg8::Unit u0; if (S.next(0, u0)) { int t3 = threadIdx.x; asm volatile("" : "+v"(t3)); pn0 = u0.pn; const unsigned* wam_ = (const unsigned*)(ws + WS_WAMAX) + f * 12032;
#pragma unroll
                  for (int ui_ = 0; ui_ < 6; ++ui_) { pg8::Unit uu; if (S.next(ui_, uu) && t3 < 256) wtab[((uu.pn - pn0) >> 2) * 256 + t3] = __uint_as_float(wam_[uu.pn * 256 + t3]) * (1.0f / 127.0f); }
                  rstd_table_fill(rtab, ssq, u0.pm & ~7, t3, asc); } }
            pg8::EpiUp E{(pg8::bf16_t*)HID, rtab, 44, (pg8::bf16_t*)CKV, ssq_ckv, (pg8::bf16_t*)KR, cos_t, sin_t, wtab, pn0};
            pg8::gemm_phase<pg8::EpiUp, pg8::StaticOrder, true, true>(ldsl + RING_OFF, g, S, E);
#if PROBE_REP == 6
            { pg8::EpiNull E0; pg8::gemm_phase<pg8::EpiNull, pg8::StaticOrder, true, true>(ldsl + RING_OFF, g, S, E0); }
#endif
            __syncthreads(); if (f < 7) STRIP_DRAIN(req_strip_after_up(f), req_strip_after_up(f + 1 < 7 ? f + 1 : 6)); CONV_DRAIN(f < 7 ? req_gu(f + 1) : IT_TOTAL);
        }
        PH_END;
        if (PH_RUN) {
            pg8::Gemm g{(const pg8::bf16_t*)HID, (const pg8::bf16_t*)WD(f), SEQ, DM, FF}; pg8::StaticOrder S; S.init(SEQ, DM, G, (int)blockIdx.x);
            const bool fq_here = fuseq && ((f & 1) ? f < 7 : l < 2);
            if (fuseq && f == 7) { pg8::EpiResT<1, true> E{ws, (LAS float*)(ldsl + RSTD_OFF), args.out, args.in[18], 8u * (qk + 1u)};
                pg8::gemm_phase<pg8::EpiResT<1, true>, pg8::StaticOrder, true, true>(ldsl + RING_OFF, g, S, E); }
            else { pg8::EpiResT<1> E{ws, (LAS float*)(ldsl + RSTD_OFF), nullptr, nullptr, fq_here ? 8u * (qk + 1u) : 0u};
            pg8::gemm_phase<pg8::EpiResT<1>, pg8::StaticOrder, true, true>(ldsl + RING_OFF, g, S, E); }
        }
        PH_END;
        if (fuseq && ((f & 1) ? true : l < 2)) ++qk;
        if (f & 1) continue;
        if (l < 2) {
            if (!fuseq) { if (PH_RUN) { int t4 = threadIdx.x; asm volatile("" : "+v"(t4)); quant_rows(HB, AQ, asc, gw, NGW, t4 & 63); }
            PH_END; }
            if (PH_RUN) {
                pg8::Gemm g{(const pg8::bf16_t*)AQ, (const pg8::bf16_t*)WQKV(l), SEQ, 6144, DM / 2}; pg8::StaticOrder S; S.init(SEQ, 6144, G, (int)blockIdx.x);
                LAS float* rtab = (LAS float*)(ldsl + RSTD_OFF); LAS float* wtab = (LAS float*)(ldsl + WTAB_OFF); int pn0 = 0;
                { pg8::Unit u0; if (S.next(0, u0)) { int t3 = threadIdx.x; asm volatile("" : "+v"(t3)); pn0 = u0.pn; const unsigned* wam_ = (const unsigned*)(ws + WS_WAMAX) + WAMAX_QKV + l * 6144;
                      for (int ui_ = 0; ui_ < 3; ++ui_) { pg8::Unit uu; if (S.next(ui_, uu) && t3 < 256) wtab[((uu.pn - pn0) >> 2) * 256 + t3] = __uint_as_float(wam_[uu.pn * 256 + t3]) * (1.0f / 127.0f); }
                      rstd_table_fill(rtab, ssq, u0.pm & ~7, t3, asc); } }
                pg8::EpiQKV E{(pg8::bf16_t*)QB_, (size_t)(WS_K - WS_Q) / 2, rtab, kmean + (size_t)l * 32 * DM, wtab, pn0};
                pg8::gemm_phase<pg8::EpiQKV, pg8::StaticOrder, true, true>(ldsl + RING_OFF, g, S, E);
            }
            PH_END;
#if MOBA_GATHER
            const att::MobaBufs MB{(unsigned*)(ws + WS_MCNT) + l * 512, (unsigned short*)(ws + WS_LIST), (att::bf16*)(ws + WS_PO), (float*)(ws + WS_PML)};
            if (PH_RUN) att::moba_gate_phase((char*)lds + RING_OFF, (const att::bf16*)QB_, kmean + (size_t)l * 32 * DM, MB);
            PH_END;
            if (PH_RUN) REPS(10) att::moba_sel_phase((char*)lds + RING_OFF, (const att::bf16*)QB_, (const att::bf16*)KB_, (const att::bf16*)VB_, MB);
            PH_END;
            if (PH_RUN) REPS(11) att::moba_own_phase((char*)lds + RING_OFF, (const att::bf16*)QB_, (const att::bf16*)KB_, (const att::bf16*)VB_, (att::bf16*)OB, MB);
            PH_END;
#else
            if (PH_RUN) REPS(2) { const att::Shared GS{(const att::bf16*)KR, kmean + (size_t)l * 32 * DM};
                att::attn_phase<0>((char*)lds + RING_OFF, (const att::bf16*)QB_, (const att::bf16*)QR, (const att::bf16*)KB_, (const att::bf16*)VB_, (att::bf16*)OB, GS); }
            PH_END;
#endif
        } else {
            if (PH_RUN) {
                if (l == 2 && (int)blockIdx.x >= 96 && G == 256) {
                    pg8::Gemm g{(const pg8::bf16_t*)CKV, (const pg8::bf16_t*)WUKV, SEQ, 4096, 512}; pg8::StaticOrder S; S.init(SEQ, 4096, 160, (int)blockIdx.x - 96);
                    pg8::EpiUKV E{(pg8::bf16_t*)KB_, (pg8::bf16_t*)VB_, ssq_ckv};
                    pg8::gemm_phase<pg8::EpiUKV, pg8::StaticOrder, true, true>(ldsl + RING_OFF, g, S, E);
                } else {
                    pg8::Gemm g{(const pg8::bf16_t*)HB, (const pg8::bf16_t*)WDQ(l - 2), SEQ, 768, DM}; pg8::StaticOrder S; S.init(SEQ, 768, G, (int)blockIdx.x);
                    LAS float* rtab = (LAS float*)(ldsl + RSTD_OFF); { pg8::Unit u0; if (S.next(0, u0)) { int t3 = threadIdx.x; asm volatile("" : "+v"(t3)); rstd_table_fill(rtab, ssq, u0.pm & ~7, t3); } }
                    pg8::EpiScaled E{(pg8::bf16_t*)CQ, 768, rtab, ssq_cq};
                    pg8::gemm_phase<pg8::EpiScaled, pg8::StaticOrder, true, true>(ldsl + RING_OFF, g, S, E);
                    { pg8::Unit u1; if (!S.next(0, u1) && l == 3) { __syncthreads(); CONV_DRAIN_W(IT_TOTAL, 2); } }
                    if (l == 2 && G != 256) {
                        pg8::Gemm g2{(const pg8::bf16_t*)CKV, (const pg8::bf16_t*)WUKV, SEQ, 4096, 512}; pg8::StaticOrder S2; S2.init(SEQ, 4096, G, (int)blockIdx.x);
                        pg8::EpiUKV E2{(pg8::bf16_t*)KB_, (pg8::bf16_t*)VB_, ssq_ckv};
                        pg8::gemm_phase<pg8::EpiUKV, pg8::StaticOrder, true, true>(ldsl + RING_OFF, g2, S2, E2); }
                }
            }
            PH_END;
            if (PH_RUN) {
                pg8::Gemm g{(const pg8::bf16_t*)CQ, (const pg8::bf16_t*)WUQ(l - 2), SEQ, 3072, 768}; pg8::StaticOrder S; S.init(SEQ, 3072, G, (int)blockIdx.x);
                pg8::EpiUQ E{(pg8::bf16_t*)QB_, (pg8::bf16_t*)QR, ssq_cq, cos_t, sin_t};
                pg8::gemm_phase<pg8::EpiUQ, pg8::StaticOrder, true, true>(ldsl + RING_OFF, g, S, E);
            }
            PH_END;
            if (PH_RUN) REPS(3) { const att::Shared GS{(const att::bf16*)KR, kmean};
                att::attn_phase<1>((char*)lds + RING_OFF, (const att::bf16*)QB_, (const att::bf16*)QR, (const att::bf16*)KB_, (const att::bf16*)VB_, (att::bf16*)OB, GS); }
            PH_END;
        }
        if (PH_RUN) {
            pg8::Gemm g{(const pg8::bf16_t*)OB, (const pg8::bf16_t*)WO(l), SEQ, DM, DM}; pg8::StaticOrder S; S.init(SEQ, DM, G, (int)blockIdx.x);
            pg8::EpiResT<0> E{ws, (LAS float*)(ldsl + RSTD_OFF), nullptr, nullptr, fuseq ? 8u * (qk + 1u) : 0u};
            pg8::gemm_phase<pg8::EpiResT<0>, pg8::StaticOrder, true, true>(ldsl + RING_OFF, g, S, E);
        }
        PH_END;
        if (fuseq) ++qk;
    }
    if (PH_RUN) {
        const bool bad = xb_ld((unsigned*)(ctl + CW_BAR) + XB_TMO) != 0u; const float poison = bad ? __builtin_nanf("") : 1.0f;
        int t2 = threadIdx.x; asm volatile("" : "+v"(t2)); const int ln = t2 & 63;
        const GAS f32x4* fn = (const GAS f32x4*)args.in[18] + ln;
        int gw2 = gw; asm volatile("" : "+s"(gw2));
        for (int m = gw2; m < SEQ; m += NGW) { const float rs = pg8::row_rstd<8>(ssq, m, 1.0f / 2048.0f) * poison; GAS f32x4* o = (GAS f32x4*)(out + (size_t)m * DM) + ln;
            const GAS unsigned long long* hb8 = (const GAS unsigned long long*)(HB + (size_t)m * DM) + ln;
#pragma unroll
            for (int j = 0; j < 8; ++j) { const unsigned long long hv = hb8[64 * j]; const unsigned lo = (unsigned)hv, hi2 = (unsigned)(hv >> 32); const f32x4 gn = fn[64 * j];
                const f32x4 v = {__uint_as_float(lo << 16), __uint_as_float(lo & 0xffff0000u), __uint_as_float(hi2 << 16), __uint_as_float(hi2 & 0xffff0000u)}; __builtin_nontemporal_store(v * rs * gn, o + 64 * j); } }
    }
#undef PH_RUN
#undef PH_END
}

extern "C" void kernel_launch(void* const* d_in, const int* in_sizes, int n_in, void* d_out, int out_size, void* d_ws, size_t ws_size, hipStream_t stream) {
    static int grid = 0;
    if (grid == 0) {
        if (n_in != 19 || in_sizes[0] != SEQ * DM || out_size != SEQ * DM || ws_size < WS_END2) { fprintf(stderr, "kernel_launch: unexpected shapes (n_in %d, in0 %d, out %d, ws %zu)\n", n_in, n_in > 0 ? in_sizes[0] : -1, out_size, ws_size); grid = -1; return; }
        int dev = 0, cus = 0, per_cu = 0;
        if (hipGetDevice(&dev) != hipSuccess || hipDeviceGetAttribute(&cus, hipDeviceAttributeMultiprocessorCount, dev) != hipSuccess) { grid = -1; return; }
        if (hipFuncSetAttribute((const void*)yoco_fwd, hipFuncAttributeMaxDynamicSharedMemorySize, LDS_BYTES) != hipSuccess) { fprintf(stderr, "kernel_launch: hipFuncSetAttribute failed\n"); grid = -1; return; }
        if (hipOccupancyMaxActiveBlocksPerMultiprocessor(&per_cu, (const void*)yoco_fwd, NWAVES * 64, LDS_BYTES) != hipSuccess || per_cu < 1) { fprintf(stderr, "kernel_launch: occupancy query reports %d workgroups per CU\n", per_cu); per_cu = 1; }
        (void)hipGetLastError();
        grid = cus;
    }
    if (grid < 0) return;
    if (hipMemsetAsync((char*)d_ws + WS_CTL, 0, ZERO_BYTES, stream) != hipSuccess) return;
    Args a{};
    for (int i = 0; i < 19; ++i) a.in[i] = (const float*)d_in[i];
    a.out = (float*)d_out; a.ws = (unsigned char*)d_ws;
#if MK_MULTI
    for (int k = 0; k < NPHASES; ++k) { a.ph_lo = k; a.ph_hi = k + 1; hipLaunchKernelGGL(yoco_fwd, dim3(grid), dim3(NWAVES * 64), LDS_BYTES, stream, a); }
#else
    a.ph_lo = 0; a.ph_hi = (FUSED_QUANT && grid == 256) ? NPHASES - 10 : NPHASES;
    hipLaunchKernelGGL(yoco_fwd, dim3(grid), dim3(NWAVES * 64), LDS_BYTES, stream, a);
#endif
    const hipError_t le = hipPeekAtLastError();
    if (le != hipSuccess) fprintf(stderr, "kernel_launch: launch failed: %s\n", hipGetErrorName(le));
}
```

```cpp
#include <hip/hip_runtime.h>
#include <hip/hip_bf16.h>
#include <cstdio>
#include <cstdint>
namespace pg8 {
#define PG8_LAS __attribute__((address_space(3)))
typedef unsigned short bf16_t;
typedef short bf16x8 __attribute__((ext_vector_type(8)));
typedef float f32x4 __attribute__((ext_vector_type(4)));
typedef unsigned u32x4 __attribute__((ext_vector_type(4)));
typedef int i32x4 __attribute__((ext_vector_type(4)));
constexpr int BM = 256, BK = 64, HALF = 128, HTB = HALF * BK * 2  , STAGE_BYTES = 8 * HTB, NXCD = 8, WGM = 8;

__host__ __device__ __forceinline__ int lds_byte(int r, int c) { const int st = (r >> 4) * 2 + (c >> 5), rr = r & 15, cc = c & 31, ob = rr * 64 + cc * 2; return st * 1024 + (ob ^ (((ob >> 9) & 1) << 5)); }
__host__ __device__ __forceinline__ void stage_rc(int b, int& R, int& C) { const int st = b / 1024, sb = b % 1024, swz = sb ^ (((sb >> 9) & 1) << 5); R = (st >> 1) * 16 + swz / 64; C = (st & 1) * 32 + (swz % 64) / 2; }
__host__ __device__ __forceinline__ int perm32(int rho) { const int n = rho >> 4, i = rho & 15; return 8 * (i >> 2) + 4 * n + (i & 3); }

struct Unit { int pm, pn; };
struct Gemm { const bf16_t* A; const bf16_t* Bt; int M, N, K; };

struct StaticOrder {
    int nM, nN, nwg, G, c;
    __host__ __device__ void init(int M, int N, int G_, int c_) { nM = M / BM; nN = N / BM; nwg = nM * nN; G = G_; c = c_; }
    __host__ __device__ __forceinline__ bool next(int i, Unit& u) const {
        const long L = (long)i * G + c; if (L >= nwg) return false;
        int wgid = (int)L; { const int q = nwg / NXCD, r = nwg % NXCD, xcd = wgid % NXCD, off = wgid / NXCD; wgid = (xcd < r ? xcd * (q + 1) : r * (q + 1) + (xcd - r) * q) + off; }
        const int nig = WGM * nN, gid = wgid / nig, fm = gid * WGM, gsz = (nM - fm) < WGM ? (nM - fm) : WGM;
        u.pm = fm + ((wgid % nig) % gsz); u.pn = (wgid % nig) / gsz; return true;
    }
    __device__ __forceinline__ void a_ready(const Unit&) const {}
    __device__ __forceinline__ void done(const Unit&) const {}
};

__device__ __forceinline__ unsigned cvt_pk_bf16(float lo, float hi) { unsigned r; asm volatile("v_cvt_pk_bf16_f32 %0, %1, %2" : "=v"(r) : "v"(lo), "v"(hi)); return r; }
__device__ __forceinline__ unsigned cvt_pk_bf16_nv(float lo, float hi) { unsigned r; asm("v_cvt_pk_bf16_f32 %0, %1, %2" : "=v"(r) : "v"(lo), "v"(hi)); return r; }
__device__ __forceinline__ float smul(float a, float b) { float r; asm("v_mul_f32 %0, %1, %2" : "=v"(r) : "v"(a), "v"(b)); return r; }
__device__ __forceinline__ void smul4t(float (&r)[4], const float (&a)[4], const float (&t)[4]) {
    asm("s_nop 0\n\tv_mul_f32 %0, %4, %8\n\tv_mul_f32 %1, %5, %9\n\tv_mul_f32 %2, %6, %10\n\tv_mul_f32 %3, %7, %11"
        : "=&v"(r[0]), "=&v"(r[1]), "=&v"(r[2]), "=&v"(r[3]) : "v"(a[0]), "v"(a[1]), "v"(a[2]), "v"(a[3]), "v"(t[0]), "v"(t[1]), "v"(t[2]), "v"(t[3]));
}
__device__ __forceinline__ f32x4 smul4(f32x4 v, float r) { return (f32x4){smul(v[0], r), smul(v[1], r), smul(v[2], r), smul(v[3], r)}; }
typedef float f32x2 __attribute__((ext_vector_type(2)));
constexpr int SSQ_STRIDE = 32;
constexpr float RMS_EPS = 1e-6f;
__device__ __forceinline__ u32x4 pack8f(f32x4 a, f32x4 b) { u32x4 w; w.x = cvt_pk_bf16(a[0], a[1]); w.y = cvt_pk_bf16(a[2], a[3]); w.z = cvt_pk_bf16(b[0], b[1]); w.w = cvt_pk_bf16(b[2], b[3]); return w; }
template <int NP4> __device__ __forceinline__ float row_rstd(const float* ssq, int row, float inv_dim) {
    const f32x4* p = (const f32x4*)(ssq + (size_t)row * SSQ_STRIDE); float s = 0.f;
#pragma unroll
    for (int j = 0; j < NP4; ++j) { const f32x4 v = p[j]; s += (v[0] + v[1]) + (v[2] + v[3]); }
    return 1.0f / sqrtf(s * inv_dim + RMS_EPS);
}
template <int NP4> __device__ __forceinline__ void lane_rstd(float (&rs)[2][4], const float* ssq, int row0w, int fr, int fq, float inv_dim) {
    const float mine0 = row_rstd<NP4>(ssq, row0w + 16 * fq + fr, inv_dim), mine1 = row_rstd<NP4>(ssq, row0w + HALF + 16 * fq + fr, inv_dim);
#pragma unroll
    for (int m = 0; m < 4; ++m) { rs[0][m] = __shfl(mine0, fr + 16 * m); rs[1][m] = __shfl(mine1, fr + 16 * m); }
    asm volatile("" ::: "memory");
}
__device__ __forceinline__ void lane_rstd_tab(float (&rs)[2][4], const PG8_LAS float* tab, int rloc  ) {
#pragma unroll
    for (int ai = 0; ai < 2; ++ai)
#pragma unroll
        for (int m = 0; m < 4; ++m) rs[ai][m] = tab[rloc + ai * HALF + m * 16];
}
__device__ __forceinline__ float sumsq4(f32x4 v) { return (v[0] * v[0] + v[1] * v[1]) + (v[2] * v[2] + v[3] * v[3]); }
__device__ __forceinline__ float silu_mul(float g, float u) { return g * u * __builtin_amdgcn_rcpf(1.0f + __builtin_amdgcn_exp2f(-1.4426950408889634f * g)); }

__device__ __forceinline__ void store_scaled_tile(const f32x4 (&acc)[2][2][4][2], const float (&rs)[2][4], bf16_t* out, int ldo, int row0, int ocol0, float* ssq_out, int slot, int fq) {
#pragma unroll
    for (int ai = 0; ai < 2; ++ai)
#pragma unroll
        for (int m = 0; m < 4; ++m) { const int row = row0 + ai * HALF + m * 16; const float r = rs[ai][m]; float s = 0.f;
#pragma unroll
            for (int bj = 0; bj < 2; ++bj) { const f32x4 v0 = smul4(acc[ai][bj][m][0], r), v1 = smul4(acc[ai][bj][m][1], r); s += sumsq4(v0) + sumsq4(v1);
                *(u32x4*)(out + (size_t)row * ldo + ocol0 + bj * HALF) = pack8f(v0, v1); }
            if (ssq_out) { s += __shfl_xor(s, 16); s += __shfl_xor(s, 32); if (fq == 0) ssq_out[(size_t)row * SSQ_STRIDE + slot] = s; }
            asm volatile("" ::: "memory"); }
}

struct EpiUp {
    static constexpr bool PERM = true, AFTER_DRAIN = false, HAS_INIT = false, I8 = true;
    bf16_t* hid; const PG8_LAS float* rtab; int n_ffn;
    bf16_t* ckv; float* ssq_ckv; bf16_t* kr; const float* cos_t; const float* sin_t; const PG8_LAS float* wtab; int pn0;
    __device__ __forceinline__ void operator()(f32x4 (&acc)[2][2][4][2], const Unit& u, int wr, int wc, int fr, int fq) const {
        const int row0 = u.pm * BM + wr * 64 + fr; float rs[2][4]; lane_rstd_tab(rs, rtab, (u.pm & 7) * BM + wr * 64 + fr);
#pragma unroll
        for (int bj = 0; bj < 2; ++bj)
#pragma unroll
            for (int n = 0; n < 2; ++n) { const f32x4 wf = *(const PG8_LAS f32x4*)(wtab + ((u.pn - pn0) >> 2) * BM + bj * HALF + wc * 32 + 8 * fq + 4 * n);
#pragma unroll
                for (int ai = 0; ai < 2; ++ai)
#pragma unroll
                    for (int m = 0; m < 4; ++m) { const i32x4 iv = __builtin_bit_cast(i32x4, acc[ai][bj][m][n]); acc[ai][bj][m][n] = (f32x4){smul((float)iv.x, wf[0]), smul((float)iv.y, wf[1]), smul((float)iv.z, wf[2]), smul((float)iv.w, wf[3])}; } }
        if (u.pn < n_ffn) {
            const int col0 = u.pn * HALF + wc * 32 + 8 * fq;
#pragma unroll
            for (int ai = 0; ai < 2; ++ai)
#pragma unroll
                for (int m = 0; m < 4; ++m) { const float r = rs[ai][m], rn = r * -1.4426950408889634f, r2 = r * r;
                    f32x4 h[2];
#pragma unroll
                    for (int n = 0; n < 2; ++n) {
                        const f32x4 xg = acc[ai][0][m][n], xu = acc[ai][1][m][n]; float e[4], rc[4];
#pragma unroll
                        for (int k = 0; k < 4; ++k) e[k] = __builtin_amdgcn_exp2f(smul(xg[k], rn));
#pragma unroll
                        for (int k = 0; k < 4; ++k) rc[k] = __builtin_amdgcn_rcpf(e[k] + 1.0f);
                        float p2[4], hh[4];
#pragma unroll
                        for (int k = 0; k < 4; ++k) p2[k] = smul(smul(xg[k], xu[k]), r2);
                        smul4t(hh, p2, rc);
#pragma unroll
                        for (int k = 0; k < 4; ++k) h[n][k] = hh[k];
                    }
                    u32x4 w; w.x = cvt_pk_bf16_nv(h[0][0], h[0][1]); w.y = cvt_pk_bf16_nv(h[0][2], h[0][3]); w.z = cvt_pk_bf16_nv(h[1][0], h[1][1]); w.w = cvt_pk_bf16_nv(h[1][2], h[1][3]);
                    *(u32x4*)(hid + (size_t)(row0 + ai * HALF + m * 16) * 5632 + col0) = w; asm volatile("" ::: "memory"); __builtin_amdgcn_sched_barrier(0); }
        } else if (u.pn < n_ffn + 2) {
            const int t = u.pn - n_ffn;
            store_scaled_tile(acc, rs, ckv, 512, row0, t * BM + wc * 32 + 8 * fq, ssq_ckv, t * 4 + wc, fq);
        } else if (wc == 0) {
#pragma unroll
            for (int ai = 0; ai < 2; ++ai)
#pragma unroll
                for (int m = 0; m < 4; ++m) { const int row = row0 + ai * HALF + m * 16; const float r = rs[ai][m];
                    const f32x4 c0 = *(const f32x4*)(cos_t + (size_t)row * 32 + 8 * fq), c1 = *(const f32x4*)(cos_t + (size_t)row * 32 + 8 * fq + 4);
                    const f32x4 s0 = *(const f32x4*)(sin_t + (size_t)row * 32 + 8 * fq), s1 = *(const f32x4*)(sin_t + (size_t)row * 32 + 8 * fq + 4);
                    const f32x4 a0 = acc[ai][0][m][0] * r, a1 = acc[ai][0][m][1] * r, b0 = acc[ai][1][m][0] * r, b1 = acc[ai][1][m][1] * r;
                    *(u32x4*)(kr + (size_t)row * 64 + 8 * fq) = pack8f(a0 * c0 - b0 * s0, a1 * c1 - b1 * s1);
                    *(u32x4*)(kr + (size_t)row * 64 + 32 + 8 * fq) = pack8f(a0 * s0 + b0 * c0, a1 * s1 + b1 * c1); asm volatile("" ::: "memory"); }
        }
    }
};
template <int HALF_STEP, bool FIN = false> struct EpiResT {
    static constexpr bool PERM = true, AFTER_DRAIN = false, HAS_INIT = true, I8 = false;
    static constexpr float alpha = HALF_STEP ? 0.5f : 1.0f, inv_alpha = HALF_STEP ? 2.0f : 1.0f;
    static __device__ __forceinline__ f32x4 sa(f32x4 v) { if constexpr (HALF_STEP) return (f32x4){__builtin_ldexpf(v[0], -1), __builtin_ldexpf(v[1], -1), __builtin_ldexpf(v[2], -1), __builtin_ldexpf(v[3], -1)}; else return v; }
    static __device__ __forceinline__ f32x4 si(f32x4 v) { if constexpr (HALF_STEP) return (f32x4){__builtin_ldexpf(v[0], 1), __builtin_ldexpf(v[1], 1), __builtin_ldexpf(v[2], 1), __builtin_ldexpf(v[3], 1)}; else return v; }
    unsigned char* wsb;
    PG8_LAS float* sm;
    float* out; const float* gain;
    unsigned target;
    static constexpr long QF_MiB = 1l << 20, QF_HB = 8 * QF_MiB, QF_SSQ = 2 * QF_MiB, QF_AMX = 1073 * QF_MiB, QF_ASC = 1072 * QF_MiB, QF_AQ = 1056 * QF_MiB  , QF_PCNT = 8448, QF_TMO = 4096 + 128  ;
    __device__ __forceinline__ void init(f32x4 (&acc)[2][2][4][2], const Unit& u, int wr, int wc, int fr, int fq) const {
        const int row0 = u.pm * BM + wr * 64 + fr, col0 = u.pn * BM + wc * 32 + 8 * fq;
#pragma unroll
        for (int ai = 0; ai < 2; ++ai)
#pragma unroll
            for (int m = 0; m < 4; ++m)
#pragma unroll
                for (int bj = 0; bj < 2; ++bj) { const u32x4 rb = *(const u32x4*)((const bf16_t*)(wsb + QF_HB) + (size_t)(row0 + ai * HALF + m * 16) * 2048 + col0 + bj * HALF);
                    acc[ai][bj][m][0] = si((f32x4){__uint_as_float(rb.x << 16), __uint_as_float(rb.x & 0xffff0000u), __uint_as_float(rb.y << 16), __uint_as_float(rb.y & 0xffff0000u)});
                    acc[ai][bj][m][1] = si((f32x4){__uint_as_float(rb.z << 16), __uint_as_float(rb.z & 0xffff0000u), __uint_as_float(rb.w << 16), __uint_as_float(rb.w & 0xffff0000u)}); }
    }
    static __device__ __forceinline__ float absmax8(u32x4 w) {
        float a = fmaxf(fabsf(__uint_as_float(w.x << 16)), fabsf(__uint_as_float(w.x & 0xffff0000u)));
        a = fmaxf(a, fmaxf(fabsf(__uint_as_float(w.y << 16)), fabsf(__uint_as_float(w.y & 0xffff0000u))));
        a = fmaxf(a, fmaxf(fabsf(__uint_as_float(w.z << 16)), fabsf(__uint_as_float(w.z & 0xffff0000u))));
        return fmaxf(a, fmaxf(fabsf(__uint_as_float(w.w << 16)), fabsf(__uint_as_float(w.w & 0xffff0000u))));
    }
    static __device__ __forceinline__ unsigned q2(unsigned u, float sc) {
        const int a0 = (int)__builtin_rintf(__uint_as_float(u << 16) * sc), a1 = (int)__builtin_rintf(__uint_as_float(u & 0xffff0000u) * sc);
        return ((unsigned)a0 & 0xffu) | (((unsigned)a1 & 0xffu) << 8);
    }
    __device__ __forceinline__ void operator()(const f32x4 (&acc)[2][2][4][2], const Unit& u, int wr, int wc, int fr, int fq) const {
        const int row0 = u.pm * BM + wr * 64 + fr, col0 = u.pn * BM + wc * 32 + 8 * fq;
        const bool fuse = target != 0u; constexpr bool last = FIN;
        bf16_t* hb = (bf16_t*)(wsb + QF_HB); float* ssq = (float*)(wsb + QF_SSQ);
#pragma unroll
        for (int ai = 0; ai < 2; ++ai)
#pragma unroll
            for (int m = 0; m < 4; ++m) { const int row = row0 + ai * HALF + m * 16; float s = 0.f, mxa = 0.f;
#pragma unroll
                for (int bj = 0; bj < 2; ++bj) { const f32x4 v0 = sa(acc[ai][bj][m][0]), v1 = sa(acc[ai][bj][m][1]); s += sumsq4(v0) + sumsq4(v1);
                    const u32x4 w = pack8f(v0, v1); mxa = fmaxf(mxa, absmax8(w));
                    if (!last) *(u32x4*)(hb + (size_t)row * 2048 + col0 + bj * HALF) = w; }
                s += __shfl_xor(s, 16); s += __shfl_xor(s, 32); if (fq == 0) ssq[(size_t)row * SSQ_STRIDE + u.pn * 4 + wc] = s;
                if (fuse) { mxa = fmaxf(mxa, __shfl_xor(mxa, 16)); mxa = fmaxf(mxa, __shfl_xor(mxa, 32));
                    if (fq == 0) sm[wc * BM + wr * 64 + ai * HALF + m * 16 + fr] = last ? s : mxa; } }
        if (!fuse) return;
        __syncthreads();
        int tq = threadIdx.x; asm volatile("" : "+v"(tq));
        float* amx = (float*)(wsb + QF_AMX);
        unsigned* tmo = (unsigned*)wsb + QF_TMO;
        if (tq < 64) {
            f32x4 a = *(const PG8_LAS f32x4*)(sm + 4 * tq);
#pragma unroll
            for (int w = 1; w < 4; ++w) { const f32x4 v = *(const PG8_LAS f32x4*)(sm + w * BM + 4 * tq);
                if constexpr (last) a = a + v; else { a[0] = fmaxf(a[0], v[0]); a[1] = fmaxf(a[1], v[1]); a[2] = fmaxf(a[2], v[2]); a[3] = fmaxf(a[3], v[3]); } }
            float* dst = amx + (size_t)(u.pm * 8 + u.pn) * BM + 4 * tq;
            asm volatile("global_store_dwordx4 %0, %1, off sc1\n\ts_nop 1" :: "v"(dst), "v"(a) : "memory");
            asm volatile("s_waitcnt vmcnt(0)" ::: "memory");
            if (tq == 0) { unsigned* pc = (unsigned*)wsb + QF_PCNT + u.pm * 16;
                (void)__hip_atomic_fetch_add(pc, 1u, __ATOMIC_RELAXED, __HIP_MEMORY_SCOPE_AGENT);
                unsigned sp = 0u;
                while (__hip_atomic_load(pc, __ATOMIC_RELAXED, __HIP_MEMORY_SCOPE_AGENT) < target) { __builtin_amdgcn_s_sleep(1);
                    if ((++sp & 255u) == 0u) { if (__hip_atomic_load(tmo, __ATOMIC_RELAXED, __HIP_MEMORY_SCOPE_AGENT)) break; if (sp > (1u << 18)) { atomicAdd(tmo, 1u); break; } } }
                __builtin_amdgcn_fence(__ATOMIC_ACQUIRE, "agent");
                asm volatile("s_waitcnt vmcnt(0)" ::: "memory"); } }
        __syncthreads();
        { const f32x4 v = *(const f32x4*)(amx + (size_t)(u.pm * 8 + (tq >> 6)) * BM + 4 * (tq & 63)); *(PG8_LAS f32x4*)(sm + (tq >> 6) * BM + 4 * (tq & 63)) = v; }
        __syncthreads();
        if (tq < BM) { float a = sm[tq];
#pragma unroll
            for (int t = 1; t < 8; ++t) { if constexpr (last) a += sm[t * BM + tq]; else a = fmaxf(a, sm[t * BM + tq]); }
            if constexpr (last) { a = 1.0f / sqrtf(a * (1.0f / 2048.0f) + RMS_EPS);
                if (__hip_atomic_load(tmo, __ATOMIC_RELAXED, __HIP_MEMORY_SCOPE_AGENT) != 0u) a = __builtin_nanf(""); }
            else if (u.pn == 0) ((float*)(wsb + QF_ASC))[u.pm * BM + tq] = a * (1.0f / 127.0f);
            sm[8 * BM + tq] = a; }
        __syncthreads();
        if (!last) {
            signed char* aq = (signed char*)(wsb + QF_AQ);
#pragma unroll
            for (int ai = 0; ai < 2; ++ai)
#pragma unroll
                for (int m = 0; m < 4; ++m) { const int row = row0 + ai * HALF + m * 16; const float rm = sm[8 * BM + wr * 64 + ai * HALF + m * 16 + fr], sc = rm > 0.f ? 127.0f / rm : 0.f;
#pragma unroll
                    for (int bj = 0; bj < 2; ++bj) { const u32x4 w = pack8f(sa(acc[ai][bj][m][0]), sa(acc[ai][bj][m][1]));
                        typedef unsigned u32x2 __attribute__((ext_vector_type(2)));
                        *(u32x2*)(aq + (size_t)row * 2048 + col0 + bj * HALF) = (u32x2){q2(w.x, sc) | (q2(w.y, sc) << 16), q2(w.z, sc) | (q2(w.w, sc) << 16)}; } }
        } else {
#pragma unroll
            for (int bj = 0; bj < 2; ++bj) { const f32x4 g0 = *(const f32x4*)(gain + col0 + bj * HALF), g1 = *(const f32x4*)(gain + col0 + bj * HALF + 4);
#pragma unroll
                for (int ai = 0; ai < 2; ++ai)
#pragma unroll
                    for (int m = 0; m < 4; ++m) { const int row = row0 + ai * HALF + m * 16; const float rs = sm[8 * BM + wr * 64 + ai * HALF + m * 16 + fr] * alpha;
                        float* o = out + (size_t)row * 2048 + col0 + bj * HALF;
                        const f32x4 a0 = smul4(acc[ai][bj][m][0], rs), a1 = smul4(acc[ai][bj][m][1], rs);
                        __builtin_nontemporal_store((f32x4){smul(a0[0], g0[0]), smul(a0[1], g0[1]), smul(a0[2], g0[2]), smul(a0[3], g0[3])}, (f32x4*)o); __builtin_nontemporal_store((f32x4){smul(a1[0], g1[0]), smul(a1[1], g1[1]), smul(a1[2], g1[2]), smul(a1[3], g1[3])}, (f32x4*)(o + 4)); asm volatile("" ::: "memory"); } }
        }
    }
};
typedef EpiResT<1> EpiRes;
struct EpiQKV {
    static constexpr bool PERM = true, AFTER_DRAIN = false, HAS_INIT = false, I8 = true;
    bf16_t* qkv; size_t tstride; const PG8_LAS float* rtab; float* kmean; const PG8_LAS float* wtab; int pn0;
    __device__ __forceinline__ void operator()(f32x4 (&acc)[2][2][4][2], const Unit& u, int wr, int wc, int fr, int fq) const {
        const int row0 = u.pm * BM + wr * 64 + fr; float rs[2][4]; lane_rstd_tab(rs, rtab, (u.pm & 7) * BM + wr * 64 + fr);
#pragma unroll
        for (int bj = 0; bj < 2; ++bj)
#pragma unroll
            for (int n = 0; n < 2; ++n) { const f32x4 wf = *(const PG8_LAS f32x4*)(wtab + ((u.pn - pn0) >> 2) * BM + bj * HALF + wc * 32 + 8 * fq + 4 * n);
#pragma unroll
                for (int ai = 0; ai < 2; ++ai)
#pragma unroll
                    for (int m = 0; m < 4; ++m) { const i32x4 iv = __builtin_bit_cast(i32x4, acc[ai][bj][m][n]); acc[ai][bj][m][n] = (f32x4){smul((float)iv.x, wf[0]), smul((float)iv.y, wf[1]), smul((float)iv.z, wf[2]), smul((float)iv.w, wf[3])}; } }
        const int t = u.pn >> 3, ocol0 = (u.pn & 7) * BM + wc * 32 + 8 * fq; bf16_t* dst = qkv + (size_t)t * tstride;
        store_scaled_tile(acc, rs, dst, 2048, row0, ocol0, nullptr, 0, fq);
        if (t == 1) {
#pragma unroll
            for (int bj = 0; bj < 2; ++bj)
#pragma unroll
                for (int n = 0; n < 2; ++n)
#pragma unroll
                    for (int e = 0; e < 4; ++e) { float s = 0.f;
#pragma unroll
                        for (int ai = 0; ai < 2; ++ai)
#pragma unroll
                            for (int m = 0; m < 4; ++m) s += acc[ai][bj][m][n][e] * rs[ai][m];
                        s += __shfl_xor(s, 1); s += __shfl_xor(s, 2); s += __shfl_xor(s, 4); s += __shfl_xor(s, 8);
                        if (fr == 0) __hip_atomic_fetch_add(kmean + (size_t)u.pm * 2048 + ocol0 + bj * HALF + 4 * n + e, s, __ATOMIC_RELAXED, __HIP_MEMORY_SCOPE_AGENT); }
        }
    }
};
struct EpiScaled {
    static constexpr bool PERM = true, AFTER_DRAIN = false, HAS_INIT = false, I8 = false;
    bf16_t* out; int ldo; const PG8_LAS float* rtab; float* ssq_out;
    __device__ __forceinline__ void operator()(const f32x4 (&acc)[2][2][4][2], const Unit& u, int wr, int wc, int fr, int fq) const {
        const int row0 = u.pm * BM + wr * 64 + fr; float rs[2][4]; lane_rstd_tab(rs, rtab, (u.pm & 7) * BM + wr * 64 + fr);
        store_scaled_tile(acc, rs, out, ldo, row0, u.pn * BM + wc * 32 + 8 * fq, ssq_out, u.pn * 4 + wc, fq);
    }
};
struct EpiUQ {
    static constexpr bool PERM = true, AFTER_DRAIN = false, HAS_INIT = false, I8 = false;
    bf16_t* qn; bf16_t* qr; const float* ssq_cq; const float* cos_t; const float* sin_t;
    __device__ __forceinline__ void operator()(const f32x4 (&acc)[2][2][4][2], const Unit& u, int wr, int wc, int fr, int fq) const {
        const int row0 = u.pm * BM + wr * 64 + fr; float rs[2][4]; lane_rstd<3>(rs, ssq_cq, row0 - fr, fr, fq, 1.0f / 768.0f);
        if (u.pn < 8) { store_scaled_tile(acc, rs, qn, 2048, row0, u.pn * BM + wc * 32 + 8 * fq, nullptr, 0, fq); }
        else { const int head = (u.pn - 8) * 4 + wc;
#pragma unroll
            for (int ai = 0; ai < 2; ++ai)
#pragma unroll
                for (int m = 0; m < 4; ++m) { const int row = row0 + ai * HALF + m * 16; const float r = rs[ai][m];
                    const f32x4 c0 = *(const f32x4*)(cos_t + (size_t)row * 32 + 8 * fq), c1 = *(const f32x4*)(cos_t + (size_t)row * 32 + 8 * fq + 4);
                    const f32x4 s0 = *(const f32x4*)(sin_t + (size_t)row * 32 + 8 * fq), s1 = *(const f32x4*)(sin_t + (size_t)row * 32 + 8 * fq + 4);
                    const f32x4 a0 = acc[ai][0][m][0] * r, a1 = acc[ai][0][m][1] * r, b0 = acc[ai][1][m][0] * r, b1 = acc[ai][1][m][1] * r;
                    *(u32x4*)(qr + (size_t)row * 1024 + head * 64 + 8 * fq) = pack8f(a0 * c0 - b0 * s0, a1 * c1 - b1 * s1);
                    *(u32x4*)(qr + (size_t)row * 1024 + head * 64 + 32 + 8 * fq) = pack8f(a0 * s0 + b0 * c0, a1 * s1 + b1 * c1); asm volatile("" ::: "memory"); } }
    }
};
struct EpiNull { static constexpr bool PERM = true, AFTER_DRAIN = false, HAS_INIT = false, I8 = false;
    __device__ __forceinline__ void operator()(const f32x4 (&acc)[2][2][4][2], const Unit&, int, int, int, int) const {
#pragma unroll
        for (int a = 0; a < 2; ++a)
#pragma unroll
            for (int b = 0; b < 2; ++b)
#pragma unroll
                for (int m = 0; m < 4; ++m)
#pragma unroll
                    for (int n = 0; n < 2; ++n) asm volatile("" :: "v"(acc[a][b][m][n])); } };
struct EpiUKV {
    static constexpr bool PERM = true, AFTER_DRAIN = false, HAS_INIT = false, I8 = false;
    bf16_t* kn; bf16_t* v; const float* ssq_ckv;
    __device__ __forceinline__ void operator()(const f32x4 (&acc)[2][2][4][2], const Unit& u, int wr, int wc, int fr, int fq) const {
        const int row0 = u.pm * BM + wr * 64 + fr; float rs[2][4]; lane_rstd<2>(rs, ssq_ckv, row0 - fr, fr, fq, 1.0f / 512.0f);
        const int ocol = u.pn * HALF + wc * 32 + 8 * fq;
#pragma unroll
        for (int ai = 0; ai < 2; ++ai)
#pragma unroll
            for (int m = 0; m < 4; ++m) { const size_t off = (size_t)(row0 + ai * HALF + m * 16) * 2048 + ocol; const float r = rs[ai][m];
                *(u32x4*)(kn + off) = pack8f(acc[ai][0][m][0] * r, acc[ai][0][m][1] * r); *(u32x4*)(v + off) = pack8f(acc[ai][1][m][0] * r, acc[ai][1][m][1] * r); }
    }
};

template <class Epi, class Sched, bool ALIGN_EPI = false, bool SP2 = false>
__device__ __forceinline__ void gemm_phase(PG8_LAS unsigned char* lds, const Gemm g, const Sched& S, const Epi& E) {
    int tid_ = threadIdx.x; asm volatile("" : "+v"(tid_));
    const int tid = tid_, wid = __builtin_amdgcn_readfirstlane(tid >> 6), lane = tid & 63, wr = wid >> 2, wc = wid & 3, fr = lane & 15, fq = lane >> 4;
    const int K = g.K, nt = K / BK;
    unsigned voffA[2], voffB[2];
#pragma unroll
    for (int i = 0; i < 2; ++i) { int R, C; stage_rc(tid * 16 + i * 8192, R, C); const int Rb = Epi::PERM ? ((R & ~31) + perm32(R & 31)) : R;
        voffA[i] = (unsigned)(R * K + C) * 2u; voffB[i] = (unsigned)(Rb * K + C) * 2u; }
    const size_t kstep = (size_t)(BK * 2);
    const size_t hstep = (size_t)HALF * K * 2;
    const size_t tstep = 2 * hstep;
    const unsigned ldsw = (unsigned)wid * 1024u;
    const int aoff = lds_byte(wr * 64 + fr, fq * 8), boff = lds_byte(wc * 32 + fr, fq * 8);
#define PG8_SA(b, h) (((b) * 2 + (h)) * HTB)
#define PG8_SB(b, h) ((4 + (b) * 2 + (h)) * HTB)
#define PG8_STAGE(bufoff, gbase, voff) do { _Pragma("unroll") for (int _i = 0; _i < 2; ++_i) \
        __builtin_amdgcn_global_load_lds((const unsigned*)((const char*)(gbase) + (voff)[_i]), (PG8_LAS unsigned*)(lds + (bufoff) + ldsw + _i * 8192), 16, 0, 0); } while (0)
#define PG8_LDA(dst, b, h) do { _Pragma("unroll") for (int m = 0; m < 4; ++m) _Pragma("unroll") for (int k = 0; k < 2; ++k) dst[m][k] = *(const PG8_LAS bf16x8*)(lds + PG8_SA(b, h) + aoff + m * 2048 + k * 1024); } while (0)
#define PG8_LDB(dst, b, h) do { _Pragma("unroll") for (int n = 0; n < 2; ++n) _Pragma("unroll") for (int k = 0; k < 2; ++k) dst[n][k] = *(const PG8_LAS bf16x8*)(lds + PG8_SB(b, h) + boff + n * 2048 + k * 1024); } while (0)
#define PG8_MMA(ai, bj, At, Bt) do { __builtin_amdgcn_s_setprio(1); _Pragma("unroll") for (int m = 0; m < 4; ++m) _Pragma("unroll") for (int n = 0; n < 2; ++n) _Pragma("unroll") for (int k = 0; k < 2; ++k) { \
        if constexpr (Epi::I8) acc[ai][bj][m][n] = __builtin_bit_cast(f32x4, __builtin_amdgcn_mfma_i32_16x16x64_i8(__builtin_bit_cast(i32x4, Bt[n][k]), __builtin_bit_cast(i32x4, At[m][k]), __builtin_bit_cast(i32x4, acc[ai][bj][m][n]), 0, 0, 0)); \
        else acc[ai][bj][m][n] = __builtin_amdgcn_mfma_f32_16x16x32_bf16(Bt[n][k], At[m][k], acc[ai][bj][m][n], 0, 0, 0); } __builtin_amdgcn_s_setprio(0); } while (0)
#define PG8_WAIT_V(n) asm volatile("s_waitcnt vmcnt(" #n ")" ::: "memory")
#define PG8_WAIT_L(n) asm volatile("s_waitcnt lgkmcnt(" #n ")" ::: "memory")
#define PG8_BAR __builtin_amdgcn_s_barrier()
#define PG8_SCHED __builtin_amdgcn_sched_barrier(0)
#define PG8_INIT(unit_) do { if constexpr (Epi::HAS_INIT) { E.init(acc, (unit_), wr, wc, fr, fq); } else { _Pragma("unroll") for (int a_ = 0; a_ < 2; ++a_) _Pragma("unroll") for (int b_ = 0; b_ < 2; ++b_) _Pragma("unroll") for (int m_ = 0; m_ < 4; ++m_) _Pragma("unroll") for (int n_ = 0; n_ < 2; ++n_) acc[a_][b_][m_][n_] = (f32x4){0.f, 0.f, 0.f, 0.f}; } } while (0)
    Unit cur, nxt; int ui = 0;
    if (!S.next(0, cur)) return;
    f32x4 acc[2][2][4][2];
    bf16x8 At[4][2], B0[2][2], B1[2][2];
    const char* cA = (const char*)g.A + (size_t)cur.pm * tstep; const char* cB = (const char*)g.Bt + (size_t)cur.pn * tstep;
    S.a_ready(cur);
    if constexpr (SP2) {
        PG8_STAGE(PG8_SB(0, 0), cB, voffB); PG8_STAGE(PG8_SB(0, 1), cB + hstep, voffB); PG8_STAGE(PG8_SA(0, 0), cA, voffA); PG8_STAGE(PG8_SA(0, 1), cA + hstep, voffA);
        PG8_INIT(cur);
        if (wr == 1) PG8_BAR;
        PG8_WAIT_V(2); PG8_BAR;
        PG8_STAGE(PG8_SB(1, 0), cB + kstep, voffB); PG8_STAGE(PG8_SA(1, 0), cA + kstep, voffA); PG8_STAGE(PG8_SB(1, 1), cB + hstep + kstep, voffB);
        PG8_WAIT_V(6); PG8_BAR;
    } else {
        PG8_STAGE(PG8_SB(0, 0), cB, voffB); PG8_STAGE(PG8_SA(0, 0), cA, voffA); PG8_STAGE(PG8_SB(0, 1), cB + hstep, voffB); PG8_STAGE(PG8_SA(0, 1), cA + hstep, voffA);
        PG8_INIT(cur);
        if (wr == 1) PG8_BAR;
        PG8_WAIT_V(4); PG8_BAR;
        PG8_STAGE(PG8_SB(1, 0), cB + kstep, voffB); PG8_STAGE(PG8_SA(1, 0), cA + kstep, voffA); PG8_STAGE(PG8_SB(1, 1), cB + hstep + kstep, voffB);
        PG8_WAIT_V(6); PG8_BAR;
    }
    for (;;) {
        const bool has_next = S.next(ui + 1, nxt);
        const char* nA = has_next ? (const char*)g.A + (size_t)nxt.pm * tstep : cA; const char* nB = has_next ? (const char*)g.Bt + (size_t)nxt.pn * tstep : cB;
        for (int t = 0; t < nt; t += 2) {
            const bool last = (t == nt - 2);
            const char* a1 = cA + (size_t)(t + 1) * kstep;
            const char* a2 = last ? nA : cA + (size_t)(t + 2) * kstep; const char* b2 = last ? nB : cB + (size_t)(t + 2) * kstep;
            const char* a3 = a2 + kstep; const char* b3 = b2 + kstep;
            if (last && has_next) S.a_ready(nxt);
            if constexpr (SP2) {
            PG8_LDB(B0, 0, 0); PG8_LDB(B1, 0, 1); PG8_SCHED; PG8_LDA(At, 0, 0); PG8_STAGE(PG8_SA(1, 1), a1 + hstep, voffA);
            PG8_WAIT_V(8); PG8_WAIT_L(0); PG8_BAR; PG8_MMA(0, 0, At, B0); PG8_MMA(0, 1, At, B1); PG8_BAR; PG8_SCHED;
            PG8_LDA(At, 0, 1); PG8_STAGE(PG8_SB(0, 0), b2, voffB); PG8_STAGE(PG8_SB(0, 1), b2 + hstep, voffB); PG8_STAGE(PG8_SA(0, 0), a2, voffA);
            PG8_WAIT_V(8); PG8_WAIT_L(0); PG8_BAR; PG8_MMA(1, 0, At, B0); PG8_MMA(1, 1, At, B1); PG8_BAR; PG8_SCHED;
            PG8_LDB(B0, 1, 0); PG8_LDB(B1, 1, 1); PG8_SCHED; PG8_LDA(At, 1, 0); PG8_STAGE(PG8_SA(0, 1), a2 + hstep, voffA);
            PG8_WAIT_V(8); PG8_WAIT_L(0); PG8_BAR; PG8_MMA(0, 0, At, B0); PG8_MMA(0, 1, At, B1); PG8_BAR; PG8_SCHED;
            PG8_LDA(At, 1, 1); PG8_STAGE(PG8_SB(1, 0), b3, voffB); PG8_STAGE(PG8_SB(1, 1), b3 + hstep, voffB); PG8_STAGE(PG8_SA(1, 0), a3, voffA);
            PG8_WAIT_V(8); PG8_WAIT_L(0); PG8_BAR; PG8_MMA(1, 0, At, B0); PG8_MMA(1, 1, At, B1); PG8_BAR; PG8_SCHED;
            } else {
            PG8_LDB(B0, 0, 0); PG8_SCHED; PG8_LDA(At, 0, 0); PG8_STAGE(PG8_SA(1, 1), a1 + hstep, voffA);
            PG8_WAIT_L(8); PG8_BAR; PG8_WAIT_L(0); PG8_MMA(0, 0, At, B0); PG8_BAR; PG8_SCHED;
            PG8_LDB(B1, 0, 1); PG8_STAGE(PG8_SB(0, 0), b2, voffB);
            PG8_BAR; PG8_WAIT_L(0); PG8_MMA(0, 1, At, B1); PG8_BAR;
            PG8_LDA(At, 0, 1); PG8_STAGE(PG8_SA(0, 0), a2, voffA);
            PG8_BAR; PG8_WAIT_L(0); PG8_MMA(1, 0, At, B0); PG8_BAR; PG8_SCHED;
            PG8_STAGE(PG8_SB(0, 1), b2 + hstep, voffB);
            PG8_WAIT_V(6); PG8_BAR; PG8_MMA(1, 1, At, B1); PG8_BAR;
            PG8_LDB(B0, 1, 0); PG8_SCHED; PG8_LDA(At, 1, 0); PG8_STAGE(PG8_SA(0, 1), a2 + hstep, voffA);
            PG8_WAIT_L(8); PG8_BAR; PG8_WAIT_L(0); PG8_MMA(0, 0, At, B0); PG8_BAR; PG8_SCHED;
            PG8_LDB(B1, 1, 1); PG8_STAGE(PG8_SB(1, 0), b3, voffB);
            PG8_BAR; PG8_WAIT_L(0); PG8_MMA(0, 1, At, B1); PG8_BAR;
            PG8_LDA(At, 1, 1); PG8_STAGE(PG8_SA(1, 0), a3, voffA);
            PG8_BAR; PG8_WAIT_L(0); PG8_MMA(1, 0, At, B0); PG8_BAR; PG8_SCHED;
            PG8_STAGE(PG8_SB(1, 1), b3 + hstep, voffB);
            PG8_WAIT_V(6); PG8_BAR; PG8_MMA(1, 1, At, B1); PG8_BAR;
            }
        }
        if constexpr (ALIGN_EPI) { if (wr == 0) PG8_BAR; }
        if constexpr (!Epi::AFTER_DRAIN) { E(acc, cur, wr, wc, fr, fq); S.done(cur); }
        if (!has_next) break;
        PG8_INIT(nxt);
        cur = nxt; cA = nA; cB = nB; ++ui;
        if constexpr (ALIGN_EPI) { if (wr == 1) PG8_BAR; }
    }
    PG8_WAIT_V(0);
    if constexpr (!ALIGN_EPI) { if (wr == 0) PG8_BAR; }
    PG8_BAR;
    if constexpr (Epi::AFTER_DRAIN) { E.fused(acc, cur, wr, wc, fr, fq, lds, wid, lane); S.done(cur); }
#undef PG8_SA
#undef PG8_SB
#undef PG8_STAGE
#undef PG8_LDA
#undef PG8_LDB
#undef PG8_MMA
#undef PG8_WAIT_V
#undef PG8_WAIT_L
#undef PG8_BAR
#undef PG8_SCHED
#undef PG8_INIT
}
}
namespace att {
using bf16 = __hip_bfloat16;
typedef short bf16x8 __attribute__((ext_vector_type(8)));
typedef short s16x4 __attribute__((ext_vector_type(4)));
typedef float f32x16 __attribute__((ext_vector_type(16)));
typedef float f32x4 __attribute__((ext_vector_type(4)));
typedef unsigned u32x4 __attribute__((ext_vector_type(4)));
constexpr int NW = 8, QBLK = 32, KVBLK = 64, QB = NW * QBLK, D = 128;
constexpr int RS = 2048, RS_QR = 1024, RS_KR = 64;
constexpr int SHM_V = KVBLK * D * 2, SHM_K = KVBLK * D * 2, SHM_KR = KVBLK * 64 * 2;
constexpr int OFF_V = 0, OFF_K = 2 * SHM_V, OFF_WS = OFF_K + 2 * SHM_K, OFF_KR = OFF_WS + NW * 64 * 4, OFF_KM = OFF_KR + 2 * SHM_KR, LDS_BYTES = OFF_KM + 32 * 256;
constexpr float THR = 8.f;
template <int MODE> struct Cfg { static constexpr float SCALE = MODE == 0 ? 0.08838834764831845f : 0.07216878364870323f; static constexpr int NQ = MODE == 0 ? 8 : 12; };

#define KSWZ(row, colB) ((row) * 256 + ((colB) ^ (((row) & 7) << 4)))
#define KRSWZ(row, colB) ((row) * 128 + ((colB) ^ ((((row) >> 1) & 7) << 4)))
#define SBAR() __builtin_amdgcn_sched_barrier(0)
__device__ __forceinline__ int v_st(int k, int c) { const int kk = (k & ~0xC) | ((k & 4) << 1) | ((k & 8) >> 1); return ((kk >> 3) * 4 + (c >> 5)) * 512 + ((kk & 7) * 32 + (c & 31)) * 2; }
__device__ __forceinline__ int v_rd_base(int lane) { return ((lane & 3) << 3) | (((lane >> 2) & 3) << 6) | (((lane >> 4) & 1) << 5) | (((lane >> 5) & 1) << 8); }
constexpr int v_rd_off(int d0, int ks, int half) { return d0 * 512 + ks * 4096 + half * 2048; }
__device__ __forceinline__ int crow(int r, int hi) { return (r & 3) + 8 * (r >> 2) + 4 * hi; }
__device__ __forceinline__ unsigned cvtpk(float lo, float hi) { unsigned r; asm volatile("v_cvt_pk_bf16_f32 %0, %1, %2" : "=v"(r) : "v"(lo), "v"(hi)); return r; }
__device__ __forceinline__ bf16x8 pack8(f32x4 a, f32x4 b) { u32x4 w = {cvtpk(a[0], a[1]), cvtpk(a[2], a[3]), cvtpk(b[0], b[1]), cvtpk(b[2], b[3])}; return *reinterpret_cast<bf16x8*>(&w); }
__device__ __forceinline__ bf16x8 load8(const bf16* p) { return *reinterpret_cast<const bf16x8*>(p); }
__device__ __forceinline__ void mask_tile(f32x16& p0, f32x16& p1, int dq) {
    const float NEG = -__builtin_inff();
#pragma unroll
    for (int r = 0; r < 16; ++r) { const int c = (r & 3) + 8 * (r >> 2); if (dq - c < 0) p0[r] = NEG; if (dq - c - 32 < 0) p1[r] = NEG; }
}
template <int MODE, bool PERROW = false> __device__ __forceinline__ void partialSM(f32x16& p0, f32x16& p1, float& m_reg, float& mn, float& alpha) {
    constexpr float SCALE = Cfg<MODE>::SCALE;
    float pmax = p0[0]; for (int r = 1; r < 16; ++r) pmax = fmaxf(pmax, p0[r]); for (int r = 0; r < 16; ++r) pmax = fmaxf(pmax, p1[r]);
    { auto rr = __builtin_amdgcn_permlane32_swap(__float_as_uint(pmax), __float_as_uint(pmax), false, false);
      pmax = fmaxf(__uint_as_float(rr[0]), __uint_as_float(rr[1])); }
    constexpr float C2 = 1.4426950408889634f * SCALE;
    if constexpr (PERROW) {
        const bool keep = (pmax - m_reg) * SCALE <= THR; mn = keep ? m_reg : fmaxf(m_reg, pmax); alpha = keep ? 1.f : __builtin_amdgcn_exp2f((m_reg - mn) * C2); m_reg = mn; }
    else if (__builtin_expect(__all((pmax - m_reg) * SCALE <= THR), 1)) { mn = m_reg; alpha = 1.f; }
    else { mn = fmaxf(m_reg, pmax); alpha = __builtin_amdgcn_exp2f((m_reg - mn) * C2); m_reg = mn; }
    const float mnL = -mn * C2;
    for (int r = 0; r < 16; ++r) p0[r] = fmaf(p0[r], C2, mnL); for (int r = 0; r < 16; ++r) p1[r] = fmaf(p1[r], C2, mnL);
    for (int r = 0; r < 16; ++r) p0[r] = __builtin_amdgcn_exp2f(p0[r]);
}
__device__ __forceinline__ void finishSM(f32x16& p0, f32x16& p1, float alpha, float& l_reg, bf16x8& pa0, bf16x8& pa1, bf16x8& pa2, bf16x8& pa3) {
    for (int r = 0; r < 16; ++r) p1[r] = __builtin_amdgcn_exp2f(p1[r]);
    float ps = 0; for (int r = 0; r < 16; ++r) ps += p0[r]; for (int r = 0; r < 16; ++r) ps += p1[r];
    { auto rr = __builtin_amdgcn_permlane32_swap(__float_as_uint(ps), __float_as_uint(ps), false, false);
      ps = __uint_as_float(rr[0]) + __uint_as_float(rr[1]); }
    l_reg = l_reg * alpha + ps;
#define PK4(P, B_, OUT) do { unsigned a0 = cvtpk(P[B_+0], P[B_+1]), a1 = cvtpk(P[B_+2], P[B_+3]);                          \
        unsigned b0 = cvtpk(P[B_+4], P[B_+5]), b1 = cvtpk(P[B_+6], P[B_+7]);                                             \
        auto r0 = __builtin_amdgcn_permlane32_swap(a0, b0, false, false); auto r1 = __builtin_amdgcn_permlane32_swap(a1, b1, false, false); \
        u32x4 w = {r0[0], r1[0], r0[1], r1[1]}; OUT = *reinterpret_cast<bf16x8*>(&w); } while (0)
    PK4(p0, 0, pa0); PK4(p0, 8, pa1); PK4(p1, 0, pa2); PK4(p1, 8, pa3);
#undef PK4
}
template <int MODE, int KB>
__device__ __forceinline__ void qkt(f32x16& p0, f32x16& p1, const char* K_lds, const char* KR_lds, int r32, int hi, const bf16x8* qr, float slopeP, float tb) {
    if constexpr (MODE == 0) {
#pragma unroll
        for (int r = 0; r < 16; ++r) { const int c = (r & 3) + 8 * (r >> 2); p0[r] = fmaf(slopeP, (float)c, tb); p1[r] = fmaf(slopeP, (float)(c + 32), tb); }
    } else { p0 = f32x16{}; p1 = f32x16{}; }
    const char* kb[4];
#pragma unroll
    for (int dd = 0; dd < 4; ++dd) kb[dd] = K_lds + KB * SHM_K + KSWZ(r32, (dd * 16 + hi * 8) * 2);
    constexpr int NS = MODE == 1 ? 12 : 8;
    bf16x8 f0[2], f1[2];
#define QK_RD(d, s_) do { if ((d) < 8) { const char* a_ = kb[(d) & 3] + ((d) >> 2) * 128; f0[s_] = *reinterpret_cast<const bf16x8*>(a_); f1[s_] = *reinterpret_cast<const bf16x8*>(a_ + 32 * 256); }   \
        else { const char* a_ = KR_lds + KB * SHM_KR + KRSWZ(r32, ((((d) - 8) & 3) * 16 + hi * 8) * 2); f0[s_] = *reinterpret_cast<const bf16x8*>(a_); f1[s_] = *reinterpret_cast<const bf16x8*>(a_ + 32 * 128); } } while (0)
    QK_RD(0, 0);
#pragma unroll
    for (int d = 0; d < NS; ++d) {
        if (d + 1 < NS) QK_RD(d + 1, (d + 1) & 1);
        SBAR();
        p0 = __builtin_amdgcn_mfma_f32_32x32x16_bf16(f0[d & 1], qr[d], p0, 0, 0, 0);
        p1 = __builtin_amdgcn_mfma_f32_32x32x16_bf16(f1[d & 1], qr[d], p1, 0, 0, 0);
        SBAR();
    }
#undef QK_RD
}
template <int VB>
__device__ __forceinline__ void pv_tile(f32x16* o, int vb0, bf16x8 pa0, bf16x8 pa1, bf16x8 pa2, bf16x8 pa3) {
#define TRRD(dst, off) asm volatile("ds_read_b64_tr_b16 %0, %1 offset:%2" : "=&v"(dst) : "v"(vb0), "i"(off) : "memory")
#define PV_D0(d0) do { s16x4 l0, l1, l2, l3, h0, h1, h2, h3; constexpr int b_ = VB * SHM_V + v_rd_off(d0, 0, 0);   \
        TRRD(l0, b_); TRRD(h0, b_ + 2048); TRRD(l1, b_ + 4096); TRRD(h1, b_ + 6144); TRRD(l2, b_ + 8192); TRRD(h2, b_ + 10240); TRRD(l3, b_ + 12288); TRRD(h3, b_ + 14336); \
        asm volatile("s_waitcnt lgkmcnt(0)" ::: "memory"); SBAR();   \
        o[d0] = __builtin_amdgcn_mfma_f32_32x32x16_bf16(pa0, (bf16x8){l0[0], l0[1], l0[2], l0[3], h0[0], h0[1], h0[2], h0[3]}, o[d0], 0, 0, 0);   \
        o[d0] = __builtin_amdgcn_mfma_f32_32x32x16_bf16(pa1, (bf16x8){l1[0], l1[1], l1[2], l1[3], h1[0], h1[1], h1[2], h1[3]}, o[d0], 0, 0, 0);   \
        o[d0] = __builtin_amdgcn_mfma_f32_32x32x16_bf16(pa2, (bf16x8){l2[0], l2[1], l2[2], l2[3], h2[0], h2[1], h2[2], h2[3]}, o[d0], 0, 0, 0);   \
        o[d0] = __builtin_amdgcn_mfma_f32_32x32x16_bf16(pa3, (bf16x8){l3[0], l3[1], l3[2], l3[3], h3[0], h3[1], h3[2], h3[3]}, o[d0], 0, 0, 0); } while (0)
    PV_D0(0); PV_D0(1); PV_D0(2); PV_D0(3);
#undef PV_D0
#undef TRRD
}

__device__ __forceinline__ void store_o_rows(const f32x16* o, char* stg, bf16* Ow, size_t ldo, int lane, int r32, int hi) {
#pragma unroll
    for (int p = 0; p < 2; ++p) {
#pragma unroll
        for (int rr = 0; rr < 8; ++rr) { const int r = 8 * p + rr, lrow = (rr & 3) + 8 * (rr >> 2) + 4 * hi;
#pragma unroll
            for (int d0 = 0; d0 < 4; ++d0) *(unsigned short*)(stg + lrow * 256 + (d0 * 32 + r32) * 2) = (unsigned short)cvtpk(o[d0][r], 0.f); }
        asm volatile("s_waitcnt lgkmcnt(0)" ::: "memory");
#pragma unroll
        for (int i = 0; i < 4; ++i) { const int row = 4 * i + (lane >> 4), ch = lane & 15; const u32x4 v = *(const u32x4*)(stg + row * 256 + ch * 16);
            *(u32x4*)(Ow + (size_t)(16 * p + row) * ldo + ch * 8) = v; }
        asm volatile("s_waitcnt lgkmcnt(0)" ::: "memory");
    }
}
struct BlockRef { const bf16* Q; const bf16* QR; const bf16* K; const bf16* V; bf16* O; int P0; int h; };
template <int MODE> struct Seam { bf16x8 qr[Cfg<MODE>::NQ]; bf16x8 st_v0, st_v1, st_k0, st_k1, st_kr; };
struct Shared { const bf16* KR; const float* kmean; };

#define ROW(p, k0, rr) ((p) + (size_t)((k0) + (rr)) * RS + sc)
#define VMW() asm volatile("s_waitcnt vmcnt(0)" ::: "memory")
#define VMWN(n) asm volatile("s_waitcnt vmcnt(%0)" :: "i"(n) : "memory")
#define SLOAD_H(Kp, Vp, k0) do { S.st_v0 = load8(ROW(Vp, k0, sr)); S.st_v1 = load8(ROW(Vp, k0, 32 + sr));              \
                         S.st_k0 = load8(ROW(Kp, k0, sr)); S.st_k1 = load8(ROW(Kp, k0, 32 + sr));                       \
                         if constexpr (MODE == 1) S.st_kr = load8(G.KR + (size_t)((k0) + krr) * RS_KR + krc); } while (0)
#define SWRITE_HK(bf) do { *(bf16x8*)(K_lds + (bf) * SHM_K + kws) = S.st_k0; *(bf16x8*)(K_lds + (bf) * SHM_K + kws + 32 * 256) = S.st_k1; \
                           if constexpr (MODE == 1) *(bf16x8*)(KR_lds + (bf) * SHM_KR + krws) = S.st_kr; } while (0)
#define SWRITE_HV(bf) do { *(bf16x8*)(V_lds + (bf) * SHM_V + vst0) = S.st_v0; *(bf16x8*)(V_lds + (bf) * SHM_V + vst1) = S.st_v1; } while (0)
#define SWRITE_H(bf) do { SWRITE_HV(bf); SWRITE_HK(bf); } while (0)
#define QLOAD(Sq, ref) do { _Pragma("unroll") for (int d0 = 0; d0 < 8; ++d0) Sq.qr[d0] = load8((ref).Q + (size_t)(wid * QBLK + r32) * RS + d0 * 16 + hi * 8);    \
        if constexpr (MODE == 1) { _Pragma("unroll") for (int d0 = 0; d0 < 4; ++d0) Sq.qr[8 + d0] = load8((ref).QR + (size_t)(wid * QBLK + r32) * RS_QR + d0 * 16 + hi * 8); } } while (0)

template <int MODE>
__device__ __forceinline__ void attn_prime(const BlockRef& cur, const Shared& G, char* lds, Seam<MODE>& S) {
    int tid_ = threadIdx.x; asm volatile("" : "+v"(tid_));
    const int tid = tid_, wid = __builtin_amdgcn_readfirstlane(tid >> 6), lane = tid & 63, r32 = lane & 31, hi = lane >> 5;
    const int sr = tid >> 4, sc = (tid & 15) * 8, vst0 = v_st(sr, sc), vst1 = v_st(32 + sr, sc), kws = KSWZ(sr, sc * 2);
    char* V_lds = lds + OFF_V; char* K_lds = lds + OFF_K; char* KR_lds = lds + OFF_KR;
    const int krr = tid >> 3, krc = (tid & 7) * 8, krws = KRSWZ(krr, krc * 2);
    QLOAD(S, cur);
    SLOAD_H(cur.K, cur.V, 0); VMW(); SWRITE_H(0);
    __syncthreads();
}
template <int MODE>
__device__ __forceinline__ void attn_block(const BlockRef& cur, const BlockRef& nxt, const Shared& G, char* lds, Seam<MODE>& S) {
    constexpr float SCALE = Cfg<MODE>::SCALE;
    int tid_ = threadIdx.x; asm volatile("" : "+v"(tid_));
    const int tid = tid_, wid = __builtin_amdgcn_readfirstlane(tid >> 6), lane = tid & 63, r32 = lane & 31, hi = lane >> 5;
    const int NT = (cur.P0 + QB) / KVBLK;
    const int qlo = cur.P0 + wid * QBLK, qm = qlo + r32 - 4 * hi;
    char* V_lds = lds + OFF_V; char* K_lds = lds + OFF_K; char* KR_lds = lds + OFF_KR;
    float* ws = (float*)(lds + OFF_WS) + wid * 64; float* li_l = ws, * al_l = ws + 32;
    float m_reg = -1e30f, l_reg = 0; f32x16 o[4] = {};
    const int sr = tid >> 4, sc = (tid & 15) * 8, vst0 = v_st(sr, sc), vst1 = v_st(32 + sr, sc), kws = KSWZ(sr, sc * 2);
    const int krr = tid >> 3, krc = (tid & 7) * 8, krws = KRSWZ(krr, krc * 2);
    const int vb0 = (int)(uintptr_t)V_lds + v_rd_base(lane);
    const bf16* Kh = cur.K; const bf16* Vh = cur.V;
    unsigned selmask = 0u; float slopeP = 0.f;
    if constexpr (MODE == 0) {
        { const int e_ = cur.h + 1; slopeP = __builtin_ldexpf((e_ & 1) ? 0.70710678118654752f : 1.0f, -(e_ >> 1)) * (1.0f / SCALE); }
        { const int row = tid >> 4, c8 = (tid & 15) * 8; const float* src = G.kmean + (size_t)row * 2048 + cur.h * 128 + c8;
          const f32x4 a = *(const f32x4*)src * (1.0f / 256.0f), b = *(const f32x4*)(src + 4) * (1.0f / 256.0f);
          *(bf16x8*)(lds + OFF_KM + KSWZ(row, c8 * 2)) = pack8(a, b); }
        __syncthreads();
        f32x16 g = {};
#pragma unroll
        for (int d0 = 0; d0 < 8; ++d0) { const bf16x8 kf = *reinterpret_cast<const bf16x8*>(lds + OFF_KM + KSWZ(r32, (d0 * 16 + hi * 8) * 2)); g = __builtin_amdgcn_mfma_f32_32x32x16_bf16(kf, S.qr[d0], g, 0, 0, 0); }
        const int qb = cur.P0 >> 8; const float NEG = -__builtin_inff();
        float gv[16];
#pragma unroll
        for (int r = 0; r < 16; ++r) gv[r] = (crow(r, hi) < qb) ? g[r] : NEG;
        float a1 = NEG, a2 = NEG, a3 = NEG;
#pragma unroll
        for (int r = 0; r < 16; ++r) a1 = fmaxf(a1, gv[r]);
#pragma unroll
        for (int r = 0; r < 16; ++r) a2 = fmaxf(a2, gv[r] < a1 ? gv[r] : NEG);
#pragma unroll
        for (int r = 0; r < 16; ++r) a3 = fmaxf(a3, gv[r] < a2 ? gv[r] : NEG);
        const float b1 = __shfl_xor(a1, 32), b2 = __shfl_xor(a2, 32), b3 = __shfl_xor(a3, 32);
        const float T = fmaxf(fmaxf(a3, b3), fmaxf(fminf(a2, b1), fminf(a1, b2)));
        unsigned msk = 0u;
#pragma unroll
        for (int r = 0; r < 16; ++r) if (gv[r] >= T && crow(r, hi) < qb) msk |= 1u << crow(r, hi);
        selmask = msk | (unsigned)__shfl_xor((int)msk, 32);
    }
#define RESC(a) do { if (__any((a) < 1.f)) { if (hi == 0) al_l[r32] = (a); asm volatile("s_waitcnt lgkmcnt(0)" ::: "memory");              \
                     for (int d_ = 0; d_ < 4; ++d_) for (int r = 0; r < 16; ++r) o[d_][r] *= al_l[crow(r, hi)]; } } while (0)
#define KBASE(t) ((t) * KVBLK)
#define TB(t) (slopeP * (float)(KBASE(t) - cur.P0 + 4 * hi))
#define MASKT(P0_, P1_, t) do { const int kb_ = KBASE(t);                                                                                     \
        if (MODE == 0 && kb_ < cur.P0) { if (!((selmask >> (kb_ >> 8)) & 1u)) { const float NEG_ = -__builtin_inff();                        \
                _Pragma("unroll") for (int r = 0; r < 16; ++r) { P0_[r] = NEG_; P1_[r] = NEG_; } } }                                          \
        else if (kb_ + KVBLK - 1 > qlo) mask_tile(P0_, P1_, qm - kb_); } while (0)
    f32x16 p0, p1; float mn, al; bf16x8 pa0, pa1, pa2, pa3;
#define TILE(t, B) do {                                                                                                       \
        const bool lastt_ = (t) + 1 >= NT;                                                                                    \
        if (!lastt_) { SLOAD_H(Kh, Vh, KBASE((t) + 1)); } else { SLOAD_H(nxt.K, nxt.V, 0); }                                  \
        SBAR(); qkt<MODE, B>(p0, p1, K_lds, KR_lds, r32, hi, S.qr, slopeP, TB(t)); SBAR();                                    \
        if (lastt_) { QLOAD(S, nxt); SBAR(); }                                                                                \
        MASKT(p0, p1, (t)); partialSM<MODE>(p0, p1, m_reg, mn, al); RESC(al);                                                 \
        finishSM(p0, p1, al, l_reg, pa0, pa1, pa2, pa3); SBAR();                                                              \
        pv_tile<B>(o, vb0, pa0, pa1, pa2, pa3); SBAR();                                                                       \
        SWRITE_H((B) ^ 1);                                                                                                    \
        __syncthreads(); } while (0)
    for (int t = 0; t < NT; t += 2) { TILE(t, 0); TILE(t + 1, 1); }
    if (hi == 0) li_l[r32] = l_reg; asm volatile("s_waitcnt lgkmcnt(0)" ::: "memory");
    float rli[16];
#pragma unroll
    for (int r = 0; r < 16; ++r) rli[r] = __builtin_amdgcn_rcpf(li_l[crow(r, hi)]);
#pragma unroll
    for (int r = 0; r < 16; ++r)
#pragma unroll
        for (int d0 = 0; d0 < 4; ++d0) o[d0][r] *= rli[r];
    store_o_rows(o, lds + (wid < 4 ? OFF_V + SHM_V + wid * 4096 : OFF_K + SHM_K + (wid - 4) * 4096), cur.O + (size_t)(wid * QBLK) * RS, RS, lane, r32, hi);
    __syncthreads();
#undef RESC
#undef KBASE
#undef TB
#undef MASKT
#undef TILE
}
#undef ROW
#undef VMW
#undef VMWN
#undef SLOAD_H
#undef SWRITE_HK
#undef SWRITE_HV
#undef SWRITE_H
#undef QLOAD

__device__ __forceinline__ BlockRef mkref(const bf16* Q, const bf16* QRp, const bf16* K, const bf16* V, bf16* O, int L_, int pass) {
    const int xcd = L_ & 7, k = L_ >> 3, h = 2 * xcd + (k >> 4), s = k & 15, qb = pass ? 31 - s : s;
    BlockRef r; r.Q = Q + (size_t)qb * QB * RS + h * 128; r.QR = QRp + (size_t)qb * QB * RS_QR + h * 64; r.K = K + h * 128; r.V = V + h * 128; r.O = O + (size_t)qb * QB * RS + h * 128; r.P0 = qb * QB; r.h = h; return r;
}
template <int MODE>
__device__ __forceinline__ void attn_phase(char* lds, const bf16* Q, const bf16* QRp, const bf16* K, const bf16* V, bf16* O, const Shared& G) {
    const int total = 256, stride = gridDim.x;
    int L = blockIdx.x; if (L >= total) return;
    int pass = 0; BlockRef cur = mkref(Q, QRp, K, V, O, L, 0);
    Seam<MODE> S;
    attn_prime<MODE>(cur, G, lds, S);
    for (;;) {
        const bool more_pass = pass == 0, more_item = L + stride < total, last = !more_pass && !more_item;
        int passn = pass + 1, Ln = L;
        if (!more_pass) { passn = 0; Ln = more_item ? L + stride : L; }
        const BlockRef nxt = last ? cur : mkref(Q, QRp, K, V, O, Ln, passn);
        attn_block<MODE>(cur, nxt, G, lds, S);
        if (last) break;
        cur = nxt; pass = passn; L = Ln;
    }
}
struct MobaBufs { unsigned* cnt; unsigned short* list; bf16* po; float* pml; };
constexpr int OFF_SCAN = OFF_KM;
constexpr int OFF_X = OFF_KM + 4096;

__device__ __forceinline__ unsigned moba_top3(const f32x16& g, int qb, int hi) {
    const float NEG = -__builtin_inff(); int hi_g = hi; asm volatile("" : "+v"(hi_g));
    float gv[16];
#pragma unroll
    for (int r = 0; r < 16; ++r) gv[r] = (crow(r, hi_g) < qb) ? g[r] : NEG;
    float a1 = NEG, a2 = NEG, a3 = NEG;
#pragma unroll
    for (int r = 0; r < 16; ++r) a1 = fmaxf(a1, gv[r]);
#pragma unroll
    for (int r = 0; r < 16; ++r) a2 = fmaxf(a2, gv[r] < a1 ? gv[r] : NEG);
#pragma unroll
    for (int r = 0; r < 16; ++r) a3 = fmaxf(a3, gv[r] < a2 ? gv[r] : NEG);
    const float b1 = __shfl_xor(a1, 32), b2 = __shfl_xor(a2, 32), b3 = __shfl_xor(a3, 32);
    const float T = fmaxf(fmaxf(a3, b3), fmaxf(fminf(a2, b1), fminf(a1, b2)));
    unsigned msk = 0u;
#pragma unroll
    for (int r = 0; r < 16; ++r) if (gv[r] >= T && crow(r, hi_g) < qb) msk |= 1u << crow(r, hi_g);
    return msk | (unsigned)__shfl_xor((int)msk, 32);
}
__device__ __forceinline__ void moba_gate_phase(char* lds, const bf16* Q, const float* kmean, const MobaBufs& B) {
    int tid_ = threadIdx.x; asm volatile("" : "+v"(tid_));
    const int tid = tid_, wid = __builtin_amdgcn_readfirstlane(tid >> 6), lane = tid & 63, r32 = lane & 31, hi = lane >> 5;
    for (int item = blockIdx.x; item < 512; item += gridDim.x) {
        const int h = item >> 5, qb = item & 31;
        { const int row = tid >> 4, c8 = (tid & 15) * 8; const float* src = kmean + (size_t)row * 2048 + h * 128 + c8;
          const f32x4 a = *(const f32x4*)src * (1.0f / 256.0f), b = *(const f32x4*)(src + 4) * (1.0f / 256.0f);
          *(bf16x8*)(lds + OFF_KM + KSWZ(row, c8 * 2)) = pack8(a, b); }
        __syncthreads();
        const int q = qb * QB + wid * QBLK + r32; const bf16* Qw = Q + (size_t)q * RS + h * 128;
        f32x16 g = {};
#pragma unroll
        for (int d0 = 0; d0 < 8; ++d0) { const bf16x8 kf = *reinterpret_cast<const bf16x8*>(lds + OFF_KM + KSWZ(r32, (d0 * 16 + hi * 8) * 2)); g = __builtin_amdgcn_mfma_f32_32x32x16_bf16(kf, load8(Qw + d0 * 16 + hi * 8), g, 0, 0, 0); }
        const unsigned m = moba_top3(g, qb, hi);
        unsigned* lcnt = (unsigned*)(lds + OFF_WS); unsigned* gbase = lcnt + 32;
        if (tid < 32) lcnt[tid] = 0u;
        __syncthreads();
        unsigned pk[3] = {0u, 0u, 0u}; int npk = 0;
        if (hi == 0) { unsigned mm = m;
#pragma unroll
            for (int jj = 0; jj < 3; ++jj) if (mm) { const int n = __builtin_ctz(mm); mm &= mm - 1u; const unsigned lr = __hip_atomic_fetch_add(lcnt + n, 1u, __ATOMIC_RELAXED, __HIP_MEMORY_SCOPE_WORKGROUP); pk[jj] = (unsigned)n | (lr << 8); npk = jj + 1; } }
        __syncthreads();
        if (tid < 32) { const unsigned c = lcnt[tid]; gbase[tid] = c ? __hip_atomic_fetch_add(B.cnt + h * 32 + tid, c, __ATOMIC_RELAXED, __HIP_MEMORY_SCOPE_AGENT) : 0u; }
        __syncthreads();
        if (hi == 0) {
            float* pm = B.pml + ((size_t)(h * 8192 + q) * 3) * 2;
            float ninf_ = -1e30f, zero_ = 0.f; asm volatile("" : "+v"(ninf_), "+v"(zero_));
#pragma unroll
            for (int jj = 0; jj < 3; ++jj) { pm[2 * jj] = ninf_; pm[2 * jj + 1] = zero_; }
#pragma unroll
            for (int jj = 0; jj < 3; ++jj) if (jj < npk) { const int n = pk[jj] & 31u; B.list[(size_t)(h * 32 + n) * 8192 + gbase[n] + (pk[jj] >> 8)] = (unsigned short)(q | (jj << 13)); }
        }
        __syncthreads();
    }
}
template <bool CAUSAL>
__device__ __forceinline__ void moba_blk4(char* lds, const bf16* Kb, const bf16* Vb, const bf16x8* qr, float slopeP, int kabs0, int qpos, int qlo, float& m_reg, float& l_reg, f32x16* o,
                                          int tid, int wid, int lane, int r32, int hi) {
    char* V_lds = lds + OFF_V; char* K_lds = lds + OFF_K; float* al_l = (float*)(lds + OFF_WS) + wid * 64 + 32;
    const int sr = tid >> 4, sc = (tid & 15) * 8, vst0 = v_st(sr, sc), vst1 = v_st(32 + sr, sc), kws = KSWZ(sr, sc * 2);
    const unsigned soff0 = (unsigned)(sr * RS + sc), soff1 = soff0 + 32u * RS;
    const int vb0 = (int)(uintptr_t)V_lds + v_rd_base(lane);
    const float tb0 = slopeP * (float)(kabs0 + 4 * hi - qpos); const int qm = qpos - 4 * hi;
    bf16x8 st_v0, st_v1, st_k0, st_k1; f32x16 p0, p1; float mn, al; bf16x8 pa0, pa1, pa2, pa3;
#define LOADT(t) do { const bf16* kb_ = Kb + (size_t)((t) * KVBLK) * RS; const bf16* vb_ = Vb + (size_t)((t) * KVBLK) * RS; st_v0 = load8(vb_ + soff0); st_v1 = load8(vb_ + soff1); st_k0 = load8(kb_ + soff0); st_k1 = load8(kb_ + soff1); } while (0)
#define WRITET(bf) do { *(bf16x8*)(V_lds + (bf) * SHM_V + vst0) = st_v0; *(bf16x8*)(V_lds + (bf) * SHM_V + vst1) = st_v1; *(bf16x8*)(K_lds + (bf) * SHM_K + kws) = st_k0; *(bf16x8*)(K_lds + (bf) * SHM_K + kws + 32 * 256) = st_k1; } while (0)
#define RESC4(a) do { if (__any((a) < 1.f)) { if (hi == 0) al_l[r32] = (a); asm volatile("s_waitcnt lgkmcnt(0)" ::: "memory"); int hi_r = hi; asm volatile("" : "+v"(hi_r));   \
                      for (int d_ = 0; d_ < 4; ++d_) for (int r = 0; r < 16; ++r) o[d_][r] *= al_l[crow(r, hi_r)]; } } while (0)
#define T4(t, Bf) do { if ((t) < 3) LOADT((t) + 1);                                                                                           \
        SBAR(); qkt<0, Bf>(p0, p1, K_lds, K_lds, r32, hi, qr, slopeP, tb0 + slopeP * (float)((t) * KVBLK)); SBAR();                           \
        if (CAUSAL) { const int kb_ = kabs0 + (t) * KVBLK; if (kb_ + KVBLK - 1 > qlo) mask_tile(p0, p1, qm - kb_); }                          \
        partialSM<0, true>(p0, p1, m_reg, mn, al); RESC4(al); finishSM(p0, p1, al, l_reg, pa0, pa1, pa2, pa3); SBAR();                              \
        pv_tile<Bf>(o, vb0, pa0, pa1, pa2, pa3); SBAR();                                                                                      \
        if ((t) < 3) WRITET((Bf) ^ 1);                                                                                                        \
        __syncthreads(); } while (0)
    LOADT(0); WRITET(0); __syncthreads();
    T4(0, 0); T4(1, 1); T4(2, 0); T4(3, 1);
#undef LOADT
#undef WRITET
#undef RESC4
#undef T4
}
__device__ __forceinline__ float moba_slope(int h) { const int e_ = h + 1; return __builtin_ldexpf((e_ & 1) ? 0.70710678118654752f : 1.0f, -(e_ >> 1)) * (1.0f / Cfg<0>::SCALE); }
__device__ __forceinline__ void moba_sel_phase(char* lds, const bf16* Q, const bf16* K, const bf16* V, const MobaBufs& B) {
    int tid_ = threadIdx.x; asm volatile("" : "+v"(tid_));
    const int tid = tid_, wid = __builtin_amdgcn_readfirstlane(tid >> 6), lane = tid & 63, r32 = lane & 31, hi = lane >> 5;
    unsigned* pre = (unsigned*)(lds + OFF_SCAN);
    { unsigned v = (B.cnt[tid] + 255u) >> 8;
#pragma unroll
      for (int o_ = 1; o_ < 64; o_ <<= 1) { const unsigned t = (unsigned)__shfl_up((int)v, o_); if (lane >= o_) v += t; }
      if (lane == 63) pre[512 + wid] = v;
      __syncthreads();
      unsigned off = 0u;
#pragma unroll
      for (int w = 0; w < 8; ++w) off += (w < wid) ? pre[512 + w] : 0u;
      pre[tid] = v + off; __syncthreads(); }
    const unsigned U = pre[511];
    float* ws = (float*)(lds + OFF_WS) + wid * 64; float* li_l = ws; unsigned* ent_l = (unsigned*)(lds + OFF_X) + wid * 64;
    for (unsigned u = blockIdx.x; u < U; u += gridDim.x) {
        int lo_ = 0, hi_ = 511; while (lo_ < hi_) { const int mid = (lo_ + hi_) >> 1; if (pre[mid] > u) hi_ = mid; else lo_ = mid + 1; }
        const int b = __builtin_amdgcn_readfirstlane(lo_), h = b >> 5, n = b & 31, slice = (int)(u - (b ? pre[b - 1] : 0u));
        const int cntb = (int)B.cnt[b]; int valid = cntb - slice * 256; if (valid > 256) valid = 256;
        const int e = wid * QBLK + r32; const unsigned ent = B.list[(size_t)b * 8192 + slice * 256 + (e < valid ? e : valid - 1)];
        const int q = ent & 8191; const bool rowvalid = e < valid;
        bf16x8 qr[8];
#pragma unroll
        for (int d0 = 0; d0 < 8; ++d0) qr[d0] = load8(Q + (size_t)q * RS + h * 128 + d0 * 16 + hi * 8);
        float m_reg = -1e30f, l_reg = 0.f; f32x16 o[4] = {};
        moba_blk4<false>(lds, K + (size_t)(n * 256) * RS + h * 128, V + (size_t)(n * 256) * RS + h * 128, qr, moba_slope(h), n * 256, q, 0, m_reg, l_reg, o, tid, wid, lane, r32, hi);
        if (hi == 0) { li_l[r32] = l_reg; ent_l[r32] = ent | (rowvalid ? 0x8000u : 0u); } asm volatile("s_waitcnt lgkmcnt(0)" ::: "memory");
        int hi_e = hi; asm volatile("" : "+v"(hi_e));
#pragma unroll
        for (int r = 0; r < 16; ++r) { const int row = crow(r, hi_e); const float rl = __builtin_amdgcn_rcpf(li_l[row]); const unsigned er = ent_l[row];
            bf16* pb = B.po + ((size_t)(h * 8192 + (int)(er & 8191u)) * 3 + ((er >> 13) & 3u)) * 128;
            typedef unsigned u32x2 __attribute__((ext_vector_type(2)));
            const u32x2 w = {cvtpk(o[0][r] * rl, o[1][r] * rl), cvtpk(o[2][r] * rl, o[3][r] * rl)};
            if (er & 0x8000u) __builtin_nontemporal_store(w, (u32x2*)(pb + r32 * 4)); }
        if (hi == 0 && rowvalid) { float* pm = B.pml + ((size_t)(h * 8192 + q) * 3 + (ent >> 13)) * 2; pm[0] = m_reg; pm[1] = l_reg; }
    }
}
__device__ __forceinline__ void moba_own_phase(char* lds, const bf16* Q, const bf16* K, const bf16* V, bf16* O, const MobaBufs& B) {
    int tid_ = threadIdx.x; asm volatile("" : "+v"(tid_));
    const int tid = tid_, wid = __builtin_amdgcn_readfirstlane(tid >> 6), lane = tid & 63, r32 = lane & 31, hi = lane >> 5;
    constexpr float C2 = 1.4426950408889634f * Cfg<0>::SCALE;
    float* ws = (float*)(lds + OFF_WS) + wid * 64; float* li_l = ws; float* mi_l = (float*)(lds + OFF_X) + wid * 64;
    for (int item = blockIdx.x; item < 512; item += gridDim.x) {
        const int xcd = item & 7, k_ = item >> 3, h = 2 * xcd + (k_ >> 5), qb = k_ & 31, P0 = qb * QB, qpos = P0 + wid * QBLK + r32;
        bf16x8 qr[8];
#pragma unroll
        for (int d0 = 0; d0 < 8; ++d0) qr[d0] = load8(Q + (size_t)qpos * RS + h * 128 + d0 * 16 + hi * 8);
        float m_reg = -1e30f, l_reg = 0.f; f32x16 o[4] = {};
        moba_blk4<true>(lds, K + (size_t)P0 * RS + h * 128, V + (size_t)P0 * RS + h * 128, qr, moba_slope(h), P0, qpos, P0 + wid * QBLK, m_reg, l_reg, o, tid, wid, lane, r32, hi);
        if (hi == 0) { li_l[r32] = l_reg; mi_l[r32] = m_reg; } asm volatile("s_waitcnt lgkmcnt(0)" ::: "memory");
        int hi_e = hi; asm volatile("" : "+v"(hi_e));
        bf16* Ow = O + (size_t)(P0 + wid * QBLK) * RS + h * 128;
#pragma unroll
        for (int r = 0; r < 16; ++r) { const int row = crow(r, hi_e); const float l0 = li_l[row], m0 = mi_l[row];
            const size_t slot0 = (size_t)(h * 8192 + P0 + wid * QBLK + row) * 3; const float* pm = B.pml + slot0 * 2;
            const float m1 = pm[0], l1 = pm[1], m2 = pm[2], l2 = pm[3], m3 = pm[4], l3 = pm[5];
            const float M = fmaxf(fmaxf(m0, m1), fmaxf(m2, m3));
            const float e0 = __builtin_amdgcn_exp2f((m0 - M) * C2), e1 = l1 * __builtin_amdgcn_exp2f((m1 - M) * C2), e2 = l2 * __builtin_amdgcn_exp2f((m2 - M) * C2), e3 = l3 * __builtin_amdgcn_exp2f((m3 - M) * C2);
            const float rden = __builtin_amdgcn_rcpf(e0 * l0 + e1 + e2 + e3);
            typedef unsigned u32x2 __attribute__((ext_vector_type(2)));
            const u32x2* pb = (const u32x2*)(B.po + slot0 * 128) + r32;
            const u32x2 w1 = __builtin_nontemporal_load(pb), w2 = __builtin_nontemporal_load(pb + 32), w3 = __builtin_nontemporal_load(pb + 64);
            const float z1 = l1 > 0.f ? e1 : 0.f, z2 = l2 > 0.f ? e2 : 0.f, z3 = l3 > 0.f ? e3 : 0.f;
            const unsigned k1 = l1 > 0.f ? 0xffffffffu : 0u, k2 = l2 > 0.f ? 0xffffffffu : 0u, k3 = l3 > 0.f ? 0xffffffffu : 0u;
            float val[4];
#pragma unroll
            for (int d0 = 0; d0 < 4; ++d0) { float a = e0 * o[d0][r];
                const unsigned a1 = (d0 < 2 ? w1.x : w1.y) & k1, a2 = (d0 < 2 ? w2.x : w2.y) & k2, a3 = (d0 < 2 ? w3.x : w3.y) & k3;
                const float x1 = __uint_as_float((d0 & 1) ? (a1 & 0xffff0000u) : (a1 << 16)), x2 = __uint_as_float((d0 & 1) ? (a2 & 0xffff0000u) : (a2 << 16)), x3 = __uint_as_float((d0 & 1) ? (a3 & 0xffff0000u) : (a3 << 16));
                a = fmaf(z1, x1, a); a = fmaf(z2, x2, a); a = fmaf(z3, x3, a); val[d0] = a * rden; }
#pragma unroll
            for (int d0 = 0; d0 < 4; ++d0) o[d0][r] = val[d0]; }
        store_o_rows(o, lds + (wid < 4 ? OFF_V + SHM_V + wid * 4096 : OFF_K + SHM_K + (wid - 4) * 4096), Ow, RS, lane, r32, hi);
    }
}
#undef KSWZ
#undef KRSWZ
#undef SBAR
}
#define GAS __attribute__((address_space(1)))
#define LAS __attribute__((address_space(3)))
typedef unsigned short bf16;
typedef unsigned v4u __attribute__((ext_vector_type(4)));
typedef float f32x4 __attribute__((ext_vector_type(4)));
typedef short bf16x8 __attribute__((ext_vector_type(8)));
typedef GAS unsigned gu32;
typedef GAS unsigned long long gu64;
#define RLX_AGENT __ATOMIC_RELAXED, __HIP_MEMORY_SCOPE_AGENT
#define LDS_WAIT() asm volatile("s_waitcnt lgkmcnt(0)" ::: "memory")
#define VM_WAIT() asm volatile("s_waitcnt vmcnt(0)" ::: "memory")
__device__ __forceinline__ unsigned long long rt() { return __builtin_amdgcn_s_memrealtime(); }
__device__ __forceinline__ unsigned f2bf(float f) { unsigned u = __builtin_bit_cast(unsigned, f); return (u + 0x7fffu + ((u >> 16) & 1u)) >> 16; }
__device__ __forceinline__ unsigned pk2(float lo, float hi) { return f2bf(lo) | (f2bf(hi) << 16); }

#define XB_TMO      128
#define XB_XCNT(j)  (256  + 64 * (j))
#define XB_XSUB(j)  (1280 + 64 * (j))
#define XB_XGEN(j)  (2304 + 64 * (j))
#define XB_TOP      3328
#define XB_TOPGEN   3392
#define XCD_BAR_WORDS 3456
#define XB_SPIN_CAP (1u << 18)

__device__ __forceinline__ unsigned xb_ld(unsigned* p)              { return __hip_atomic_load(p, __ATOMIC_RELAXED, __HIP_MEMORY_SCOPE_AGENT); }
__device__ __forceinline__ unsigned xb_add(unsigned* p, unsigned v) { return __hip_atomic_fetch_add(p, v, __ATOMIC_RELAXED, __HIP_MEMORY_SCOPE_AGENT); }
__device__ __forceinline__ unsigned xb_xcc_id() { return (unsigned)__builtin_amdgcn_s_getreg((3 << 11) | 20) & 0xFu; }
#define XB_SPIN(cond, bar) do { unsigned _sp = 0; while (cond) { __builtin_amdgcn_s_sleep(1); \
    if ((++_sp & 255u) == 0u) { if (xb_ld(&(bar)[XB_TMO])) break; if (_sp > XB_SPIN_CAP) { atomicAdd(&(bar)[XB_TMO], 1u); break; } } } } while (0)

struct XcdBarrier {
    unsigned* bar; unsigned x;
    volatile LAS unsigned* st;
};

__device__ __forceinline__ XcdBarrier xcd_barrier_post(unsigned* bar, volatile LAS unsigned* st) {
    XcdBarrier b; b.bar = bar; b.x = xb_xcc_id(); b.st = st;
    if (threadIdx.x == 0) (void)xb_add(&bar[XB_XCNT(b.x)], 1u);
    return b;
}
__device__ __forceinline__ void xcd_barrier_complete(unsigned* bar, unsigned x, unsigned& nloc, unsigned& nx) {
    const unsigned G = gridDim.x * gridDim.y * gridDim.z;
    unsigned sum, cnt, mine, sp = 0u;
    for (;;) {
        sum = 0u; cnt = 0u; mine = 0u;
#pragma unroll
        for (unsigned j = 0; j < 16; ++j) { const unsigned c = xb_ld(&bar[XB_XCNT(j)]); sum += c; cnt += (c > 0u) ? 1u : 0u; mine = (j == x) ? c : mine; }
        if (sum == G) break;
        __builtin_amdgcn_s_sleep(1);
        if ((++sp & 255u) == 0u) { if (xb_ld(&bar[XB_TMO])) break; if (sp > XB_SPIN_CAP) { atomicAdd(&bar[XB_TMO], 1u); break; } }
    }
    nloc = mine > 0u ? mine : 1u; nx = cnt > 0u ? cnt : 1u;
}

__device__ __forceinline__ void xcd_barrier(const XcdBarrier& b) {
    asm volatile("s_waitcnt vmcnt(0)" ::: "memory");
    __syncthreads();
    if (threadIdx.x == 0) {
        unsigned* bar = b.bar;
        __builtin_amdgcn_s_waitcnt(0);
        unsigned nloc = b.st[0], nx = b.st[1];
        if (nloc == 0u) { xcd_barrier_complete(bar, b.x, nloc, nx); b.st[0] = nloc; b.st[1] = nx; }
        const unsigned old = xb_add(&bar[XB_XSUB(b.x)], 1u);
        const unsigned gen = old / nloc;
        if (old + 1u == (gen + 1u) * nloc) {
            __builtin_amdgcn_fence(__ATOMIC_RELEASE, "agent");
            asm volatile("s_waitcnt vmcnt(0)" ::: "memory");
            const unsigned og = xb_add(&bar[XB_TOP], 1u);
            const unsigned tg = og / nx;
            if (og + 1u == (tg + 1u) * nx) xb_add(&bar[XB_TOPGEN], 1u);
            else XB_SPIN(xb_ld(&bar[XB_TOPGEN]) == tg, bar);
            __builtin_amdgcn_fence(__ATOMIC_ACQUIRE, "agent");
            xb_add(&bar[XB_XGEN(b.x)], 1u);
            asm volatile("s_waitcnt vmcnt(0)" ::: "memory");
        } else {
            XB_SPIN(xb_ld(&bar[XB_XGEN(b.x)]) == gen, bar);
            __builtin_amdgcn_fence(__ATOMIC_ACQUIRE, "agent");
            asm volatile("s_waitcnt vmcnt(0)" ::: "memory");
        }
    }
    __syncthreads();
}
constexpr int NWAVES = 8;
#ifndef CONV_WAVES
#define CONV_WAVES 2
#endif
#ifndef FUSED_QUANT
#define FUSED_QUANT 1
#endif
#ifndef PROBE_REP
#define PROBE_REP 0
#endif
#define REPS(k) _Pragma("unroll 1") for (int rep_ = 0; rep_ < (PROBE_REP == (k) ? 2 : 1); ++rep_)
#ifndef MK_MULTI
#define MK_MULTI 0
#endif
#ifndef MOBA_GATHER
#define MOBA_GATHER 1
#endif
constexpr int SEQ = 8192, DM = 2048, FF = 5632, NPHASES = MOBA_GATHER ? 45 : 41;
constexpr size_t MiB = 1u << 20;
constexpr size_t WS_CTL = 0, WS_KMEAN = 1 * MiB, ZERO_BYTES = 2 * MiB;
constexpr size_t WS_SSQ = 2 * MiB, WS_SSQ_CQ = 3 * MiB, WS_SSQ_CKV = 4 * MiB, WS_COS = 5 * MiB, WS_SIN = 6 * MiB;
constexpr size_t WS_HB = 8 * MiB, WS_HID = 40 * MiB, WS_Q = 128 * MiB, WS_K = 160 * MiB, WS_V = 192 * MiB, WS_O = 224 * MiB, WS_QR = 256 * MiB, WS_KR = 272 * MiB, WS_CKV = 273 * MiB, WS_CQ = 281 * MiB;
constexpr size_t WS_FFN = 296 * MiB, FFN_SLOT = 69 * MiB, FFN_WD = 47 * MiB;
constexpr size_t WS_WQKV = 848 * MiB, WS_WO = 896 * MiB, WS_WUKV = 928 * MiB, WS_WDQ = 932 * MiB, WS_WUQ = 938 * MiB, WS_PO = 948 * MiB, WS_PML = 1044 * MiB, WS_LIST = 1048 * MiB, WS_END = 1056 * MiB;
constexpr size_t WS_AQ = 1056 * MiB, WS_ASC = 1072 * MiB, WS_AMX = 1073 * MiB, WS_END2 = 1074 * MiB;
static_assert((long)WS_AMX == pg8::EpiRes::QF_AMX && (long)WS_ASC == pg8::EpiRes::QF_ASC && (long)WS_AQ == pg8::EpiRes::QF_AQ && (long)WS_HB == pg8::EpiRes::QF_HB && (long)WS_SSQ == pg8::EpiRes::QF_SSQ && WS_CTL == 0, "fused quantisation offsets");
constexpr size_t WS_WAMAX = 256 * 1024;
constexpr size_t WS_MCNT = WS_KMEAN + 768 * 1024;
constexpr int CW_BAR = 4096, CW_CONV = 8192, CW_STRIP = 8256, CW_PCNT = 8448  ;
static_assert(CW_PCNT == pg8::EpiRes::QF_PCNT && CW_BAR + XB_TMO == pg8::EpiRes::QF_TMO && CW_PCNT + 32 * 16 <= 65536, "fused quantisation control words");
static_assert(WS_V - WS_K == WS_K - WS_Q, "q | k | v equally spaced");
constexpr int RING_OFF = 0, RING_BYTES = 131072, LDSCTL_OFF = RING_BYTES, MISC_OFF = LDSCTL_OFF + 320, RSTD_OFF = RING_BYTES + 1024, WTAB_OFF = RSTD_OFF + 8192, LDS_BYTES = 147456;
static_assert(att::LDS_BYTES <= RING_BYTES && MISC_OFF + 128 <= RSTD_OFF && WTAB_OFF + 6144 <= LDS_BYTES, "LDS map");

__device__ __forceinline__ float wave_sum(float v) {
#pragma unroll
    for (int o = 1; o < 64; o <<= 1) v += __shfl_xor(v, o);
    return v;
}
__device__ __forceinline__ int conv_src_col(int kind, int n0) {
    if (kind == 0) return n0;
    if (kind == 1) { const int pn = n0 >> 8, bj = (n0 >> 7) & 1, j = n0 & 127; return bj * FF + pn * 128 + j; }
    if (kind == 2) { if (n0 < 2048) { const int pn = n0 >> 8, hh = (n0 >> 7) & 1, j = n0 & 127; return (2 * pn + hh) * 192 + j; }
                     const int r = n0 - 2048, t = r >> 8, bj = (r >> 7) & 1, hh = (r >> 5) & 3; return (4 * t + hh) * 192 + 128 + 32 * bj; }
    if (n0 < 512) return n0; if (n0 == 512) return 512; if (n0 == 640) return 544; return -1;
}
__device__ __forceinline__ void conv_tile(const float* __restrict__ W, int K, int srcN, int N, const float* __restrict__ gain, bf16* __restrict__ WT, int kind, LAS unsigned char* wl, int lane, int it, const unsigned* __restrict__ wamax) {
    const int ngrp = N / 64, nkc = K / 128, c = lane & 15, q = lane >> 4;
    const int gs = (ngrp & 7) ? 4 : 8, g8 = it / gs, w8 = it - g8 * gs, b = g8 / nkc, kc = g8 - b * nkc, ng = ((b + kc) % (ngrp / gs)) * gs + w8;
    const int nd = ng * 64 + 4 * c, scg = conv_src_col(kind, nd & ~31);
    const bool valid = scg >= 0;
    const float* src = W + (size_t)(kc * 128 + 8 * q) * srcN + (valid ? scg + (nd & 31) : 0);
    f32x4 v[4][8], gv[4][2];
    if (gain) {
#pragma unroll
        for (int t = 0; t < 4; ++t) { gv[t][0] = *(const GAS f32x4*)(gain + kc * 128 + 8 * (q + 4 * t)); gv[t][1] = *(const GAS f32x4*)(gain + kc * 128 + 8 * (q + 4 * t) + 4); } }
#pragma unroll
    for (int t = 0; t < 4; ++t)
#pragma unroll
        for (int j = 0; j < 8; ++j) v[t][j] = __builtin_nontemporal_load((const GAS f32x4*)(src + (size_t)(32 * t + j) * srcN));
    if (kind == 3) { const float z = valid ? 1.f : 0.f;
#pragma unroll
        for (int t = 0; t < 4; ++t)
#pragma unroll
            for (int j = 0; j < 8; ++j) v[t][j] = v[t][j] * z; }
    if (gain) {
#pragma unroll
        for (int t = 0; t < 4; ++t) { const f32x4 g0 = gv[t][0], g1 = gv[t][1];
#pragma unroll
            for (int j = 0; j < 4; ++j) { v[t][j] = v[t][j] * g0[j]; v[t][4 + j] = v[t][4 + j] * g1[j]; } } }
    if (wamax) {
        const v4u ab = *(const v4u*)(wamax + nd); f32x4 sc;
#pragma unroll
        for (int i = 0; i < 4; ++i) { const float a = __uint_as_float(ab[i]); sc[i] = a > 0.f ? 127.0f / a : 0.f; }
#pragma unroll
        for (int t = 0; t < 4; ++t) { const int chunk = q + 4 * t;
#pragma unroll
            for (int i = 0; i < 4; ++i) { unsigned lo = 0u, hi2 = 0u;
#pragma unroll
                for (int j = 0; j < 4; ++j) { const int a0 = (int)__builtin_rintf(v[t][j][i] * sc[i]), a1 = (int)__builtin_rintf(v[t][4 + j][i] * sc[i]); lo |= ((unsigned)a0 & 0xffu) << (8 * j); hi2 |= ((unsigned)a1 & 0xffu) << (8 * j); }
                typedef unsigned u32x2 __attribute__((ext_vector_type(2)));
                *(LAS u32x2*)(wl + (4 * c + i) * 128 + 8 * (chunk ^ (2 * (c & 7)))) = (u32x2){lo, hi2}; } }
        LDS_WAIT(); asm volatile("" ::: "memory");
        unsigned char* dst = (unsigned char*)WT + (size_t)(ng * 64 + (lane >> 3)) * K + kc * 128 + 16 * (lane & 7); v4u ov[8];
#pragma unroll
        for (int st = 0; st < 8; ++st) { const int r = (lane >> 3) + 8 * st; ov[st] = *(const LAS v4u*)(wl + r * 128 + 8 * ((2 * (lane & 7)) ^ (2 * ((r >> 2) & 7)))); }
        LDS_WAIT(); asm volatile("" ::: "memory");
#pragma unroll
        for (int st = 0; st < 8; ++st) *(GAS v4u*)(dst + (size_t)(8 * st) * K) = ov[st];
        return;
    }
#pragma unroll
    for (int t = 0; t < 4; ++t) { const int chunk = q + 4 * t;
#pragma unroll
        for (int i = 0; i < 4; ++i) { v4u o; o.x = pg8::cvt_pk_bf16(v[t][0][i], v[t][1][i]); o.y = pg8::cvt_pk_bf16(v[t][2][i], v[t][3][i]); o.z = pg8::cvt_pk_bf16(v[t][4][i], v[t][5][i]); o.w = pg8::cvt_pk_bf16(v[t][6][i], v[t][7][i]);
            *(LAS v4u*)(wl + (4 * c + i) * 256 + 16 * (chunk ^ (c & 7))) = o; } }
    LDS_WAIT(); asm volatile("" ::: "memory");
    bf16* dst = WT + (size_t)(ng * 64 + q) * K + kc * 128 + 8 * c; v4u ov[16];
#pragma unroll
    for (int st = 0; st < 16; ++st) ov[st] = *(const LAS v4u*)(wl + (4 * st + q) * 256 + 16 * (c ^ (st & 7)));
    LDS_WAIT(); asm volatile("" ::: "memory");
#pragma unroll
    for (int st = 0; st < 16; ++st) *(GAS v4u*)(dst + (size_t)(4 * st) * K) = ov[st];
}
constexpr int IT_GU = 0, IT_D = 1408, IT_QKV = 0, IT_O = 512, IT_DKV = 0, IT_UKV = 256, IT_DQ = 192, IT_UQ = 288;
constexpr int IT_LA = 2 * IT_GU + 2 * IT_D + IT_QKV + IT_O;
constexpr int IT_L2 = 2 * IT_GU + 2 * IT_D + IT_DKV + IT_UKV + IT_DQ + IT_UQ + IT_O;
constexpr int IT_L3 = 2 * IT_GU + 2 * IT_D + IT_DQ + IT_UQ + IT_O;
constexpr int IT_B2 = 2 * IT_LA, IT_B3 = IT_B2 + IT_L2, IT_TOTAL = IT_B3 + IT_L3;
static_assert(IT_TOTAL == 40320 - 8 * 2816 - 192 - 2 * 1536, "conversion item count");
__device__ __forceinline__ int req_gu(int f) { const int l = f >> 1, w = f & 1; if (l < 2) return l * IT_LA + (w ? 2 * IT_GU + IT_D + IT_QKV + IT_O : IT_GU);
    if (l == 2) return IT_B2 + (w ? 2 * IT_GU + IT_DKV + IT_D + IT_UKV + IT_DQ + IT_UQ + IT_O : IT_GU + IT_DKV); return IT_B3 + (w ? 2 * IT_GU + IT_D + IT_DQ + IT_UQ + IT_O : IT_GU); }
__device__ __forceinline__ int req_d(int f) { return req_gu(f) + IT_D; }
__device__ __forceinline__ int req_qkv(int l) { return l * IT_LA + IT_GU + IT_D + IT_QKV; }
__device__ __forceinline__ int req_ukv() { return IT_B2 + IT_GU + IT_DKV + IT_D + IT_UKV; }
__device__ __forceinline__ int req_dq(int l) { return l == 2 ? req_ukv() + IT_DQ : IT_B3 + IT_GU + IT_D + IT_DQ; }
__device__ __forceinline__ int req_uq(int l) { return req_dq(l) + IT_UQ; }
__device__ __forceinline__ int req_o(int l) { return l < 2 ? req_qkv(l) + IT_O : req_uq(l) + IT_O; }

__device__ __forceinline__ void rstd_table_fill(LAS float* tab, const float* ssq, int fm, int tid, const float* rowfac = nullptr) {
#pragma unroll
    for (int j = 0; j < 4; ++j) { const int r = tid + 512 * j; float v = pg8::row_rstd<8>(ssq, fm * 256 + r, 1.0f / 2048.0f); if (rowfac) v *= rowfac[fm * 256 + r]; tab[r] = v; }
    __syncthreads();
}
__device__ __forceinline__ void quant_rows(const bf16* HB, signed char* AQ, float* asc, int gw, int NGW, int lane) {
    for (int m0 = gw * 4; m0 < SEQ; m0 += NGW * 4) {
        v4u w[4][4]; float mx[4];
#pragma unroll
        for (int r = 0; r < 4; ++r) { const GAS v4u* hr = (const GAS v4u*)(HB + (size_t)(m0 + r) * DM) + lane;
#pragma unroll
            for (int j = 0; j < 4; ++j) w[r][j] = hr[64 * j]; }
#pragma unroll
        for (int r = 0; r < 4; ++r) { float a = 0.f;
#pragma unroll
            for (int j = 0; j < 4; ++j)
#pragma unroll
                for (int e = 0; e < 4; ++e) { const unsigned u = w[r][j][e]; a = fmaxf(a, fmaxf(fabsf(__uint_as_float(u << 16)), fabsf(__uint_as_float(u & 0xffff0000u)))); }
            mx[r] = a; }
#pragma unroll
        for (int o = 1; o < 64; o <<= 1)
#pragma unroll
            for (int r = 0; r < 4; ++r) mx[r] = fmaxf(mx[r], __shfl_xor(mx[r], o));
#pragma unroll
        for (int r = 0; r < 4; ++r) { const float sc = mx[r] > 0.f ? 127.0f / mx[r] : 0.f;
            if (lane == 0) asc[m0 + r] = mx[r] * (1.0f / 127.0f);
            GAS unsigned long long* qo = (GAS unsigned long long*)(AQ + (size_t)(m0 + r) * DM) + lane;
#pragma unroll
            for (int j = 0; j < 4; ++j) { unsigned long long pk = 0ull;
#pragma unroll
                for (int e = 0; e < 4; ++e) { const unsigned u = w[r][j][e]; const int a0 = (int)__builtin_rintf(__uint_as_float(u << 16) * sc), a1 = (int)__builtin_rintf(__uint_as_float(u & 0xffff0000u) * sc);
                    pk |= (unsigned long long)(((unsigned)a0 & 0xffu) | (((unsigned)a1 & 0xffu) << 8)) << (16 * e); }
                qo[64 * j] = pk; } }
    }
}
__device__ __forceinline__ void wamax_job(const float* __restrict__ W, int srcN, int ncols, const float* __restrict__ gain, int kind, unsigned* __restrict__ amax, int gw, int NGW, int lane, int& rot) {
    const int ngrp = (ncols + 255) / 256, nitems = ngrp * (DM / 64);
    int w0 = gw - rot; if (w0 < 0) w0 += NGW; rot = (rot + nitems) % NGW;
    for (int it = w0; it < nitems; it += NGW) { const int kc = it / ngrp, ng = it - kc * ngrp, col = ng * 256 + 4 * lane;
        f32x4 mx = {0.f, 0.f, 0.f, 0.f};
        if (col >= ncols) continue;
#pragma unroll 8
        for (int j = 0; j < 64; ++j) { const f32x4 v = *(const GAS f32x4*)(W + (size_t)(kc * 64 + j) * srcN + col); const float g = gain[kc * 64 + j];
            mx[0] = fmaxf(mx[0], fabsf(v[0] * g)); mx[1] = fmaxf(mx[1], fabsf(v[1] * g)); mx[2] = fmaxf(mx[2], fabsf(v[2] * g)); mx[3] = fmaxf(mx[3], fabsf(v[3] * g)); }
#pragma unroll
        for (int e = 0; e < 4; ++e) { const int c = col + e; int n;
            if (kind == 1) { const int up = c >= FF, cc = up ? c - FF : c; n = (cc >> 7) * 256 + up * 128 + (cc & 127); } else { n = c < 512 ? c : 512 + ((c - 512) >> 5) * 128 + ((c - 512) & 31); }
            __hip_atomic_fetch_max(amax + n, __float_as_uint(mx[e]), __ATOMIC_RELAXED, __HIP_MEMORY_SCOPE_AGENT); } }
}
__device__ __forceinline__ void conv_strip(const float* __restrict__ W, int srcN, const float* __restrict__ gain, int kind, signed char* __restrict__ WQ, unsigned* __restrict__ wamax, int strip,
                                           LAS unsigned char* tile, LAS unsigned* mx, int tid) {
    const int c16 = tid & 15, kr = tid >> 4, nd = strip * 64 + 4 * c16, scg = conv_src_col(kind, nd & ~31);
    const bool valid = scg >= 0; const float z = valid ? 1.f : 0.f;
    const float* src = W + (size_t)(8 * kr) * srcN + (valid ? scg + (nd & 31) : 0);
    if (tid < 64) mx[tid] = 0u;
    __syncthreads();
    unsigned pk[8][4][4]; f32x4 mxl = {0.f, 0.f, 0.f, 0.f};
#pragma unroll
    for (int t = 0; t < 8; ++t) { f32x4 v[8];
        const f32x4 g0 = *(const GAS f32x4*)(gain + 8 * (kr + 32 * t)), g1 = *(const GAS f32x4*)(gain + 8 * (kr + 32 * t) + 4);
#pragma unroll
        for (int j = 0; j < 8; ++j) v[j] = __builtin_nontemporal_load((const GAS f32x4*)(src + (size_t)(256 * t + j) * srcN));
#pragma unroll
        for (int j = 0; j < 8; ++j) { const float gf = (j < 4 ? g0[j & 3] : g1[j & 3]) * z;
#pragma unroll
            for (int i = 0; i < 4; ++i) { v[j][i] = pg8::smul(v[j][i], gf); mxl[i] = fmaxf(mxl[i], fabsf(v[j][i])); } }
#pragma unroll
        for (int jp = 0; jp < 4; ++jp)
#pragma unroll
            for (int i = 0; i < 4; ++i) pk[t][jp][i] = pg8::cvt_pk_bf16(v[2 * jp][i], v[2 * jp + 1][i]); }
#pragma unroll
    for (int i = 0; i < 4; ++i) __hip_atomic_fetch_max(mx + 4 * c16 + i, __float_as_uint(mxl[i]), __ATOMIC_RELAXED, __HIP_MEMORY_SCOPE_WORKGROUP);
    __syncthreads();
    f32x4 sc;
#pragma unroll
    for (int i = 0; i < 4; ++i) { const float a = __uint_as_float(mx[4 * c16 + i]); sc[i] = a > 0.f ? 127.0f / a : 0.f; }
    if (tid < 64) wamax[strip * 64 + tid] = mx[tid];
#pragma unroll
    for (int t = 0; t < 8; ++t)
#pragma unroll
        for (int i = 0; i < 4; ++i) { unsigned tw[4];
#pragma unroll
            for (int jp = 0; jp < 4; ++jp) { const unsigned u = pk[t][jp][i]; const float f0 = __uint_as_float(u << 16), f1 = __uint_as_float(u & 0xffff0000u), magic = 12582912.0f; unsigned b0, b1;
                asm("v_fma_f32 %0, %1, %2, %3" : "=v"(b0) : "v"(f0), "v"(sc[i]), "v"(magic)); asm("v_fma_f32 %0, %1, %2, %3" : "=v"(b1) : "v"(f1), "v"(sc[i]), "v"(magic));
                tw[jp] = __builtin_amdgcn_perm(b1, b0, 0x0c0c0400u); }
            const unsigned lo = __builtin_amdgcn_perm(tw[1], tw[0], 0x05040100u), hi2 = __builtin_amdgcn_perm(tw[3], tw[2], 0x05040100u);
            typedef unsigned u32x2 __attribute__((ext_vector_type(2)));
            *(LAS u32x2*)(tile + (4 * c16 + i) * 2048 + 8 * ((kr + 32 * t) ^ (2 * c16))) = (u32x2){lo, hi2}; }
    __syncthreads();
#pragma unroll 4
    for (int it = 0; it < 16; ++it) { const int id = it * 512 + tid, row = id >> 7, g = id & 127;
        const v4u o = *(const LAS v4u*)(tile + row * 2048 + 8 * ((2 * g) ^ (2 * ((row >> 2) & 15))));
        *(GAS v4u*)(WQ + (size_t)(strip * 64 + row) * 2048 + 16 * g) = o; }
    __syncthreads();
}
constexpr int ST_GU = 176, ST_DKV = 12, ST_QKV = 96, ST_TOTAL = 8 * ST_GU + ST_DKV + 2 * ST_QKV;
constexpr int SB_GU0 = 0, SB_QKV0 = SB_GU0 + ST_GU, SB_GU1 = SB_QKV0 + ST_QKV, SB_GU2 = SB_GU1 + ST_GU, SB_QKV1 = SB_GU2 + ST_GU, SB_GU3 = SB_QKV1 + ST_QKV, SB_GU4 = SB_GU3 + ST_GU, SB_DKV = SB_GU4 + ST_GU,
              SB_GU5 = SB_DKV + ST_DKV, SB_GU6 = SB_GU5 + ST_GU, SB_GU7 = SB_GU6 + ST_GU;
static_assert(SB_GU7 + ST_GU == ST_TOTAL, "strip list");
__device__ __forceinline__ int req_strip_after_up(int f) { return f == 0 ? SB_GU2 : f == 1 ? SB_QKV1 : f == 2 ? SB_GU4 : f == 3 ? SB_GU5 : f == 4 ? SB_GU6 : f == 5 ? SB_GU7 : ST_TOTAL; }
constexpr int WAMAX_QKV = 8 * 12032;
struct Args { const float* in[19]; float* out; unsigned char* ws; int ph_lo, ph_hi; };
#define WGU(f) ((bf16*)(ws + WS_FFN + (size_t)(f) * FFN_SLOT))
#define WD(f) ((bf16*)(ws + WS_FFN + (size_t)(f) * FFN_SLOT + FFN_WD))
#define WQKV(l) ((bf16*)(ws + WS_WQKV + (size_t)(l) * 24 * MiB))
#define WO(l) ((bf16*)(ws + WS_WO + (size_t)(l) * 8 * MiB))
#define WUKV ((bf16*)(ws + WS_WUKV))
#define WDQ(j) ((bf16*)(ws + WS_WDQ + (size_t)(j) * 3 * MiB))
#define WUQ(j) ((bf16*)(ws + WS_WUQ + (size_t)(j) * 5 * MiB))
__device__ __forceinline__ void conv_item(const Args& args, unsigned char* ws, LAS unsigned char* wl, int lane, int idx) {
    int i = idx, K, sN, N, kind = 0; const float* src; const float* gain = nullptr; bf16* dst; const unsigned* wam = nullptr;
#define SET_GU(f_) do { const int l_ = (f_) >> 1, w_ = (f_) & 1; src = (w_ ? args.in[6] : args.in[2]) + (size_t)l_ * DM * 2 * FF; gain = (w_ ? args.in[5] : args.in[1]) + l_ * DM; dst = WGU(f_); K = DM; sN = 2 * FF; N = 2 * FF; kind = 1; wam = (const unsigned*)(ws + WS_WAMAX) + (f_) * 12032; } while (0)
#define SET_D(f_) do { const int l_ = (f_) >> 1, w_ = (f_) & 1; src = (w_ ? args.in[7] : args.in[3]) + (size_t)l_ * FF * DM; dst = WD(f_); K = FF; sN = DM; N = DM; } while (0)
#define SET_QKV(l_) do { src = args.in[8] + (size_t)(l_) * DM * 6144; gain = args.in[4] + (l_) * DM; dst = WQKV(l_); K = DM; sN = 6144; N = 6144; } while (0)
#define SET_O(l_) do { src = (l_) < 2 ? args.in[9] + (size_t)(l_) * DM * DM : args.in[17] + (size_t)((l_) - 2) * DM * DM; dst = WO(l_); K = DM; sN = DM; N = DM; } while (0)
#define SET_DKV() do { src = args.in[11]; gain = args.in[10]; dst = (bf16*)((unsigned char*)WGU(4) + (size_t)2 * FF * DM); K = DM; sN = 576; N = 768; kind = 3; wam = (const unsigned*)(ws + WS_WAMAX) + 4 * 12032 + 2 * FF; } while (0)
#define SET_UKV() do { src = args.in[13]; gain = args.in[12]; dst = WUKV; K = 512; sN = 4096; N = 4096; } while (0)
#define SET_DQ(j_) do { src = args.in[14] + (size_t)(j_) * DM * 768; gain = args.in[4] + (2 + (j_)) * DM; dst = WDQ(j_); K = DM; sN = 768; N = 768; } while (0)
#define SET_UQ(j_) do { src = args.in[16] + (size_t)(j_) * 768 * 3072; gain = args.in[15] + (j_) * 768; dst = WUQ(j_); K = 768; sN = 3072; N = 3072; kind = 2; } while (0)
    if (i < IT_B2) { const int l = i >= IT_LA ? 1 : 0; i -= l * IT_LA;
        if (i < IT_GU) SET_GU(2 * l); else if ((i -= IT_GU) < IT_D) SET_D(2 * l); else if ((i -= IT_D) < IT_QKV) SET_QKV(l); else if ((i -= IT_QKV) < IT_O) SET_O(l);
        else if ((i -= IT_O) < IT_GU) SET_GU(2 * l + 1); else { i -= IT_GU; SET_D(2 * l + 1); } }
    else if (i < IT_B3) { i -= IT_B2;
        if (i < IT_GU) SET_GU(4); else if ((i -= IT_GU) < IT_DKV) SET_DKV(); else if ((i -= IT_DKV) < IT_D) SET_D(4); else if ((i -= IT_D) < IT_UKV) SET_UKV(); else if ((i -= IT_UKV) < IT_DQ) SET_DQ(0);
        else if ((i -= IT_DQ) < IT_UQ) SET_UQ(0); else if ((i -= IT_UQ) < IT_O) SET_O(2); else if ((i -= IT_O) < IT_GU) SET_GU(5); else { i -= IT_GU; SET_D(5); } }
    else { i -= IT_B3;
        if (i < IT_GU) SET_GU(6); else if ((i -= IT_GU) < IT_D) SET_D(6); else if ((i -= IT_D) < IT_DQ) SET_DQ(1); else if ((i -= IT_DQ) < IT_UQ) SET_UQ(1); else if ((i -= IT_UQ) < IT_O) SET_O(3);
        else if ((i -= IT_O) < IT_GU) SET_GU(7); else { i -= IT_GU; SET_D(7); } }
#undef SET_GU
#undef SET_D
#undef SET_QKV
#undef SET_O
#undef SET_DKV
#undef SET_UKV
#undef SET_DQ
#undef SET_UQ
    conv_tile(src, K, sN, N, gain, dst, kind, wl, lane, i, wam);
}
__global__ void __launch_bounds__(NWAVES * 64, 2) yoco_fwd(Args args) {
    extern __shared__ __attribute__((aligned(16))) unsigned char lds[];
    LAS unsigned char* ldsl = (LAS unsigned char*)lds;
    const int tid = threadIdx.x, lane = tid & 63, wave = __builtin_amdgcn_readfirstlane(tid >> 6), G = gridDim.x;
    unsigned char* ws = args.ws;
    gu32* ctl = (gu32*)(ws + WS_CTL);
    for (int u = tid; u < (LDS_BYTES - LDSCTL_OFF) / 4; u += NWAVES * 64) ((LAS unsigned*)(ldsl + LDSCTL_OFF))[u] = 0u;
    __syncthreads();
    XcdBarrier bar = xcd_barrier_post((unsigned*)(ctl + CW_BAR), (volatile LAS unsigned*)(ldsl + MISC_OFF) + 8);
    const int lo = args.ph_lo, hi = args.ph_hi; int seq = 0;
#define PH_RUN (seq >= lo && seq < hi)
#define PH_END do { if (seq >= lo && seq + 1 < hi) { xcd_barrier(bar); if (PROBE_REP == 8) xcd_barrier(bar); } ++seq; } while (0)
#define STRIP_DRAIN(R_, SOFT_) do { const int RS__ = (R_), RSOFT__ = (SOFT_); gu32* sc_ = ctl + CW_STRIP; volatile LAS int* sidx_ = (volatile LAS int*)(ldsl + RSTD_OFF + 512); int tq_ = threadIdx.x; asm volatile("" : "+v"(tq_)); \
        for (int nth_ = 0;; ++nth_) { const int lim_ = nth_ == 0 ? RSOFT__ : RS__;     \
            if (tq_ == 0) { int v_ = 1 << 30; if ((int)__hip_atomic_load(sc_, RLX_AGENT) < lim_) v_ = (int)__hip_atomic_fetch_add(sc_, 1u, RLX_AGENT); *sidx_ = v_; } __syncthreads(); const int si_ = *sidx_; __syncthreads(); \
            if (si_ < ST_TOTAL) { unsigned* wab_ = (unsigned*)(ws + WS_WAMAX); LAS unsigned char* tl2_ = ldsl + RING_OFF; LAS unsigned* mx_ = (LAS unsigned*)(ldsl + RSTD_OFF); \
                if ((si_ >= SB_QKV0 && si_ < SB_GU1) || (si_ >= SB_QKV1 && si_ < SB_GU3)) { const int l_ = si_ >= SB_QKV1 ? 1 : 0, ls_ = si_ - (l_ ? SB_QKV1 : SB_QKV0); \
                    conv_strip(args.in[8] + (size_t)l_ * DM * 6144, 6144, args.in[4] + l_ * DM, 0, (signed char*)WQKV(l_), wab_ + WAMAX_QKV + l_ * 6144, ls_, tl2_, mx_, tq_); } \
                else if (si_ >= SB_DKV && si_ < SB_GU5) { conv_strip(args.in[11], 576, args.in[10], 3, (signed char*)WGU(4) + (size_t)2 * FF * DM, wab_ + 4 * 12032 + 2 * FF, si_ - SB_DKV, tl2_, mx_, tq_); } \
                else { const int f_ = si_ < SB_QKV0 ? 0 : si_ < SB_GU2 ? 1 : si_ < SB_QKV1 ? 2 : si_ < SB_GU4 ? 3 : si_ < SB_DKV ? 4 : si_ < SB_GU6 ? 5 : si_ < SB_GU7 ? 6 : 7; \
                    const int base_ = f_ == 0 ? SB_GU0 : f_ == 1 ? SB_GU1 : f_ == 2 ? SB_GU2 : f_ == 3 ? SB_GU3 : f_ == 4 ? SB_GU4 : f_ == 5 ? SB_GU5 : f_ == 6 ? SB_GU6 : SB_GU7, l_ = f_ >> 1, w_ = f_ & 1; \
                    conv_strip((w_ ? args.in[6] : args.in[2]) + (size_t)l_ * DM * 2 * FF, 2 * FF, (w_ ? args.in[5] : args.in[1]) + l_ * DM, 1, (signed char*)WGU(f_), wab_ + f_ * 12032, si_ - base_, tl2_, mx_, tq_); } } \
            if (si_ + 1 >= RS__) break; } } while (0)
#define CONV_DRAIN(R_) CONV_DRAIN_W(R_, CONV_WAVES)
#define CONV_DRAIN_W(R_, NW_) do { const int R__ = (R_); gu32* cc_ = ctl + CW_CONV; LAS unsigned char* wl_ = ldsl + RING_OFF + wave * 16384; int tl_ = threadIdx.x; asm volatile("" : "+v"(tl_)); const int ln_ = tl_ & 63; \
        if (wave < (NW_) && (int)__builtin_amdgcn_readfirstlane(__hip_atomic_load(cc_, RLX_AGENT)) < R__) { for (;;) { int idx_ = 0; if (ln_ == 0) idx_ = (int)__hip_atomic_fetch_add(cc_, 1u, RLX_AGENT); idx_ = __builtin_amdgcn_readfirstlane(idx_); \
            if (idx_ < IT_TOTAL) conv_item(args, ws, wl_, ln_, idx_); if (idx_ + 1 >= R__) break; } } } while (0)
    const float* x = args.in[0]; float* out = args.out;
    float* kmean = (float*)(ws + WS_KMEAN); float* ssq = (float*)(ws + WS_SSQ); float* ssq_cq = (float*)(ws + WS_SSQ_CQ); float* ssq_ckv = (float*)(ws + WS_SSQ_CKV);
    float* cos_t = (float*)(ws + WS_COS); float* sin_t = (float*)(ws + WS_SIN);
    bf16* HB = (bf16*)(ws + WS_HB); bf16* HID = (bf16*)(ws + WS_HID); bf16* QB_ = (bf16*)(ws + WS_Q); bf16* KB_ = (bf16*)(ws + WS_K); bf16* VB_ = (bf16*)(ws + WS_V); bf16* OB = (bf16*)(ws + WS_O);
    bf16* QR = (bf16*)(ws + WS_QR); bf16* KR = (bf16*)(ws + WS_KR); bf16* CKV = (bf16*)(ws + WS_CKV); bf16* CQ = (bf16*)(ws + WS_CQ);
    const int gw = (int)blockIdx.x * NWAVES + wave, NGW = G * NWAVES;

    if (PH_RUN) REPS(1) {
        STRIP_DRAIN(SB_QKV0, req_strip_after_up(0));
        for (int m = gw; m < SEQ; m += NGW) {
            const GAS f32x4* xr = (const GAS f32x4*)(x + (size_t)m * DM) + lane; GAS unsigned long long* o8 = (GAS unsigned long long*)(HB + (size_t)m * DM) + lane; float s = 0.f, mxa = 0.f; unsigned long long hb[8];
#pragma unroll
            for (int j = 0; j < 8; ++j) { const f32x4 v = __builtin_nontemporal_load(xr + 64 * j); s += (v.x * v.x + v.y * v.y) + (v.z * v.z + v.w * v.w); const unsigned p0_ = pk2(v.x, v.y), p1_ = pk2(v.z, v.w); hb[j] = (unsigned long long)p0_ | ((unsigned long long)p1_ << 32); o8[64 * j] = hb[j];
                mxa = fmaxf(fmaxf(mxa, fmaxf(fabsf(__uint_as_float(p0_ << 16)), fabsf(__uint_as_float(p0_ & 0xffff0000u)))), fmaxf(fabsf(__uint_as_float(p1_ << 16)), fabsf(__uint_as_float(p1_ & 0xffff0000u)))); }
            s = wave_sum(s); if (lane < 32) ssq[(size_t)m * 32 + lane] = lane == 0 ? s : 0.f;
#pragma unroll
            for (int o = 1; o < 64; o <<= 1) mxa = fmaxf(mxa, __shfl_xor(mxa, o));
            const float qs = mxa > 0.f ? 127.0f / mxa : 0.f; if (lane == 0) ((float*)(ws + WS_ASC))[m] = mxa * (1.0f / 127.0f);
            GAS unsigned* q4 = (GAS unsigned*)((signed char*)(ws + WS_AQ) + (size_t)m * DM) + lane;
#pragma unroll
            for (int j = 0; j < 8; ++j) { const unsigned p0_ = (unsigned)hb[j], p1_ = (unsigned)(hb[j] >> 32);
                const int a0 = (int)__builtin_rintf(__uint_as_float(p0_ << 16) * qs), a1 = (int)__builtin_rintf(__uint_as_float(p0_ & 0xffff0000u) * qs), a2 = (int)__builtin_rintf(__uint_as_float(p1_ << 16) * qs), a3 = (int)__builtin_rintf(__uint_as_float(p1_ & 0xffff0000u) * qs);
                q4[64 * j] = ((unsigned)a0 & 0xffu) | (((unsigned)a1 & 0xffu) << 8) | (((unsigned)a2 & 0xffu) << 16) | (((unsigned)a3 & 0xffu) << 24); } }
        for (int idx = (int)blockIdx.x * 512 + tid; idx < SEQ * 32; idx += G * 512) {
            const int pos = idx >> 5, i = idx & 31;
            const float pw = (float)exp2((double)(2 * i) * (13.287712379549449 / 64.0)), inv = 1.0f / pw, ang = (float)pos * inv;
            const double a = (double)ang, q = rint(a * 0.6366197723675814), r = (a - q * 1.5707963267948966) - q * 6.123233995736766e-17, r2 = r * r;
            const double sn = r + r * r2 * (-1.0 / 6 + r2 * (1.0 / 120 + r2 * (-1.0 / 5040 + r2 * (1.0 / 362880 + r2 * (-1.0 / 39916800)))));
            const double cs = 1.0 + r2 * (-0.5 + r2 * (1.0 / 24 + r2 * (-1.0 / 720 + r2 * (1.0 / 40320 + r2 * (-1.0 / 3628800 + r2 * (1.0 / 479001600))))));
            const int qi = (int)q & 3; const double c_ = qi == 0 ? cs : qi == 1 ? -sn : qi == 2 ? -cs : sn, s_ = qi == 0 ? sn : qi == 1 ? cs : qi == 2 ? -sn : -cs;
            cos_t[idx] = (float)c_; sin_t[idx] = (float)s_; }
    }
    PH_END;
    signed char* AQ = (signed char*)(ws + WS_AQ); float* asc = (float*)(ws + WS_ASC);
    const bool fuseq = FUSED_QUANT && G == 256; unsigned qk = 0u;

    for (int f = 0; f < 8; ++f) {
        const int l = f >> 1;
        if (f > 0 && !fuseq) { if (PH_RUN) { int t4 = threadIdx.x; asm volatile("" : "+v"(t4)); quant_rows(HB, AQ, asc, gw, NGW, t4 & 63); } PH_END; }
        if (PH_RUN) REPS(4) {
            pg8::Gemm g{(const pg8::bf16_t*)AQ, (const pg8::bf16_t*)WGU(f), SEQ, f == 4 ? 2 * FF + 768 : 2 * FF, DM / 2}; pg8::StaticOrder S; S.init(SEQ, g.N, G, (int)blockIdx.x);
            LAS float* rtab = (LAS float*)(ldsl + RSTD_OFF); LAS float* wtab = (LAS float*)(ldsl + WTAB_OFF); int pn0 = 0;
            { pg8::Unit u0; if (S.next(0, u0)) { int t3 = threadIdx.x; asm volatile("" : "+v"(t3)); pn0 = u0.pn; const unsigned* wam_ = (const unsigned*)(ws + WS_WAMAX) + f * 12032;
#pragma unroll
                  for (int ui_ = 0; ui_ < 6; ++ui_) { pg8::Unit uu; if (S.next(ui_, uu) && t3 < 256) wtab[((uu.pn - pn0) >> 2) * 256 + t3] = __uint_as_float(wam_[uu.pn * 256 + t3]) * (1.0f / 127.0f); }
                  rstd_table_fill(rtab, ssq, u0.pm & ~7, t3, asc); } }
            pg8::EpiUp E{(pg8::bf16_t*)HID, rtab, 44, (pg8::bf16_t*)CKV, ssq_ckv, (pg8::bf16_t*)KR, cos_t, sin_t, wtab, pn0};
            pg8::gemm_phase<pg8::EpiUp, pg8::StaticOrder, true, true>(ldsl + RING_OFF, g, S, E);
#if PROBE_REP == 6
            { pg8::EpiNull E0; pg8::gemm_phase<pg8::EpiNull, pg8::StaticOrder, true, true>(ldsl + RING_OFF, g, S, E0); }
#endif
            __syncthreads(); if (f < 7) STRIP_DRAIN(req_strip_after_up(f), req_strip_after_up(f + 1 < 7 ? f + 1 : 6)); CONV_DRAIN(f < 7 ? req_gu(f + 1) : IT_TOTAL);
        }
        PH_END;
        if (PH_RUN) {
            pg8::Gemm g{(const pg8::bf16_t*)HID, (const pg8::bf16_t*)WD(f), SEQ, DM, FF}; pg8::StaticOrder S; S.init(SEQ, DM, G, (int)blockIdx.x);
            const bool fq_here = fuseq && ((f & 1) ? f < 7 : l < 2);
            if (fuseq && f == 7) { pg8::EpiResT<1, true> E{ws, (LAS float*)(ldsl + RSTD_OFF), args.out, args.in[18], 8u * (qk + 1u)};
                pg8::gemm_phase<pg8::EpiResT<1, true>, pg8::StaticOrder, true, true>(ldsl + RING_OFF, g, S, E); }
            else { pg8::EpiResT<1> E{ws, (LAS float*)(ldsl + RSTD_OFF), nullptr, nullptr, fq_here ? 8u * (qk + 1u) : 0u};
            pg8::gemm_phase<pg8::EpiResT<1>, pg8::StaticOrder, true, true>(ldsl + RING_OFF, g, S, E); }
        }
        PH_END;
        if (fuseq && ((f & 1) ? true : l < 2)) ++qk;
        if (f & 1) continue;
        if (l < 2) {
            if (!fuseq) { if (PH_RUN) { int t4 = threadIdx.x; asm volatile("" : "+v"(t4)); quant_rows(HB, AQ, asc, gw, NGW, t4 & 63); }
            PH_END; }
            if (PH_RUN) {
                pg8::Gemm g{(const pg8::bf16_t*)AQ, (const pg8::bf16_t*)WQKV(l), SEQ, 6144, DM / 2}; pg8::StaticOrder S; S.init(SEQ, 6144, G, (int)blockIdx.x);
                LAS float* rtab = (LAS float*)(ldsl + RSTD_OFF); LAS float* wtab = (LAS float*)(ldsl + WTAB_OFF); int pn0 = 0;
                { pg8::Unit u0; if (S.next(0, u0)) { int t3 = threadIdx.x; asm volatile("" : "+v"(t3)); pn0 = u0.pn; const unsigned* wam_ = (const unsigned*)(ws + WS_WAMAX) + WAMAX_QKV + l * 6144;
                      for (int ui_ = 0; ui_ < 3; ++ui_) { pg8::Unit uu; if (S.next(ui_, uu) && t3 < 256) wtab[((uu.pn - pn0) >> 2) * 256 + t3] = __uint_as_float(wam_[uu.pn * 256 + t3]) * (1.0f / 127.0f); }
                      rstd_table_fill(rtab, ssq, u0.pm & ~7, t3, asc); } }
                pg8::EpiQKV E{(pg8::bf16_t*)QB_, (size_t)(WS_K - WS_Q) / 2, rtab, kmean + (size_t)l * 32 * DM, wtab, pn0};
                pg8::gemm_phase<pg8::EpiQKV, pg8::StaticOrder, true, true>(ldsl + RING_OFF, g, S, E);
            }
            PH_END;
#if MOBA_GATHER
            const att::MobaBufs MB{(unsigned*)(ws + WS_MCNT) + l * 512, (unsigned short*)(ws + WS_LIST), (att::bf16*)(ws + WS_PO), (float*)(ws + WS_PML)};
            if (PH_RUN) att::moba_gate_phase((char*)lds + RING_OFF, (const att::bf16*)QB_, kmean + (size_t)l * 32 * DM, MB);
            PH_END;
            if (PH_RUN) REPS(10) att::moba_sel_phase((char*)lds + RING_OFF, (const att::bf16*)QB_, (const att::bf16*)KB_, (const att::bf16*)VB_, MB);
            PH_END;
            if (PH_RUN) REPS(11) att::moba_own_phase((char*)lds + RING_OFF, (const att::bf16*)QB_, (const att::bf16*)KB_, (const att::bf16*)VB_, (att::bf16*)OB, MB);
            PH_END;
#else
            if (PH_RUN) REPS(2) { const att::Shared GS{(const att::bf16*)KR, kmean + (size_t)l * 32 * DM};
                att::attn_phase<0>((char*)lds + RING_OFF, (const att::bf16*)QB_, (const att::bf16*)QR, (const att::bf16*)KB_, (const att::bf16*)VB_, (att::bf16*)OB, GS); }
            PH_END;
#endif
        } else {
            if (PH_RUN) {
                if (l == 2 && (int)blockIdx.x >= 96 && G == 256) {
                    pg8::Gemm g{(const pg8::bf16_t*)CKV, (const pg8::bf16_t*)WUKV, SEQ, 4096, 512}; pg8::StaticOrder S; S.init(SEQ, 4096, 160, (int)blockIdx.x - 96);
                    pg8::EpiUKV E{(pg8::bf16_t*)KB_, (pg8::bf16_t*)VB_, ssq_ckv};
                    pg8::gemm_phase<pg8::EpiUKV, pg8::StaticOrder, true, true>(ldsl + RING_OFF, g, S, E);
                } else {
                    pg8::Gemm g{(const pg8::bf16_t*)HB, (const pg8::bf16_t*)WDQ(l - 2), SEQ, 768, DM}; pg8::StaticOrder S; S.init(SEQ, 768, G, (int)blockIdx.x);
                    LAS float* rtab = (LAS float*)(ldsl + RSTD_OFF); { pg8::Unit u0; if (S.next(0, u0)) { int t3 = threadIdx.x; asm volatile("" : "+v"(t3)); rstd_table_fill(rtab, ssq, u0.pm & ~7, t3); } }
                    pg8::EpiScaled E{(pg8::bf16_t*)CQ, 768, rtab, ssq_cq};
                    pg8::gemm_phase<pg8::EpiScaled, pg8::StaticOrder, true, true>(ldsl + RING_OFF, g, S, E);
                    { pg8::Unit u1; if (!S.next(0, u1) && l == 3) { __syncthreads(); CONV_DRAIN_W(IT_TOTAL, 2); } }
                    if (l == 2 && G != 256) {
                        pg8::Gemm g2{(const pg8::bf16_t*)CKV, (const pg8::bf16_t*)WUKV, SEQ, 4096, 512}; pg8::StaticOrder S2; S2.init(SEQ, 4096, G, (int)blockIdx.x);
                        pg8::EpiUKV E2{(pg8::bf16_t*)KB_, (pg8::bf16_t*)VB_, ssq_ckv};
                        pg8::gemm_phase<pg8::EpiUKV, pg8::StaticOrder, true, true>(ldsl + RING_OFF, g2, S2, E2); }
                }
            }
            PH_END;
            if (PH_RUN) {
                pg8::Gemm g{(const pg8::bf16_t*)CQ, (const pg8::bf16_t*)WUQ(l - 2), SEQ, 3072, 768}; pg8::StaticOrder S; S.init(SEQ, 3072, G, (int)blockIdx.x);
                pg8::EpiUQ E{(pg8::bf16_t*)QB_, (pg8::bf16_t*)QR, ssq_cq, cos_t, sin_t};
                pg8::gemm_phase<pg8::EpiUQ, pg8::StaticOrder, true, true>(ldsl + RING_OFF, g, S, E);
            }
            PH_END;
            if (PH_RUN) REPS(3) { const att::Shared GS{(const att::bf16*)KR, kmean};
                att::attn_phase<1>((char*)lds + RING_OFF, (const att::bf16*)QB_, (const att::bf16*)QR, (const att::bf16*)KB_, (const att::bf16*)VB_, (att::bf16*)OB, GS); }
            PH_END;
        }
        if (PH_RUN) {
            pg8::Gemm g{(const pg8::bf16_t*)OB, (const pg8::bf16_t*)WO(l), SEQ, DM, DM}; pg8::StaticOrder S; S.init(SEQ, DM, G, (int)blockIdx.x);
            pg8::EpiResT<0> E{ws, (LAS float*)(ldsl + RSTD_OFF), nullptr, nullptr, fuseq ? 8u * (qk + 1u) : 0u};
            pg8::gemm_phase<pg8::EpiResT<0>, pg8::StaticOrder, true, true>(ldsl + RING_OFF, g, S, E);
        }
        PH_END;
        if (fuseq) ++qk;
    }
    if (PH_RUN) {
        const bool bad = xb_ld((unsigned*)(ctl + CW_BAR) + XB_TMO) != 0u; const float poison = bad ? __builtin_nanf("") : 1.0f;
        int t2 = threadIdx.x; asm volatile("" : "+v"(t2)); const int ln = t2 & 63;
        const GAS f32x4* fn = (const GAS f32x4*)args.in[18] + ln;
        int gw2 = gw; asm volatile("" : "+s"(gw2));
        for (int m = gw2; m < SEQ; m += NGW) { const float rs = pg8::row_rstd<8>(ssq, m, 1.0f / 2048.0f) * poison; GAS f32x4* o = (GAS f32x4*)(out + (size_t)m * DM) + ln;
            const GAS unsigned long long* hb8 = (const GAS unsigned long long*)(HB + (size_t)m * DM) + ln;
#pragma unroll
            for (int j = 0; j < 8; ++j) { const unsigned long long hv = hb8[64 * j]; const unsigned lo = (unsigned)hv, hi2 = (unsigned)(hv >> 32); const f32x4 gn = fn[64 * j];
                const f32x4 v = {__uint_as_float(lo << 16), __uint_as_float(lo & 0xffff0000u), __uint_as_float(hi2 << 16), __uint_as_float(hi2 & 0xffff0000u)}; __builtin_nontemporal_store(v * rs * gn, o + 64 * j); } }
    }
#undef PH_RUN
#undef PH_END
}

extern "C" void kernel_launch(void* const* d_in, const int* in_sizes, int n_in, void* d_out, int out_size, void* d_ws, size_t ws_size, hipStream_t stream) {
    static int grid = 0;
    if (grid == 0) {
        if (n_in != 19 || in_sizes[0] != SEQ * DM || out_size != SEQ * DM || ws_size < WS_END2) { fprintf(stderr, "kernel_launch: unexpected shapes (n_in %d, in0 %d, out %d, ws %zu)\n", n_in, n_in > 0 ? in_sizes[0] : -1, out_size, ws_size); grid = -1; return; }
        int dev = 0, cus = 0, per_cu = 0;
        if (hipGetDevice(&dev) != hipSuccess || hipDeviceGetAttribute(&cus, hipDeviceAttributeMultiprocessorCount, dev) != hipSuccess) { grid = -1; return; }
        if (hipFuncSetAttribute((const void*)yoco_fwd, hipFuncAttributeMaxDynamicSharedMemorySize, LDS_BYTES) != hipSuccess) { fprintf(stderr, "kernel_launch: hipFuncSetAttribute failed\n"); grid = -1; return; }
        if (hipOccupancyMaxActiveBlocksPerMultiprocessor(&per_cu, (const void*)yoco_fwd, NWAVES * 64, LDS_BYTES) != hipSuccess || per_cu < 1) { fprintf(stderr, "kernel_launch: occupancy query reports %d workgroups per CU\n", per_cu); per_cu = 1; }
        (void)hipGetLastError();
        grid = cus;
    }
    if (grid < 0) return;
    if (hipMemsetAsync((char*)d_ws + WS_CTL, 0, ZERO_BYTES, stream) != hipSuccess) return;
    Args a{};
    for (int i = 0; i < 19; ++i) a.in[i] = (const float*)d_in[i];
    a.out = (float*)d_out; a.ws = (unsigned char*)d_ws;
#if MK_MULTI
    for (int k = 0; k < NPHASES; ++k) { a.ph_lo = k; a.ph_hi = k + 1; hipLaunchKernelGGL(yoco_fwd, dim3(grid), dim3(NWAVES * 64), LDS_BYTES, stream, a); }
#else
    a.ph_lo = 0; a.ph_hi = (FUSED_QUANT && grid == 256) ? NPHASES - 10 : NPHASES;
    hipLaunchKernelGGL(yoco_fwd, dim3(grid), dim3(NWAVES * 64), LDS_BYTES, stream, a);
#endif
    const hipError_t le = hipPeekAtLastError();
    if (le != hipSuccess) fprintf(stderr, "kernel_launch: launch failed: %s\n", hipGetErrorName(le));
}
```

```cpp
#include <hip/hip_runtime.h>
#include <hip/hip_bf16.h>
#include <cstdio>
#include <cstdint>
namespace pg8 {
#define PG8_LAS __attribute__((address_space(3)))
typedef unsigned short bf16_t;
typedef short bf16x8 __attribute__((ext_vector_type(8)));
typedef float f32x4 __attribute__((ext_vector_type(4)));
typedef unsigned u32x4 __attribute__((ext_vector_type(4)));
typedef int i32x4 __attribute__((ext_vector_type(4)));
constexpr int BM = 256, BK = 64, HALF = 128, HTB = HALF * BK * 2  , STAGE_BYTES = 8 * HTB, NXCD = 8, WGM = 8;

__host__ __device__ __forceinline__ int lds_byte(int r, int c) { const int st = (r >> 4) * 2 + (c >> 5), rr = r & 15, cc = c & 31, ob = rr * 64 + cc * 2; return st * 1024 + (ob ^ (((ob >> 9) & 1) << 5)); }
__host__ __device__ __forceinline__ void stage_rc(int b, int& R, int& C) { const int st = b / 1024, sb = b % 1024, swz = sb ^ (((sb >> 9) & 1) << 5); R = (st >> 1) * 16 + swz / 64; C = (st & 1) * 32 + (swz % 64) / 2; }
__host__ __device__ __forceinline__ int perm32(int rho) { const int n = rho >> 4, i = rho & 15; return 8 * (i >> 2) + 4 * n + (i & 3); }

struct Unit { int pm, pn; };
struct Gemm { const bf16_t* A; const bf16_t* Bt; int M, N, K; };

struct StaticOrder {
    int nM, nN, nwg, G, c;
    __host__ __device__ void init(int M, int N, int G_, int c_) { nM = M / BM; nN = N / BM; nwg = nM * nN; G = G_; c = c_; }
    __host__ __device__ __forceinline__ bool next(int i, Unit& u) const {
        const long L = (long)i * G + c; if (L >= nwg) return false;
        int wgid = (int)L; { const int q = nwg / NXCD, r = nwg % NXCD, xcd = wgid % NXCD, off = wgid / NXCD; wgid = (xcd < r ? xcd * (q + 1) : r * (q + 1) + (xcd - r) * q) + off; }
        const int nig = WGM * nN, gid = wgid / nig, fm = gid * WGM, gsz = (nM - fm) < WGM ? (nM - fm) : WGM;
        u.pm = fm + ((wgid % nig) % gsz); u.pn = (wgid % nig) / gsz; return true;
    }
    __device__ __forceinline__ void a_ready(const Unit&) const {}
    __device__ __forceinline__ void done(const Unit&) const {}
};

__device__ __forceinline__ unsigned cvt_pk_bf16(float lo, float hi) { unsigned r; asm volatile("v_cvt_pk_bf16_f32 %0, %1, %2" : "=v"(r) : "v"(lo), "v"(hi)); return r; }
__device__ __forceinline__ unsigned cvt_pk_bf16_nv(float lo, float hi) { unsigned r; asm("v_cvt_pk_bf16_f32 %0, %1, %2" : "=v"(r) : "v"(lo), "v"(hi)); return r; }
__device__ __forceinline__ float smul(float a, float b) { float r; asm("v_mul_f32 %0, %1, %2" : "=v"(r) : "v"(a), "v"(b)); return r; }
__device__ __forceinline__ void smul4t(float (&r)[4], const float (&a)[4], const float (&t)[4]) {
    asm("s_nop 0\n\tv_mul_f32 %0, %4, %8\n\tv_mul_f32 %1, %5, %9\n\tv_mul_f32 %2, %6, %10\n\tv_mul_f32 %3, %7, %11"
        : "=&v"(r[0]), "=&v"(r[1]), "=&v"(r[2]), "=&v"(r[3]) : "v"(a[0]), "v"(a[1]), "v"(a[2]), "v"(a[3]), "v"(t[0]), "v"(t[1]), "v"(t[2]), "v"(t[3]));
}
__device__ __forceinline__ f32x4 smul4(f32x4 v, float r) { return (f32x4){smul(v[0], r), smul(v[1], r), smul(v[2], r), smul(v[3], r)}; }
typedef float f32x2 __attribute__((ext_vector_type(2)));
constexpr int SSQ_STRIDE = 32;
constexpr float RMS_EPS = 1e-6f;
__device__ __forceinline__ u32x4 pack8f(f32x4 a, f32x4 b) { u32x4 w; w.x = cvt_pk_bf16(a[0], a[1]); w.y = cvt_pk_bf16(a[2], a[3]); w.z = cvt_pk_bf16(b[0], b[1]); w.w = cvt_pk_bf16(b[2], b[3]); return w; }
template <int NP4> __device__ __forceinline__ float row_rstd(const float* ssq, int row, float inv_dim) {
    const f32x4* p = (const f32x4*)(ssq + (size_t)row * SSQ_STRIDE); float s = 0.f;
#pragma unroll
    for (int j = 0; j < NP4; ++j) { const f32x4 v = p[j]; s += (v[0] + v[1]) + (v[2] + v[3]); }
    return 1.0f / sqrtf(s * inv_dim + RMS_EPS);
}
template <int NP4> __device__ __forceinline__ void lane_rstd(float (&rs)[2][4], const float* ssq, int row0w, int fr, int fq, float inv_dim) {
    const float mine0 = row_rstd<NP4>(ssq, row0w + 16 * fq + fr, inv_dim), mine1 = row_rstd<NP4>(ssq, row0w + HALF + 16 * fq + fr, inv_dim);
#pragma unroll
    for (int m = 0; m < 4; ++m) { rs[0][m] = __shfl(mine0, fr + 16 * m); rs[1][m] = __shfl(mine1, fr + 16 * m); }
    asm volatile("" ::: "memory");
}
__device__ __forceinline__ void lane_rstd_tab(float (&rs)[2][4], const PG8_LAS float* tab, int rloc  ) {
#pragma unroll
    for (int ai = 0; ai < 2; ++ai)
#pragma unroll
        for (int m = 0; m < 4; ++m) rs[ai][m] = tab[rloc + ai * HALF + m * 16];
}
__device__ __forceinline__ float sumsq4(f32x4 v) { return (v[0] * v[0] + v[1] * v[1]) + (v[2] * v[2] + v[3] * v[3]); }
__device__ __forceinline__ float silu_mul(float g, float u) { return g * u * __builtin_amdgcn_rcpf(1.0f + __builtin_amdgcn_exp2f(-1.4426950408889634f * g)); }

__device__ __forceinline__ void store_scaled_tile(const f32x4 (&acc)[2][2][4][2], const float (&rs)[2][4], bf16_t* out, int ldo, int row0, int ocol0, float* ssq_out, int slot, int fq) {
#pragma unroll
    for (int ai = 0; ai < 2; ++ai)
#pragma unroll
        for (int m = 0; m < 4; ++m) { const int row = row0 + ai * HALF + m * 16; const float r = rs[ai][m]; float s = 0.f;
#pragma unroll
            for (int bj = 0; bj < 2; ++bj) { const f32x4 v0 = smul4(acc[ai][bj][m][0], r), v1 = smul4(acc[ai][bj][m][1], r); s += sumsq4(v0) + sumsq4(v1);
                *(u32x4*)(out + (size_t)row * ldo + ocol0 + bj * HALF) = pack8f(v0, v1); }
            if (ssq_out) { s += __shfl_xor(s, 16); s += __shfl_xor(s, 32); if (fq == 0) ssq_out[(size_t)row * SSQ_STRIDE + slot] = s; }
            asm volatile("" ::: "memory"); }
}

struct EpiUp {
    static constexpr bool PERM = true, AFTER_DRAIN = false, HAS_INIT = false, I8 = true;
    bf16_t* hid; const PG8_LAS float* rtab; int n_ffn;
    bf16_t* ckv; float* ssq_ckv; bf16_t* kr; const float* cos_t; const float* sin_t; const PG8_LAS float* wtab; int pn0;
    __device__ __forceinline__ void operator()(f32x4 (&acc)[2][2][4][2], const Unit& u, int wr, int wc, int fr, int fq) const {
        const int row0 = u.pm * BM + wr * 64 + fr; float rs[2][4]; lane_rstd_tab(rs, rtab, (u.pm & 7) * BM + wr * 64 + fr);
#pragma unroll
        for (int bj = 0; bj < 2; ++bj)
#pragma unroll
            for (int n = 0; n < 2; ++n) { const f32x4 wf = *(const PG8_LAS f32x4*)(wtab + ((u.pn - pn0) >> 2) * BM + bj * HALF + wc * 32 + 8 * fq + 4 * n);
#pragma unroll
                for (int ai = 0; ai < 2; ++ai)
#pragma unroll
                    for (int m = 0; m < 4; ++m) { const i32x4 iv = __builtin_bit_cast(i32x4, acc[ai][bj][m][n]); acc[ai][bj][m][n] = (f32x4){smul((float)iv.x, wf[0]), smul((float)iv.y, wf[1]), smul((float)iv.z, wf[2]), smul((float)iv.w, wf[3])}; } }
        if (u.pn < n_ffn) {
            const int col0 = u.pn * HALF + wc * 32 + 8 * fq;
#pragma unroll
            for (int ai = 0; ai < 2; ++ai)
#pragma unroll
                for (int m = 0; m < 4; ++m) { const float r = rs[ai][m], rn = r * -1.4426950408889634f, r2 = r * r;
                    f32x4 h[2];
#pragma unroll
                    for (int n = 0; n < 2; ++n) {
                        const f32x4 xg = acc[ai][0][m][n], xu = acc[ai][1][m][n]; float e[4], rc[4];
#pragma unroll
                        for (int k = 0; k < 4; ++k) e[k] = __builtin_amdgcn_exp2f(smul(xg[k], rn));
#pragma unroll
                        for (int k = 0; k < 4; ++k) rc[k] = __builtin_amdgcn_rcpf(e[k] + 1.0f);
                        float p2[4], hh[4];
#pragma unroll
                        for (int k = 0; k < 4; ++k) p2[k] = smul(smul(xg[k], xu[k]), r2);
                        smul4t(hh, p2, rc);
#pragma unroll
                        for (int k = 0; k < 4; ++k) h[n][k] = hh[k];
                    }
                    u32x4 w; w.x = cvt_pk_bf16_nv(h[0][0], h[0][1]); w.y = cvt_pk_bf16_nv(h[0][2], h[0][3]); w.z = cvt_pk_bf16_nv(h[1][0], h[1][1]); w.w = cvt_pk_bf16_nv(h[1][2], h[1][3]);
                    *(u32x4*)(hid + (size_t)(row0 + ai * HALF + m * 16) * 5632 + col0) = w; asm volatile("" ::: "memory"); __builtin_amdgcn_sched_barrier(0); }
        } else if (u.pn < n_ffn + 2) {
            const int t = u.pn - n_ffn;
            store_scaled_tile(acc, rs, ckv, 512, row0, t * BM + wc * 32 + 8 * fq, ssq_ckv, t * 4 + wc, fq);
        } else if (wc == 0) {
#pragma unroll
            for (int ai = 0; ai < 2; ++ai)
#pragma unroll
                for (int m = 0; m < 4; ++m) { const int row = row0 + ai * HALF + m * 16; const float r = rs[ai][m];
                    const f32x4 c0 = *(const f32x4*)(cos_t + (size_t)row * 32 + 8 * fq), c1 = *(const f32x4*)(cos_t + (size_t)row * 32 + 8 * fq + 4);
                    const f32x4 s0 = *(const f32x4*)(sin_t + (size_t)row * 32 + 8 * fq), s1 = *(const f32x4*)(sin_t + (size_t)row * 32 + 8 * fq + 4);
                    const f32x4 a0 = acc[ai][0][m][0] * r, a1 = acc[ai][0][m][1] * r, b0 = acc[ai][1][m][0] * r, b1 = acc[ai][1][m][1] * r;
                    *(u32x4*)(kr + (size_t)row * 64 + 8 * fq) = pack8f(a0 * c0 - b0 * s0, a1 * c1 - b1 * s1);
                    *(u32x4*)(kr + (size_t)row * 64 + 32 + 8 * fq) = pack8f(a0 * s0 + b0 * c0, a1 * s1 + b1 * c1); asm volatile("" ::: "memory"); }
        }
    }
};
template <int HALF_STEP, bool FIN = false> struct EpiResT {
    static constexpr bool PERM = true, AFTER_DRAIN = false, HAS_INIT = true, I8 = false;
    static constexpr float alpha = HALF_STEP ? 0.5f : 1.0f, inv_alpha = HALF_STEP ? 2.0f : 1.0f;
    static __device__ __forceinline__ f32x4 sa(f32x4 v) { if constexpr (HALF_STEP) return (f32x4){__builtin_ldexpf(v[0], -1), __builtin_ldexpf(v[1], -1), __builtin_ldexpf(v[2], -1), __builtin_ldexpf(v[3], -1)}; else return v; }
    static __device__ __forceinline__ f32x4 si(f32x4 v) { if constexpr (HALF_STEP) return (f32x4){__builtin_ldexpf(v[0], 1), __builtin_ldexpf(v[1], 1), __builtin_ldexpf(v[2], 1), __builtin_ldexpf(v[3], 1)}; else return v; }
    unsigned char* wsb;
    PG8_LAS float* sm;
    float* out; const float* gain;
    unsigned target;
    static constexpr long QF_MiB = 1l << 20, QF_HB = 8 * QF_MiB, QF_SSQ = 2 * QF_MiB, QF_AMX = 1073 * QF_MiB, QF_ASC = 1072 * QF_MiB, QF_AQ = 1056 * QF_MiB  , QF_PCNT = 8448, QF_TMO = 4096 + 128  ;
    __device__ __forceinline__ void init(f32x4 (&acc)[2][2][4][2], const Unit& u, int wr, int wc, int fr, int fq) const {
        const int row0 = u.pm * BM + wr * 64 + fr, col0 = u.pn * BM + wc * 32 + 8 * fq;
#pragma unroll
        for (int ai = 0; ai < 2; ++ai)
#pragma unroll
            for (int m = 0; m < 4; ++m)
#pragma unroll
                for (int bj = 0; bj < 2; ++bj) { const u32x4 rb = *(const u32x4*)((const bf16_t*)(wsb + QF_HB) + (size_t)(row0 + ai * HALF + m * 16) * 2048 + col0 + bj * HALF);
                    acc[ai][bj][m][0] = si((f32x4){__uint_as_float(rb.x << 16), __uint_as_float(rb.x & 0xffff0000u), __uint_as_float(rb.y << 16), __uint_as_float(rb.y & 0xffff0000u)});
                    acc[ai][bj][m][1] = si((f32x4){__uint_as_float(rb.z << 16), __uint_as_float(rb.z & 0xffff0000u), __uint_as_float(rb.w << 16), __uint_as_float(rb.w & 0xffff0000u)}); }
    }
    static __device__ __forceinline__ float absmax8(u32x4 w) {
        float a = fmaxf(fabsf(__uint_as_float(w.x << 16)), fabsf(__uint_as_float(w.x & 0xffff0000u)));
        a = fmaxf(a, fmaxf(fabsf(__uint_as_float(w.y << 16)), fabsf(__uint_as_float(w.y & 0xffff0000u))));
        a = fmaxf(a, fmaxf(fabsf(__uint_as_float(w.z << 16)), fabsf(__uint_as_float(w.z & 0xffff0000u))));
        return fmaxf(a, fmaxf(fabsf(__uint_as_float(w.w << 16)), fabsf(__uint_as_float(w.w & 0xffff0000u))));
    }
    static __device__ __forceinline__ unsigned q2(unsigned u, float sc) {
        const int a0 = (int)__builtin_rintf(__uint_as_float(u << 16) * sc), a1 = (int)__builtin_rintf(__uint_as_float(u & 0xffff0000u) * sc);
        return ((unsigned)a0 & 0xffu) | (((unsigned)a1 & 0xffu) << 8);
    }
    __device__ __forceinline__ void operator()(const f32x4 (&acc)[2][2][4][2], const Unit& u, int wr, int wc, int fr, int fq) const {
        const int row0 = u.pm * BM + wr * 64 + fr, col0 = u.pn * BM + wc * 32 + 8 * fq;
        const bool fuse = target != 0u; constexpr bool last = FIN;
        bf16_t* hb = (bf16_t*)(wsb + QF_HB); float* ssq = (float*)(wsb + QF_SSQ);
#pragma unroll
        for (int ai = 0; ai < 2; ++ai)
#pragma unroll
            for (int m = 0; m < 4; ++m) { const int row = row0 + ai * HALF + m * 16; float s = 0.f, mxa = 0.f;
#pragma unroll
                for (int bj = 0; bj < 2; ++bj) { const f32x4 v0 = sa(acc[ai][bj][m][0]), v1 = sa(acc[ai][bj][m][1]); s += sumsq4(v0) + sumsq4(v1);
                    const u32x4 w = pack8f(v0, v1); mxa = fmaxf(mxa, absmax8(w));
                    if (!last) *(u32x4*)(hb + (size_t)row * 2048 + col0 + bj * HALF) = w; }
                s += __shfl_xor(s, 16); s += __shfl_xor(s, 32); if (fq == 0) ssq[(size_t)row * SSQ_STRIDE + u.pn * 4 + wc] = s;
                if (fuse) { mxa = fmaxf(mxa, __shfl_xor(mxa, 16)); mxa = fmaxf(mxa, __shfl_xor(mxa, 32));
                    if (fq == 0) sm[wc * BM + wr * 64 + ai * HALF + m * 16 + fr] = last ? s : mxa; } }
        if (!fuse) return;
        __syncthreads();
        int tq = threadIdx.x; asm volatile("" : "+v"(tq));
        float* amx = (float*)(wsb + QF_AMX);
        unsigned* tmo = (unsigned*)wsb + QF_TMO;
        if (tq < 64) {
            f32x4 a = *(const PG8_LAS f32x4*)(sm + 4 * tq);
#pragma unroll
            for (int w = 1; w < 4; ++w) { const f32x4 v = *(const PG8_LAS f32x4*)(sm + w * BM + 4 * tq);
                if constexpr (last) a = a + v; else { a[0] = fmaxf(a[0], v[0]); a[1] = fmaxf(a[1], v[1]); a[2] = fmaxf(a[2], v[2]); a[3] = fmaxf(a[3], v[3]); } }
            float* dst = amx + (size_t)(u.pm * 8 + u.pn) * BM + 4 * tq;
            asm volatile("global_store_dwordx4 %0, %1, off sc1\n\ts_nop 1" :: "v"(dst), "v"(a) : "memory");
            asm volatile("s_waitcnt vmcnt(0)" ::: "memory");
            if (tq == 0) { unsigned* pc = (unsigned*)wsb + QF_PCNT + u.pm * 16;
                (void)__hip_atomic_fetch_add(pc, 1u, __ATOMIC_RELAXED, __HIP_MEMORY_SCOPE_AGENT);
                unsigned sp = 0u;
                while (__hip_atomic_load(pc, __ATOMIC_RELAXED, __HIP_MEMORY_SCOPE_AGENT) < target) { __builtin_amdgcn_s_sleep(1);
                    if ((++sp & 255u) == 0u) { if (__hip_atomic_load(tmo, __ATOMIC_RELAXED, __HIP_MEMORY_SCOPE_AGENT)) break; if (sp > (1u << 18)) { atomicAdd(tmo, 1u); break; } } }
                __builtin_amdgcn_fence(__ATOMIC_ACQUIRE, "agent");
                asm volatile("s_waitcnt vmcnt(0)" ::: "memory"); } }
        __syncthreads();
        { const f32x4 v = *(const f32x4*)(amx + (size_t)(u.pm * 8 + (tq >> 6)) * BM + 4 * (tq & 63)); *(PG8_LAS f32x4*)(sm + (tq >> 6) * BM + 4 * (tq & 63)) = v; }
        __syncthreads();
        if (tq < BM) { float a = sm[tq];
#pragma unroll
            for (int t = 1; t < 8; ++t) { if constexpr (last) a += sm[t * BM + tq]; else a = fmaxf(a, sm[t * BM + tq]); }
            if constexpr (last) { a = 1.0f / sqrtf(a * (1.0f / 2048.0f) + RMS_EPS);
                if (__hip_atomic_load(tmo, __ATOMIC_RELAXED, __HIP_MEMORY_SCOPE_AGENT) != 0u) a = __builtin_nanf(""); }
            else if (u.pn == 0) ((float*)(wsb + QF_ASC))[u.pm * BM + tq] = a * (1.0f / 127.0f);
            sm[8 * BM + tq] = a; }
        __syncthreads();
        if (!last) {
            signed char* aq = (signed char*)(wsb + QF_AQ);
#pragma unroll
            for (int ai = 0; ai < 2; ++ai)
#pragma unroll
                for (int m = 0; m < 4; ++m) { const int row = row0 + ai * HALF + m * 16; const float rm = sm[8 * BM + wr * 64 + ai * HALF + m * 16 + fr], sc = rm > 0.f ? 127.0f / rm : 0.f;
#pragma unroll
                    for (int bj = 0; bj < 2; ++bj) { const u32x4 w = pack8f(sa(acc[ai][bj][m][0]), sa(acc[ai][bj][m][1]));
                        typedef unsigned u32x2 __attribute__((ext_vector_type(2)));
                        *(u32x2*)(aq + (size_t)row * 2048 + col0 + bj * HALF) = (u32x2){q2(w.x, sc) | (q2(w.y, sc) << 16), q2(w.z, sc) | (q2(w.w, sc) << 16)}; } }
        } else {
#pragma unroll
            for (int bj = 0; bj < 2; ++bj) { const f32x4 g0 = *(const f32x4*)(gain + col0 + bj * HALF), g1 = *(const f32x4*)(gain + col0 + bj * HALF + 4);
#pragma unroll
                for (int ai = 0; ai < 2; ++ai)
#pragma unroll
                    for (int m = 0; m < 4; ++m) { const int row = row0 + ai * HALF + m * 16; const float rs = sm[8 * BM + wr * 64 + ai * HALF + m * 16 + fr] * alpha;
                        float* o = out + (size_t)row * 2048 + col0 + bj * HALF;
                        const f32x4 a0 = smul4(acc[ai][bj][m][0], rs), a1 = smul4(acc[ai][bj][m][1], rs);
                        __builtin_nontemporal_store((f32x4){smul(a0[0], g0[0]), smul(a0[1], g0[1]), smul(a0[2], g0[2]), smul(a0[3], g0[3])}, (f32x4*)o); __builtin_nontemporal_store((f32x4){smul(a1[0], g1[0]), smul(a1[1], g1[1]), smul(a1[2], g1[2]), smul(a1[3], g1[3])}, (f32x4*)(o + 4)); asm volatile("" ::: "memory"); } }
        }
    }
};
typedef EpiResT<1> EpiRes;
struct EpiQKV {
    static constexpr bool PERM = true, AFTER_DRAIN = false, HAS_INIT = false, I8 = true;
    bf16_t* qkv; size_t tstride; const PG8_LAS float* rtab; float* kmean; const PG8_LAS float* wtab; int pn0;
    __device__ __forceinline__ void operator()(f32x4 (&acc)[2][2][4][2], const Unit& u, int wr, int wc, int fr, int fq) const {
        const int row0 = u.pm * BM + wr * 64 + fr; float rs[2][4]; lane_rstd_tab(rs, rtab, (u.pm & 7) * BM + wr * 64 + fr);
#pragma unroll
        for (int bj = 0; bj < 2; ++bj)
#pragma unroll
            for (int n = 0; n < 2; ++n) { const f32x4 wf = *(const PG8_LAS f32x4*)(wtab + ((u.pn - pn0) >> 2) * BM + bj * HALF + wc * 32 + 8 * fq + 4 * n);
#pragma unroll
                for (int ai = 0; ai < 2; ++ai)
#pragma unroll
                    for (int m = 0; m < 4; ++m) { const i32x4 iv = __builtin_bit_cast(i32x4, acc[ai][bj][m][n]); acc[ai][bj][m][n] = (f32x4){smul((float)iv.x, wf[0]), smul((float)iv.y, wf[1]), smul((float)iv.z, wf[2]), smul((float)iv.w, wf[3])}; } }
        const int t = u.pn >> 3, ocol0 = (u.pn & 7) * BM + wc * 32 + 8 * fq; bf16_t* dst = qkv + (size_t)t * tstride;
        store_scaled_tile(acc, rs, dst, 2048, row0, ocol0, nullptr, 0, fq);
        if (t == 1) {
#pragma unroll
            for (int bj = 0; bj < 2; ++bj)
#pragma unroll
                for (int n = 0; n < 2; ++n)
#pragma unroll
                    for (int e = 0; e < 4; ++e) { float s = 0.f;
#pragma unroll
                        for (int ai = 0; ai < 2; ++ai)
#pragma unroll
                            for (int m = 0; m < 4; ++m) s += acc[ai][bj][m][n][e] * rs[ai][m];
                        s += __shfl_xor(s, 1); s += __shfl_xor(s, 2); s += __shfl_xor(s, 4); s += __shfl_xor(s, 8);
                        if (fr == 0) __hip_atomic_fetch_add(kmean + (size_t)u.pm * 2048 + ocol0 + bj * HALF + 4 * n + e, s, __ATOMIC_RELAXED, __HIP_MEMORY_SCOPE_AGENT); }
        }
    }
};
struct EpiScaled {
    static constexpr bool PERM = true, AFTER_DRAIN = false, HAS_INIT = false, I8 = false;
    bf16_t* out; int ldo; const PG8_LAS float* rtab; float* ssq_out;
    __device__ __forceinline__ void operator()(const f32x4 (&acc)[2][2][4][2], const Unit& u, int wr, int wc, int fr, int fq) const {
        const int row0 = u.pm * BM + wr * 64 + fr; float rs[2][4]; lane_rstd_tab(rs, rtab, (u.pm & 7) * BM + wr * 64 + fr);
        store_scaled_tile(acc, rs, out, ldo, row0, u.pn * BM + wc * 32 + 8 * fq, ssq_out, u.pn * 4 + wc, fq);
    }
};
struct EpiUQ {
    static constexpr bool PERM = true, AFTER_DRAIN = false, HAS_INIT = false, I8 = false;
    bf16_t* qn; bf16_t* qr; const float* ssq_cq; const float* cos_t; const float* sin_t;
    __device__ __forceinline__ void operator()(const f32x4 (&acc)[2][2][4][2], const Unit& u, int wr, int wc, int fr, int fq) const {
        const int row0 = u.pm * BM + wr * 64 + fr; float rs[2][4]; lane_rstd<3>(rs, ssq_cq, row0 - fr, fr, fq, 1.0f / 768.0f);
        if (u.pn < 8) { store_scaled_tile(acc, rs, qn, 2048, row0, u.pn * BM + wc * 32 + 8 * fq, nullptr, 0, fq); }
        else { const int head = (u.pn - 8) * 4 + wc;
#pragma unroll
            for (int ai = 0; ai < 2; ++ai)
#pragma unroll
                for (int m = 0; m < 4; ++m) { const int row = row0 + ai * HALF + m * 16; const float r = rs[ai][m];
                    const f32x4 c0 = *(const f32x4*)(cos_t + (size_t)row * 32 + 8 * fq), c1 = *(const f32x4*)(cos_t + (size_t)row * 32 + 8 * fq + 4);
                    const f32x4 s0 = *(const f32x4*)(sin_t + (size_t)row * 32 + 8 * fq), s1 = *(const f32x4*)(sin_t + (size_t)row * 32 + 8 * fq + 4);
                    const f32x4 a0 = acc[ai][0][m][0] * r, a1 = acc[ai][0][m][1] * r, b0 = acc[ai][1][m][0] * r, b1 = acc[ai][1][m][1] * r;
                    *(u32x4*)(qr + (size_t)row * 1024 + head * 64 + 8 * fq) = pack8f(a0 * c0 - b0 * s0, a1 * c1 - b1 * s1);
                    *(u32x4*)(qr + (size_t)row * 1024 + head * 64 + 32 + 8 * fq) = pack8f(a0 * s0 + b0 * c0, a1 * s1 + b1 * c1); asm volatile("" ::: "memory"); } }
    }
};
struct EpiNull { static constexpr bool PERM = true, AFTER_DRAIN = false, HAS_INIT = false, I8 = false;
    __device__ __forceinline__ void operator()(const f32x4 (&acc)[2][2][4][2], const Unit&, int, int, int, int) const {
#pragma unroll
        for (int a = 0; a < 2; ++a)
#pragma unroll
            for (int b = 0; b < 2; ++b)
#pragma unroll
                for (int m = 0; m < 4; ++m)
#pragma unroll
                    for (int n = 0; n < 2; ++n) asm volatile("" :: "v"(acc[a][b][m][n])); } };
struct EpiUKV {
    static constexpr bool PERM = true, AFTER_DRAIN = false, HAS_INIT = false, I8 = false;
    bf16_t* kn; bf16_t* v; const float* ssq_ckv;
    __device__ __forceinline__ void operator()(const f32x4 (&acc)[2][2][4][2], const Unit& u, int wr, int wc, int fr, int fq) const {
        const int row0 = u.pm * BM + wr * 64 + fr; float rs[2][4]; lane_rstd<2>(rs, ssq_ckv, row0 - fr, fr, fq, 1.0f / 512.0f);
        const int ocol = u.pn * HALF + wc * 32 + 8 * fq;
#pragma unroll
        for (int ai = 0; ai < 2; ++ai)
#pragma unroll
            for (int m = 0; m < 4; ++m) { const size_t off = (size_t)(row0 + ai * HALF + m * 16) * 2048 + ocol; const float r = rs[ai][m];
                *(u32x4*)(kn + off) = pack8f(acc[ai][0][m][0] * r, acc[ai][0][m][1] * r); *(u32x4*)(v + off) = pack8f(acc[ai][1][m][0] * r, acc[ai][1][m][1] * r); }
    }
};

template <class Epi, class Sched, bool ALIGN_EPI = false, bool SP2 = false>
__device__ __forceinline__ void gemm_phase(PG8_LAS unsigned char* lds, const Gemm g, const Sched& S, const Epi& E) {
    int tid_ = threadIdx.x; asm volatile("" : "+v"(tid_));
    const int tid = tid_, wid = __builtin_amdgcn_readfirstlane(tid >> 6), lane = tid & 63, wr = wid >> 2, wc = wid & 3, fr = lane & 15, fq = lane >> 4;
    const int K = g.K, nt = K / BK;
    unsigned voffA[2], voffB[2];
#pragma unroll
    for (int i = 0; i < 2; ++i) { int R, C; stage_rc(tid * 16 + i * 8192, R, C); const int Rb = Epi::PERM ? ((R & ~31) + perm32(R & 31)) : R;
        voffA[i] = (unsigned)(R * K + C) * 2u; voffB[i] = (unsigned)(Rb * K + C) * 2u; }
    const size_t kstep = (size_t)(BK * 2);
    const size_t hstep = (size_t)HALF * K * 2;
    const size_t tstep = 2 * hstep;
    const unsigned ldsw = (unsigned)wid * 1024u;
    const int aoff = lds_byte(wr * 64 + fr, fq * 8), boff = lds_byte(wc * 32 + fr, fq * 8);
#define PG8_SA(b, h) (((b) * 2 + (h)) * HTB)
#define PG8_SB(b, h) ((4 + (b) * 2 + (h)) * HTB)
#define PG8_STAGE(bufoff, gbase, voff) do { _Pragma("unroll") for (int _i = 0; _i < 2; ++_i) \
        __builtin_amdgcn_global_load_lds((const unsigned*)((const char*)(gbase) + (voff)[_i]), (PG8_LAS unsigned*)(lds + (bufoff) + ldsw + _i * 8192), 16, 0, 0); } while (0)
#define PG8_LDA(dst, b, h) do { _Pragma("unroll") for (int m = 0; m < 4; ++m) _Pragma("unroll") for (int k = 0; k < 2; ++k) dst[m][k] = *(const PG8_LAS bf16x8*)(lds + PG8_SA(b, h) + aoff + m * 2048 + k * 1024); } while (0)
#define PG8_LDB(dst, b, h) do { _Pragma("unroll") for (int n = 0; n < 2; ++n) _Pragma("unroll") for (int k = 0; k < 2; ++k) dst[n][k] = *(const PG8_LAS bf16x8*)(lds + PG8_SB(b, h) + boff + n * 2048 + k * 1024); } while (0)
#define PG8_MMA(ai, bj, At, Bt) do { __builtin_amdgcn_s_setprio(1); _Pragma("unroll") for (int m = 0; m < 4; ++m) _Pragma("unroll") for (int n = 0; n < 2; ++n) _Pragma("unroll") for (int k = 0; k < 2; ++k) { \
        if constexpr (Epi::I8) acc[ai][bj][m][n] = __builtin_bit_cast(f32x4, __builtin_amdgcn_mfma_i32_16x16x64_i8(__builtin_bit_cast(i32x4, Bt[n][k]), __builtin_bit_cast(i32x4, At[m][k]), __builtin_bit_cast(i32x4, acc[ai][bj][m][n]), 0, 0, 0)); \
        else acc[ai][bj][m][n] = __builtin_amdgcn_mfma_f32_16x16x32_bf16(Bt[n][k], At[m][k], acc[ai][bj][m][n], 0, 0, 0); } __builtin_amdgcn_s_setprio(0); } while (0)
#define PG8_WAIT_V(n) asm volatile("s_waitcnt vmcnt(" #n ")" ::: "memory")
#define PG8_WAIT_L(n) asm volatile("s_waitcnt lgkmcnt(" #n ")" ::: "memory")
#define PG8_BAR __builtin_amdgcn_s_barrier()
#define PG8_SCHED __builtin_amdgcn_sched_barrier(0)
#define PG8_INIT(unit_) do { if constexpr (Epi::HAS_INIT) { E.init(acc, (unit_), wr, wc, fr, fq); } else { _Pragma("unroll") for (int a_ = 0; a_ < 2; ++a_) _Pragma("unroll") for (int b_ = 0; b_ < 2; ++b_) _Pragma("unroll") for (int m_ = 0; m_ < 4; ++m_) _Pragma("unroll") for (int n_ = 0; n_ < 2; ++n_) acc[a_][b_][m_][n_] = (f32x4){0.f, 0.f, 0.f, 0.f}; } } while (0)
    Unit cur, nxt; int ui = 0;
    if (!S.next(0, cur)) return;
    f32x4 acc[2][2][4][2];
    bf16x8 At[4][2], B0[2][2], B1[2][2];
    const char* cA = (const char*)g.A + (size_t)cur.pm * tstep; const char* cB = (const char*)g.Bt + (size_t)cur.pn * tstep;
    S.a_ready(cur);
    if constexpr (SP2) {
        PG8_STAGE(PG8_SB(0, 0), cB, voffB); PG8_STAGE(PG8_SB(0, 1), cB + hstep, voffB); PG8_STAGE(PG8_SA(0, 0), cA, voffA); PG8_STAGE(PG8_SA(0, 1), cA + hstep, voffA);
        PG8_INIT(cur);
        if (wr == 1) PG8_BAR;
        PG8_WAIT_V(2); PG8_BAR;
        PG8_STAGE(PG8_SB(1, 0), cB + kstep, voffB); PG8_STAGE(PG8_SA(1, 0), cA + kstep, voffA); PG8_STAGE(PG8_SB(1, 1), cB + hstep + kstep, voffB);
        PG8_WAIT_V(6); PG8_BAR;
    } else {
        PG8_STAGE(PG8_SB(0, 0), cB, voffB); PG8_STAGE(PG8_SA(0, 0), cA, voffA); PG8_STAGE(PG8_SB(0, 1), cB + hstep, voffB); PG8_STAGE(PG8_SA(0, 1), cA + hstep, voffA);
        PG8_INIT(cur);
        if (wr == 1) PG8_BAR;
        PG8_WAIT_V(4); PG8_BAR;
        PG8_STAGE(PG8_SB(1, 0), cB + kstep, voffB); PG8_STAGE(PG8_SA(1, 0), cA + kstep, voffA); PG8_STAGE(PG8_SB(1, 1), cB + hstep + kstep, voffB);
        PG8_WAIT_V(6); PG8_BAR;
    }
    for (;;) {
        const bool has_next = S.next(ui + 1, nxt);
        const char* nA = has_next ? (const char*)g.A + (size_t)nxt.pm * tstep : cA; const char* nB = has_next ? (const char*)g.Bt + (size_t)nxt.pn * tstep : cB;
        for (int t = 0; t < nt; t += 2) {
            const bool last = (t == nt - 2);
            const char* a1 = cA + (size_t)(t + 1) * kstep;
            const char* a2 = last ? nA : cA + (size_t)(t + 2) * kstep; const char* b2 = last ? nB : cB + (size_t)(t + 2) * kstep;
            const char* a3 = a2 + kstep; const char* b3 = b2 + kstep;
            if (last && has_next) S.a_ready(nxt);
            if constexpr (SP2) {
            PG8_LDB(B0, 0, 0); PG8_LDB(B1, 0, 1); PG8_SCHED; PG8_LDA(At, 0, 0); PG8_STAGE(PG8_SA(1, 1), a1 + hstep, voffA);
            PG8_WAIT_V(8); PG8_WAIT_L(0); PG8_BAR; PG8_MMA(0, 0, At, B0); PG8_MMA(0, 1, At, B1); PG8_BAR; PG8_SCHED;
            PG8_LDA(At, 0, 1); PG8_STAGE(PG8_SB(0, 0), b2, voffB); PG8_STAGE(PG8_SB(0, 1), b2 + hstep, voffB); PG8_STAGE(PG8_SA(0, 0), a2, voffA);
            PG8_WAIT_V(8); PG8_WAIT_L(0); PG8_BAR; PG8_MMA(1, 0, At, B0); PG8_MMA(1, 1, At, B1); PG8_BAR; PG8_SCHED;
            PG8_LDB(B0, 1, 0); PG8_LDB(B1, 1, 1); PG8_SCHED; PG8_LDA(At, 1, 0); PG8_STAGE(PG8_SA(0, 1), a2 + hstep, voffA);
            PG8_WAIT_V(8); PG8_WAIT_L(0); PG8_BAR; PG8_MMA(0, 0, At, B0); PG8_MMA(0, 1, At, B1); PG8_BAR; PG8_SCHED;
            PG8_LDA(At, 1, 1); PG8_STAGE(PG8_SB(1, 0), b3, voffB); PG8_STAGE(PG8_SB(1, 1), b3 + hstep, voffB); PG8_STAGE(PG8_SA(1, 0), a3, voffA);
            PG8_WAIT_V(8); PG8_WAIT_L(0); PG8_BAR; PG8_MMA(1, 0, At, B0); PG8_MMA(1, 1, At, B1); PG8_BAR; PG8_SCHED;
            } else {
            PG8_LDB(B0, 0, 0); PG8_SCHED; PG8_LDA(At, 0, 0); PG8_STAGE(PG8_SA(1, 1), a1 + hstep, voffA);
            PG8_WAIT_L(8); PG8_BAR; PG8_WAIT_L(0); PG8_MMA(0, 0, At, B0); PG8_BAR; PG8_SCHED;
            PG8_LDB(B1, 0, 1); PG8_STAGE(PG8_SB(0, 0), b2, voffB);
            PG8_BAR; PG8_WAIT_L(0); PG8_MMA(0, 1, At, B1); PG8_BAR;
            PG8_LDA(At, 0, 1); PG8_STAGE(PG8_SA(0, 0), a2, voffA);
            PG8_BAR; PG8_WAIT_L(0); PG8_MMA(1, 0, At, B0); PG8_BAR; PG8_SCHED;
            PG8_STAGE(PG8_SB(0, 1), b2 + hstep, voffB);
            PG8_WAIT_V(6); PG8_BAR; PG8_MMA(1, 1, At, B1); PG8_BAR;
            PG8_LDB(B0, 1, 0); PG8_SCHED; PG8_LDA(At, 1, 0); PG8_STAGE(PG8_SA(0, 1), a2 + hstep, voffA);
            PG8_WAIT_L(8); PG8_BAR; PG8_WAIT_L(0); PG8_MMA(0, 0, At, B0); PG8_BAR; PG8_SCHED;
            PG8_LDB(B1, 1, 1); PG8_STAGE(PG8_SB(1, 0), b3, voffB);
            PG8_BAR; PG8_WAIT_L(0); PG8_MMA(0, 1, At, B1); PG8_BAR;
            PG8_LDA(At, 1, 1); PG8_STAGE(PG8_SA(1, 0), a3, voffA);
            PG8_BAR; PG8_WAIT_L(0); PG8_MMA(1, 0, At, B0); PG8_BAR; PG8_SCHED;
            PG8_STAGE(PG8_SB(1, 1), b3 + hstep, voffB);
            PG8_WAIT_V(6); PG8_BAR; PG8_MMA(1, 1, At, B1); PG8_BAR;
            }
        }
        if constexpr (ALIGN_EPI) { if (wr == 0) PG8_BAR; }
        if constexpr (!Epi::AFTER_DRAIN) { E(acc, cur, wr, wc, fr, fq); S.done(cur); }
        if (!has_next) break;
        PG8_INIT(nxt);
        cur = nxt; cA = nA; cB = nB; ++ui;
        if constexpr (ALIGN_EPI) { if (wr == 1) PG8_BAR; }
    }
    PG8_WAIT_V(0);
    if constexpr (!ALIGN_EPI) { if (wr == 0) PG8_BAR; }
    PG8_BAR;
    if constexpr (Epi::AFTER_DRAIN) { E.fused(acc, cur, wr, wc, fr, fq, lds, wid, lane); S.done(cur); }
#undef PG8_SA
#undef PG8_SB
#undef PG8_STAGE
#undef PG8_LDA
#undef PG8_LDB
#undef PG8_MMA
#undef PG8_WAIT_V
#undef PG8_WAIT_L
#undef PG8_BAR
#undef PG8_SCHED
#undef PG8_INIT
}
}
namespace att {
using bf16 = __hip_bfloat16;
typedef short bf16x8 __attribute__((ext_vector_type(8)));
typedef short s16x4 __attribute__((ext_vector_type(4)));
typedef float f32x16 __attribute__((ext_vector_type(16)));
typedef float f32x4 __attribute__((ext_vector_type(4)));
typedef unsigned u32x4 __attribute__((ext_vector_type(4)));
constexpr int NW = 8, QBLK = 32, KVBLK = 64, QB = NW * QBLK, D = 128;
constexpr int RS = 2048, RS_QR = 1024, RS_KR = 64;
constexpr int SHM_V = KVBLK * D * 2, SHM_K = KVBLK * D * 2, SHM_KR = KVBLK * 64 * 2;
constexpr int OFF_V = 0, OFF_K = 2 * SHM_V, OFF_WS = OFF_K + 2 * SHM_K, OFF_KR = OFF_WS + NW * 64 * 4, OFF_KM = OFF_KR + 2 * SHM_KR, LDS_BYTES = OFF_KM + 32 * 256;
constexpr float THR = 8.f;
template <int MODE> struct Cfg { static constexpr float SCALE = MODE == 0 ? 0.08838834764831845f : 0.07216878364870323f; static constexpr int NQ = MODE == 0 ? 8 : 12; };

#define KSWZ(row, colB) ((row) * 256 + ((colB) ^ (((row) & 7) << 4)))
#define KRSWZ(row, colB) ((row) * 128 + ((colB) ^ ((((row) >> 1) & 7) << 4)))
#define SBAR() __builtin_amdgcn_sched_barrier(0)
__device__ __forceinline__ int v_st(int k, int c) { const int kk = (k & ~0xC) | ((k & 4) << 1) | ((k & 8) >> 1); return ((kk >> 3) * 4 + (c >> 5)) * 512 + ((kk & 7) * 32 + (c & 31)) * 2; }
__device__ __forceinline__ int v_rd_base(int lane) { return ((lane & 3) << 3) | (((lane >> 2) & 3) << 6) | (((lane >> 4) & 1) << 5) | (((lane >> 5) & 1) << 8); }
constexpr int v_rd_off(int d0, int ks, int half) { return d0 * 512 + ks * 4096 + half * 2048; }
__device__ __forceinline__ int crow(int r, int hi) { return (r & 3) + 8 * (r >> 2) + 4 * hi; }
__device__ __forceinline__ unsigned cvtpk(float lo, float hi) { unsigned r; asm volatile("v_cvt_pk_bf16_f32 %0, %1, %2" : "=v"(r) : "v"(lo), "v"(hi)); return r; }
__device__ __forceinline__ bf16x8 pack8(f32x4 a, f32x4 b) { u32x4 w = {cvtpk(a[0], a[1]), cvtpk(a[2], a[3]), cvtpk(b[0], b[1]), cvtpk(b[2], b[3])}; return *reinterpret_cast<bf16x8*>(&w); }
__device__ __forceinline__ bf16x8 load8(const bf16* p) { return *reinterpret_cast<const bf16x8*>(p); }
__device__ __forceinline__ void mask_tile(f32x16& p0, f32x16& p1, int dq) {
    const float NEG = -__builtin_inff();
#pragma unroll
    for (int r = 0; r < 16; ++r) { const int c = (r & 3) + 8 * (r >> 2); if (dq - c < 0) p0[r] = NEG; if (dq - c - 32 < 0) p1[r] = NEG; }
}
template <int MODE, bool PERROW = false> __device__ __forceinline__ void partialSM(f32x16& p0, f32x16& p1, float& m_reg, float& mn, float& alpha) {
    constexpr float SCALE = Cfg<MODE>::SCALE;
    float pmax = p0[0]; for (int r = 1; r < 16; ++r) pmax = fmaxf(pmax, p0[r]); for (int r = 0; r < 16; ++r) pmax = fmaxf(pmax, p1[r]);
    { auto rr = __builtin_amdgcn_permlane32_swap(__float_as_uint(pmax), __float_as_uint(pmax), false, false);
      pmax = fmaxf(__uint_as_float(rr[0]), __uint_as_float(rr[1])); }
    constexpr float C2 = 1.4426950408889634f * SCALE;
    if constexpr (PERROW) {
        const bool keep = (pmax - m_reg) * SCALE <= THR; mn = keep ? m_reg : fmaxf(m_reg, pmax); alpha = keep ? 1.f : __builtin_amdgcn_exp2f((m_reg - mn) * C2); m_reg = mn; }
    else if (__builtin_expect(__all((pmax - m_reg) * SCALE <= THR), 1)) { mn = m_reg; alpha = 1.f; }
    else { mn = fmaxf(m_reg, pmax); alpha = __builtin_amdgcn_exp2f((m_reg - mn) * C2); m_reg = mn; }
    const float mnL = -mn * C2;
    for (int r = 0; r < 16; ++r) p0[r] = fmaf(p0[r], C2, mnL); for (int r = 0; r < 16; ++r) p1[r] = fmaf(p1[r], C2, mnL);
    for (int r = 0; r < 16; ++r) p0[r] = __builtin_amdgcn_exp2f(p0[r]);
}
__device__ __forceinline__ void finishSM(f32x16& p0, f32x16& p1, float alpha, float& l_reg, bf16x8& pa0, bf16x8& pa1, bf16x8& pa2, bf16x8& pa3) {
    for (int r = 0; r < 16; ++r) p1[r] = __builtin_amdgcn_exp2f(p1[r]);
    float ps = 0; for (int r = 0; r < 16; ++r) ps += p0[r]; for (int r = 0; r < 16; ++r) ps += p1[r];
    { auto rr = __builtin_amdgcn_permlane32_swap(__float_as_uint(ps), __float_as_uint(ps), false, false);
      ps = __uint_as_float(rr[0]) + __uint_as_float(rr[1]); }
    l_reg = l_reg * alpha + ps;
#define PK4(P, B_, OUT) do { unsigned a0 = cvtpk(P[B_+0], P[B_+1]), a1 = cvtpk(P[B_+2], P[B_+3]);                          \
        unsigned b0 = cvtpk(P[B_+4], P[B_+5]), b1 = cvtpk(P[B_+6], P[B_+7]);                                             \
        auto r0 = __builtin_amdgcn_permlane32_swap(a0, b0, false, false); auto r1 = __builtin_amdgcn_permlane32_swap(a1, b1, false, false); \
        u32x4 w = {r0[0], r1[0], r0[1], r1[1]}; OUT = *reinterpret_cast<bf16x8*>(&w); } while (0)
    PK4(p0, 0, pa0); PK4(p0, 8, pa1); PK4(p1, 0, pa2); PK4(p1, 8, pa3);
#undef PK4
}
template <int MODE, int KB>
__device__ __forceinline__ void qkt(f32x16& p0, f32x16& p1, const char* K_lds, const char* KR_lds, int r32, int hi, const bf16x8* qr, float slopeP, float tb) {
    if constexpr (MODE == 0) {
#pragma unroll
        for (int r = 0; r < 16; ++r) { const int c = (r & 3) + 8 * (r >> 2); p0[r] = fmaf(slopeP, (float)c, tb); p1[r] = fmaf(slopeP, (float)(c + 32), tb); }
    } else { p0 = f32x16{}; p1 = f32x16{}; }
    const char* kb[4];
#pragma unroll
    for (int dd = 0; dd < 4; ++dd) kb[dd] = K_lds + KB * SHM_K + KSWZ(r32, (dd * 16 + hi * 8) * 2);
    constexpr int NS = MODE == 1 ? 12 : 8;
    bf16x8 f0[2], f1[2];
#define QK_RD(d, s_) do { if ((d) < 8) { const char* a_ = kb[(d) & 3] + ((d) >> 2) * 128; f0[s_] = *reinterpret_cast<const bf16x8*>(a_); f1[s_] = *reinterpret_cast<const bf16x8*>(a_ + 32 * 256); }   \
        else { const char* a_ = KR_lds + KB * SHM_KR + KRSWZ(r32, ((((d) - 8) & 3) * 16 + hi * 8) * 2); f0[s_] = *reinterpret_cast<const bf16x8*>(a_); f1[s_] = *reinterpret_cast<const bf16x8*>(a_ + 32 * 128); } } while (0)
    QK_RD(0, 0);
#pragma unroll
    for (int d = 0; d < NS; ++d) {
        if (d + 1 < NS) QK_RD(d + 1, (d + 1) & 1);
        SBAR();
        p0 = __builtin_amdgcn_mfma_f32_32x32x16_bf16(f0[d & 1], qr[d], p0, 0, 0, 0);
        p1 = __builtin_amdgcn_mfma_f32_32x32x16_bf16(f1[d & 1], qr[d], p1, 0, 0, 0);
        SBAR();
    }
#undef QK_RD
}
template <int VB>
__device__ __forceinline__ void pv_tile(f32x16* o, int vb0, bf16x8 pa0, bf16x8 pa1, bf16x8 pa2, bf16x8 pa3) {
#define TRRD(dst, off) asm volatile("ds_read_b64_tr_b16 %0, %1 offset:%2" : "=&v"(dst) : "v"(vb0), "i"(off) : "memory")
#define PV_D0(d0) do { s16x4 l0, l1, l2, l3, h0, h1, h2, h3; constexpr int b_ = VB * SHM_V + v_rd_off(d0, 0, 0);   \
        TRRD(l0, b_); TRRD(h0, b_ + 2048); TRRD(l1, b_ + 4096); TRRD(h1, b_ + 6144); TRRD(l2, b_ + 8192); TRRD(h2, b_ + 10240); TRRD(l3, b_ + 12288); TRRD(h3, b_ + 14336); \
        asm volatile("s_waitcnt lgkmcnt(0)" ::: "memory"); SBAR();   \
        o[d0] = __builtin_amdgcn_mfma_f32_32x32x16_bf16(pa0, (bf16x8){l0[0], l0[1], l0[2], l0[3], h0[0], h0[1], h0[2], h0[3]}, o[d0], 0, 0, 0);   \
        o[d0] = __builtin_amdgcn_mfma_f32_32x32x16_bf16(pa1, (bf16x8){l1[0], l1[1], l1[2], l1[3], h1[0], h1[1], h1[2], h1[3]}, o[d0], 0, 0, 0);   \
        o[d0] = __builtin_amdgcn_mfma_f32_32x32x16_bf16(pa2, (bf16x8){l2[0], l2[1], l2[2], l2[3], h2[0], h2[1], h2[2], h2[3]}, o[d0], 0, 0, 0);   \
        o[d0] = __builtin_amdgcn_mfma_f32_32x32x16_bf16(pa3, (bf16x8){l3[0], l3[1], l3[2], l3[3], h3[0], h3[1], h3[2], h3[3]}, o[d0], 0, 0, 0); } while (0)
    PV_D0(0); PV_D0(1); PV_D0(2); PV_D0(3);
#undef PV_D0
#undef TRRD
}

__device__ __forceinline__ void store_o_rows(const f32x16* o, char* stg, bf16* Ow, size_t ldo, int lane, int r32, int hi) {
#pragma unroll
    for (int p = 0; p < 2; ++p) {
#pragma unroll
        for (int rr = 0; rr < 8; ++rr) { const int r = 8 * p + rr, lrow = (rr & 3) + 8 * (rr >> 2) + 4 * hi;
#pragma unroll
            for (int d0 = 0; d0 < 4; ++d0) *(unsigned short*)(stg + lrow * 256 + (d0 * 32 + r32) * 2) = (unsigned short)cvtpk(o[d0][r], 0.f); }
        asm volatile("s_waitcnt lgkmcnt(0)" ::: "memory");
#pragma unroll
        for (int i = 0; i < 4; ++i) { const int row = 4 * i + (lane >> 4), ch = lane & 15; const u32x4 v = *(const u32x4*)(stg + row * 256 + ch * 16);
            *(u32x4*)(Ow + (size_t)(16 * p + row) * ldo + ch * 8) = v; }
        asm volatile("s_waitcnt lgkmcnt(0)" ::: "memory");
    }
}
struct BlockRef { const bf16* Q; const bf16* QR; const bf16* K; const bf16* V; bf16* O; int P0; int h; };
template <int MODE> struct Seam { bf16x8 qr[Cfg<MODE>::NQ]; bf16x8 st_v0, st_v1, st_k0, st_k1, st_kr; };
struct Shared { const bf16* KR; const float* kmean; };

#define ROW(p, k0, rr) ((p) + (size_t)((k0) + (rr)) * RS + sc)
#define VMW() asm volatile("s_waitcnt vmcnt(0)" ::: "memory")
#define VMWN(n) asm volatile("s_waitcnt vmcnt(%0)" :: "i"(n) : "memory")
#define SLOAD_H(Kp, Vp, k0) do { S.st_v0 = load8(ROW(Vp, k0, sr)); S.st_v1 = load8(ROW(Vp, k0, 32 + sr));              \
                         S.st_k0 = load8(ROW(Kp, k0, sr)); S.st_k1 = load8(ROW(Kp, k0, 32 + sr));                       \
                         if constexpr (MODE == 1) S.st_kr = load8(G.KR + (size_t)((k0) + krr) * RS_KR + krc); } while (0)
#define SWRITE_HK(bf) do { *(bf16x8*)(K_lds + (bf) * SHM_K + kws) = S.st_k0; *(bf16x8*)(K_lds + (bf) * SHM_K + kws + 32 * 256) = S.st_k1; \
                           if constexpr (MODE == 1) *(bf16x8*)(KR_lds + (bf) * SHM_KR + krws) = S.st_kr; } while (0)
#define SWRITE_HV(bf) do { *(bf16x8*)(V_lds + (bf) * SHM_V + vst0) = S.st_v0; *(bf16x8*)(V_lds + (bf) * SHM_V + vst1) = S.st_v1; } while (0)
#define SWRITE_H(bf) do { SWRITE_HV(bf); SWRITE_HK(bf); } while (0)
#define QLOAD(Sq, ref) do { _Pragma("unroll") for (int d0 = 0; d0 < 8; ++d0) Sq.qr[d0] = load8((ref).Q + (size_t)(wid * QBLK + r32) * RS + d0 * 16 + hi * 8);    \
        if constexpr (MODE == 1) { _Pragma("unroll") for (int d0 = 0; d0 < 4; ++d0) Sq.qr[8 + d0] = load8((ref).QR + (size_t)(wid * QBLK + r32) * RS_QR + d0 * 16 + hi * 8); } } while (0)

template <int MODE>
__device__ __forceinline__ void attn_prime(const BlockRef& cur, const Shared& G, char* lds, Seam<MODE>& S) {
    int tid_ = threadIdx.x; asm volatile("" : "+v"(tid_));
    const int tid = tid_, wid = __builtin_amdgcn_readfirstlane(tid >> 6), lane = tid & 63, r32 = lane & 31, hi = lane >> 5;
    const int sr = tid >> 4, sc = (tid & 15) * 8, vst0 = v_st(sr, sc), vst1 = v_st(32 + sr, sc), kws = KSWZ(sr, sc * 2);
    char* V_lds = lds + OFF_V; char* K_lds = lds + OFF_K; char* KR_lds = lds + OFF_KR;
    const int krr = tid >> 3, krc = (tid & 7) * 8, krws = KRSWZ(krr, krc * 2);
    QLOAD(S, cur);
    SLOAD_H(cur.K, cur.V, 0); VMW(); SWRITE_H(0);
    __syncthreads();
}
template <int MODE>
__device__ __forceinline__ void attn_block(const BlockRef& cur, const BlockRef& nxt, const Shared& G, char* lds, Seam<MODE>& S) {
    constexpr float SCALE = Cfg<MODE>::SCALE;
    int tid_ = threadIdx.x; asm volatile("" : "+v"(tid_));
    const int tid = tid_, wid = __builtin_amdgcn_readfirstlane(tid >> 6), lane = tid & 63, r32 = lane & 31, hi = lane >> 5;
    const int NT = (cur.P0 + QB) / KVBLK;
    const int qlo = cur.P0 + wid * QBLK, qm = qlo + r32 - 4 * hi;
    char* V_lds = lds + OFF_V; char* K_lds = lds + OFF_K; char* KR_lds = lds + OFF_KR;
    float* ws = (float*)(lds + OFF_WS) + wid * 64; float* li_l = ws, * al_l = ws + 32;
    float m_reg = -1e30f, l_reg = 0; f32x16 o[4] = {};
    const int sr = tid >> 4, sc = (tid & 15) * 8, vst0 = v_st(sr, sc), vst1 = v_st(32 + sr, sc), kws = KSWZ(sr, sc * 2);
    const int krr = tid >> 3, krc = (tid & 7) * 8, krws = KRSWZ(krr, krc * 2);
    const int vb0 = (int)(uintptr_t)V_lds + v_rd_base(lane);
    const bf16* Kh = cur.K; const bf16* Vh = cur.V;
    unsigned selmask = 0u; float slopeP = 0.f;
    if constexpr (MODE == 0) {
        { const int e_ = cur.h + 1; slopeP = __builtin_ldexpf((e_ & 1) ? 0.70710678118654752f : 1.0f, -(e_ >> 1)) * (1.0f / SCALE); }
        { const int row = tid >> 4, c8 = (tid & 15) * 8; const float* src = G.kmean + (size_t)row * 2048 + cur.h * 128 + c8;
          const f32x4 a = *(const f32x4*)src * (1.0f / 256.0f), b = *(const f32x4*)(src + 4) * (1.0f / 256.0f);
          *(bf16x8*)(lds + OFF_KM + KSWZ(row, c8 * 2)) = pack8(a, b); }
        __syncthreads();
        f32x16 g = {};
#pragma unroll
        for (int d0 = 0; d0 < 8; ++d0) { const bf16x8 kf = *reinterpret_cast<const bf16x8*>(lds + OFF_KM + KSWZ(r32, (d0 * 16 + hi * 8) * 2)); g = __builtin_amdgcn_mfma_f32_32x32x16_bf16(kf, S.qr[d0], g, 0, 0, 0); }
        const int qb = cur.P0 >> 8; const float NEG = -__builtin_inff();
        float gv[16];
#pragma unroll
        for (int r = 0; r < 16; ++r) gv[r] = (crow(r, hi) < qb) ? g[r] : NEG;
        float a1 = NEG, a2 = NEG, a3 = NEG;
#pragma unroll
        for (int r = 0; r < 16; ++r) a1 = fmaxf(a1, gv[r]);
#pragma unroll
        for (int r = 0; r < 16; ++r) a2 = fmaxf(a2, gv[r] < a1 ? gv[r] : NEG);
#pragma unroll
        for (int r = 0; r < 16; ++r) a3 = fmaxf(a3, gv[r] < a2 ? gv[r] : NEG);
        const float b1 = __shfl_xor(a1, 32), b2 = __shfl_xor(a2, 32), b3 = __shfl_xor(a3, 32);
        const float T = fmaxf(fmaxf(a3, b3), fmaxf(fminf(a2, b1), fminf(a1, b2)));
        unsigned msk = 0u;
#pragma unroll
        for (int r = 0; r < 16; ++r) if (gv[r] >= T && crow(r, hi) < qb) msk |= 1u << crow(r, hi);
        selmask = msk | (unsigned)__shfl_xor((int)msk, 32);
    }
#define RESC(a) do { if (__any((a) < 1.f)) { if (hi == 0) al_l[r32] = (a); asm volatile("s_waitcnt lgkmcnt(0)" ::: "memory");              \
                     for (int d_ = 0; d_ < 4; ++d_) for (int r = 0; r < 16; ++r) o[d_][r] *= al_l[crow(r, hi)]; } } while (0)
#define KBASE(t) ((t) * KVBLK)
#define TB(t) (slopeP * (float)(KBASE(t) - cur.P0 + 4 * hi))
#define MASKT(P0_, P1_, t) do { const int kb_ = KBASE(t);                                                                                     \
        if (MODE == 0 && kb_ < cur.P0) { if (!((selmask >> (kb_ >> 8)) & 1u)) { const float NEG_ = -__builtin_inff();                        \
                _Pragma("unroll") for (int r = 0; r < 16; ++r) { P0_[r] = NEG_; P1_[r] = NEG_; } } }                                          \
        else if (kb_ + KVBLK - 1 > qlo) mask_tile(P0_, P1_, qm - kb_); } while (0)
    f32x16 p0, p1; float mn, al; bf16x8 pa0, pa1, pa2, pa3;
#define TILE(t, B) do {                                                                                                       \
        const bool lastt_ = (t) + 1 >= NT;                                                                                    \
        if (!lastt_) { SLOAD_H(Kh, Vh, KBASE((t) + 1)); } else { SLOAD_H(nxt.K, nxt.V, 0); }                                  \
        SBAR(); qkt<MODE, B>(p0, p1, K_lds, KR_lds, r32, hi, S.qr, slopeP, TB(t)); SBAR();                                    \
        if (lastt_) { QLOAD(S, nxt); SBAR(); }                                                                                \
        MASKT(p0, p1, (t)); partialSM<MODE>(p0, p1, m_reg, mn, al); RESC(al);                                                 \
        finishSM(p0, p1, al, l_reg, pa0, pa1, pa2, pa3); SBAR();                                                              \
        pv_tile<B>(o, vb0, pa0, pa1, pa2, pa3); SBAR();                                                                       \
        SWRITE_H((B) ^ 1);                                                                                                    \
        __syncthreads(); } while (0)
    for (int t = 0; t < NT; t += 2) { TILE(t, 0); TILE(t + 1, 1); }
    if (hi == 0) li_l[r32] = l_reg; asm volatile("s_waitcnt lgkmcnt(0)" ::: "memory");
    float rli[16];
#pragma unroll
    for (int r = 0; r < 16; ++r) rli[r] = __builtin_amdgcn_rcpf(li_l[crow(r, hi)]);
#pragma unroll
    for (int r = 0; r < 16; ++r)
#pragma unroll
        for (int d0 = 0; d0 < 4; ++d0) o[d0][r] *= rli[r];
    store_o_rows(o, lds + (wid < 4 ? OFF_V + SHM_V + wid * 4096 : OFF_K + SHM_K + (wid - 4) * 4096), cur.O + (size_t)(wid * QBLK) * RS, RS, lane, r32, hi);
    __syncthreads();
#undef RESC
#undef KBASE
#undef TB
#undef MASKT
#undef TILE
}
#undef ROW
#undef VMW
#undef VMWN
#undef SLOAD_H
#undef SWRITE_HK
#undef SWRITE_HV
#undef SWRITE_H
#undef QLOAD

__device__ __forceinline__ BlockRef mkref(const bf16* Q, const bf16* QRp, const bf16* K, const bf16* V, bf16* O, int L_, int pass) {
    const int xcd = L_ & 7, k = L_ >> 3, h = 2 * xcd + (k >> 4), s = k & 15, qb = pass ? 31 - s : s;
    BlockRef r; r.Q = Q + (size_t)qb * QB * RS + h * 128; r.QR = QRp + (size_t)qb * QB * RS_QR + h * 64; r.K = K + h * 128; r.V = V + h * 128; r.O = O + (size_t)qb * QB * RS + h * 128; r.P0 = qb * QB; r.h = h; return r;
}
template <int MODE>
__device__ __forceinline__ void attn_phase(char* lds, const bf16* Q, const bf16* QRp, const bf16* K, const bf16* V, bf16* O, const Shared& G) {
    const int total = 256, stride = gridDim.x;
    int L = blockIdx.x; if (L >= total) return;
    int pass = 0; BlockRef cur = mkref(Q, QRp, K, V, O, L, 0);
    Seam<MODE> S;
    attn_prime<MODE>(cur, G, lds, S);
    for (;;) {
        const bool more_pass = pass == 0, more_item = L + stride < total, last = !more_pass && !more_item;
        int passn = pass + 1, Ln = L;
        if (!more_pass) { passn = 0; Ln = more_item ? L + stride : L; }
        const BlockRef nxt = last ? cur : mkref(Q, QRp, K, V, O, Ln, passn);
        attn_block<MODE>(cur, nxt, G, lds, S);
        if (last) break;
        cur = nxt; pass = passn; L = Ln;
    }
}
struct MobaBufs { unsigned* cnt; unsigned short* list; bf16* po; float* pml; };
constexpr int OFF_SCAN = OFF_KM;
constexpr int OFF_X = OFF_KM + 4096;

__device__ __forceinline__ unsigned moba_top3(const f32x16& g, int qb, int hi) {
    const float NEG = -__builtin_inff(); int hi_g = hi; asm volatile("" : "+v"(hi_g));
    float gv[16];
#pragma unroll
    for (int r = 0; r < 16; ++r) gv[r] = (crow(r, hi_g) < qb) ? g[r] : NEG;
    float a1 = NEG, a2 = NEG, a3 = NEG;
#pragma unroll
    for (int r = 0; r < 16; ++r) a1 = fmaxf(a1, gv[r]);
#pragma unroll
    for (int r = 0; r < 16; ++r) a2 = fmaxf(a2, gv[r] < a1 ? gv[r] : NEG);
#pragma unroll
    for (int r = 0; r < 16; ++r) a3 = fmaxf(a3, gv[r] < a2 ? gv[r] : NEG);
    const float b1 = __shfl_xor(a1, 32), b2 = __shfl_xor(a2, 32), b3 = __shfl_xor(a3, 32);
    const float T = fmaxf(fmaxf(a3, b3), fmaxf(fminf(a2, b1), fminf(a1, b2)));
    unsigned msk = 0u;
#pragma unroll
    for (int r = 0; r < 16; ++r) if (gv[r] >= T && crow(r, hi_g) < qb) msk |= 1u << crow(r, hi_g);
    return msk | (unsigned)__shfl_xor((int)msk, 32);
}
__device__ __forceinline__ void moba_gate_phase(char* lds, const bf16* Q, const float* kmean, const MobaBufs& B) {
    int tid_ = threadIdx.x; asm volatile("" : "+v"(tid_));
    const int tid = tid_, wid = __builtin_amdgcn_readfirstlane(tid >> 6), lane = tid & 63, r32 = lane & 31, hi = lane >> 5;
    for (int item = blockIdx.x; item < 512; item += gridDim.x) {
        const int h = item >> 5, qb = item & 31;
        { const int row = tid >> 4, c8 = (tid & 15) * 8; const float* src = kmean + (size_t)row * 2048 + h * 128 + c8;
          const f32x4 a = *(const f32x4*)src * (1.0f / 256.0f), b = *(const f32x4*)(src + 4) * (1.0f / 256.0f);
          *(bf16x8*)(lds + OFF_KM + KSWZ(row, c8 * 2)) = pack8(a, b); }
        __syncthreads();
        const int q = qb * QB + wid * QBLK + r32; const bf16* Qw = Q + (size_t)q * RS + h * 128;
        f32x16 g = {};
#pragma unroll
        for (int d0 = 0; d0 < 8; ++d0) { const bf16x8 kf = *reinterpret_cast<const bf16x8*>(lds + OFF_KM + KSWZ(r32, (d0 * 16 + hi * 8) * 2)); g = __builtin_amdgcn_mfma_f32_32x32x16_bf16(kf, load8(Qw + d0 * 16 + hi * 8), g, 0, 0, 0); }
        const unsigned m = moba_top3(g, qb, hi);
        unsigned* lcnt = (unsigned*)(lds + OFF_WS); unsigned* gbase = lcnt + 32;
        if (tid < 32) lcnt[tid] = 0u;
        __syncthreads();
        unsigned pk[3] = {0u, 0u, 0u}; int npk = 0;
        if (hi == 0) { unsigned mm = m;
#pragma unroll
            for (int jj = 0; jj < 3; ++jj) if (mm) { const int n = __builtin_ctz(mm); mm &= mm - 1u; const unsigned lr = __hip_atomic_fetch_add(lcnt + n, 1u, __ATOMIC_RELAXED, __HIP_MEMORY_SCOPE_WORKGROUP); pk[jj] = (unsigned)n | (lr << 8); npk = jj + 1; } }
        __syncthreads();
        if (tid < 32) { const unsigned c = lcnt[tid]; gbase[tid] = c ? __hip_atomic_fetch_add(B.cnt + h * 32 + tid, c, __ATOMIC_RELAXED, __HIP_MEMORY_SCOPE_AGENT) : 0u; }
        __syncthreads();
        if (hi == 0) {
            float* pm = B.pml + ((size_t)(h * 8192 + q) * 3) * 2;
            float ninf_ = -1e30f, zero_ = 0.f; asm volatile("" : "+v"(ninf_), "+v"(zero_));
#pragma unroll
            for (int jj = 0; jj < 3; ++jj) { pm[2 * jj] = ninf_; pm[2 * jj + 1] = zero_; }
#pragma unroll
            for (int jj = 0; jj < 3; ++jj) if (jj < npk) { const int n = pk[jj] & 31u; B.list[(size_t)(h * 32 + n) * 8192 + gbase[n] + (pk[jj] >> 8)] = (unsigned short)(q | (jj << 13)); }
        }
        __syncthreads();
    }
}
template <bool CAUSAL>
__device__ __forceinline__ void moba_blk4(char* lds, const bf16* Kb, const bf16* Vb, const bf16x8* qr, float slopeP, int kabs0, int qpos, int qlo, float& m_reg, float& l_reg, f32x16* o,
                                          int tid, int wid, int lane, int r32, int hi) {
    char* V_lds = lds + OFF_V; char* K_lds = lds + OFF_K; float* al_l = (float*)(lds + OFF_WS) + wid * 64 + 32;
    const int sr = tid >> 4, sc = (tid & 15) * 8, vst0 = v_st(sr, sc), vst1 = v_st(32 + sr, sc), kws = KSWZ(sr, sc * 2);
    const unsigned soff0 = (unsigned)(sr * RS + sc), soff1 = soff0 + 32u * RS;
    const int vb0 = (int)(uintptr_t)V_lds + v_rd_base(lane);
    const float tb0 = slopeP * (float)(kabs0 + 4 * hi - qpos); const int qm = qpos - 4 * hi;
    bf16x8 st_v0, st_v1, st_k0, st_k1; f32x16 p0, p1; float mn, al; bf16x8 pa0, pa1, pa2, pa3;
#define LOADT(t) do { const bf16* kb_ = Kb + (size_t)((t) * KVBLK) * RS; const bf16* vb_ = Vb + (size_t)((t) * KVBLK) * RS; st_v0 = load8(vb_ + soff0); st_v1 = load8(vb_ + soff1); st_k0 = load8(kb_ + soff0); st_k1 = load8(kb_ + soff1); } while (0)
#define WRITET(bf) do { *(bf16x8*)(V_lds + (bf) * SHM_V + vst0) = st_v0; *(bf16x8*)(V_lds + (bf) * SHM_V + vst1) = st_v1; *(bf16x8*)(K_lds + (bf) * SHM_K + kws) = st_k0; *(bf16x8*)(K_lds + (bf) * SHM_K + kws + 32 * 256) = st_k1; } while (0)
#define RESC4(a) do { if (__any((a) < 1.f)) { if (hi == 0) al_l[r32] = (a); asm volatile("s_waitcnt lgkmcnt(0)" ::: "memory"); int hi_r = hi; asm volatile("" : "+v"(hi_r));   \
                      for (int d_ = 0; d_ < 4; ++d_) for (int r = 0; r < 16; ++r) o[d_][r] *= al_l[crow(r, hi_r)]; } } while (0)
#define T4(t, Bf) do { if ((t) < 3) LOADT((t) + 1);                                                                                           \
        SBAR(); qkt<0, Bf>(p0, p1, K_lds, K_lds, r32, hi, qr, slopeP, tb0 + slopeP * (float)((t) * KVBLK)); SBAR();                           \
        if (CAUSAL) { const int kb_ = kabs0 + (t) * KVBLK; if (kb_ + KVBLK - 1 > qlo) mask_tile(p0, p1, qm - kb_); }                          \
        partialSM<0, true>(p0, p1, m_reg, mn, al); RESC4(al); finishSM(p0, p1, al, l_reg, pa0, pa1, pa2, pa3); SBAR();                              \
        pv_tile<Bf>(o, vb0, pa0, pa1, pa2, pa3); SBAR();                                                                                      \
        if ((t) < 3) WRITET((Bf) ^ 1);                                                                                                        \
        __syncthreads(); } while (0)
    LOADT(0); WRITET(0); __syncthreads();
    T4(0, 0); T4(1, 1); T4(2, 0); T4(3, 1);
#undef LOADT
#undef WRITET
#undef RESC4
#undef T4
}
__device__ __forceinline__ float moba_slope(int h) { const int e_ = h + 1; return __builtin_ldexpf((e_ & 1) ? 0.70710678118654752f : 1.0f, -(e_ >> 1)) * (1.0f / Cfg<0>::SCALE); }
__device__ __forceinline__ void moba_sel_phase(char* lds, const bf16* Q, const bf16* K, const bf16* V, const MobaBufs& B) {
    int tid_ = threadIdx.x; asm volatile("" : "+v"(tid_));
    const int tid = tid_, wid = __builtin_amdgcn_readfirstlane(tid >> 6), lane = tid & 63, r32 = lane & 31, hi = lane >> 5;
    unsigned* pre = (unsigned*)(lds + OFF_SCAN);
    { unsigned v = (B.cnt[tid] + 255u) >> 8;
#pragma unroll
      for (int o_ = 1; o_ < 64; o_ <<= 1) { const unsigned t = (unsigned)__shfl_up((int)v, o_); if (lane >= o_) v += t; }
      if (lane == 63) pre[512 + wid] = v;
      __syncthreads();
      unsigned off = 0u;
#pragma unroll
      for (int w = 0; w < 8; ++w) off += (w < wid) ? pre[512 + w] : 0u;
      pre[tid] = v + off; __syncthreads(); }
    const unsigned U = pre[511];
    float* ws = (float*)(lds + OFF_WS) + wid * 64; float* li_l = ws; unsigned* ent_l = (unsigned*)(lds + OFF_X) + wid * 64;
    const unsigned gsz_ = gridDim.x, vb_ = (gsz_ & 7u) ? blockIdx.x : (blockIdx.x & 7u) * (gsz_ >> 3) + (blockIdx.x >> 3);
    for (unsigned u = vb_; u < U; u += gsz_) {
        int lo_ = 0, hi_ = 511; while (lo_ < hi_) { const int mid = (lo_ + hi_) >> 1; if (pre[mid] > u) hi_ = mid; else lo_ = mid + 1; }
        const int b = __builtin_amdgcn_readfirstlane(lo_), h = b >> 5, n = b & 31, slice = (int)(u - (b ? pre[b - 1] : 0u));
        const int cntb = (int)B.cnt[b]; int valid = cntb - slice * 256; if (valid > 256) valid = 256;
        const int e = wid * QBLK + r32; const unsigned ent = B.list[(size_t)b * 8192 + slice * 256 + (e < valid ? e : valid - 1)];
        const int q = ent & 8191; const bool rowvalid = e < valid;
        bf16x8 qr[8];
#pragma unroll
        for (int d0 = 0; d0 < 8; ++d0) qr[d0] = load8(Q + (size_t)q * RS + h * 128 + d0 * 16 + hi * 8);
        float m_reg = -1e30f, l_reg = 0.f; f32x16 o[4] = {};
        moba_blk4<false>(lds, K + (size_t)(n * 256) * RS + h * 128, V + (size_t)(n * 256) * RS + h * 128, qr, moba_slope(h), n * 256, q, 0, m_reg, l_reg, o, tid, wid, lane, r32, hi);
        if (hi == 0) { li_l[r32] = l_reg; ent_l[r32] = ent | (rowvalid ? 0x8000u : 0u); } asm volatile("s_waitcnt lgkmcnt(0)" ::: "memory");
        int hi_e = hi; asm volatile("" : "+v"(hi_e));
#pragma unroll
        for (int r = 0; r < 16; ++r) { const int row = crow(r, hi_e); const float rl = __builtin_amdgcn_rcpf(li_l[row]); const unsigned er = ent_l[row];
            bf16* pb = B.po + ((size_t)(h * 8192 + (int)(er & 8191u)) * 3 + ((er >> 13) & 3u)) * 128;
            typedef unsigned u32x2 __attribute__((ext_vector_type(2)));
            const u32x2 w = {cvtpk(o[0][r] * rl, o[1][r] * rl), cvtpk(o[2][r] * rl, o[3][r] * rl)};
            if (er & 0x8000u) __builtin_nontemporal_store(w, (u32x2*)(pb + r32 * 4)); }
        if (hi == 0 && rowvalid) { float* pm = B.pml + ((size_t)(h * 8192 + q) * 3 + (ent >> 13)) * 2; pm[0] = m_reg; pm[1] = l_reg; }
    }
}
__device__ __forceinline__ void moba_own_phase(char* lds, const bf16* Q, const bf16* K, const bf16* V, bf16* O, const MobaBufs& B) {
    int tid_ = threadIdx.x; asm volatile("" : "+v"(tid_));
    const int tid = tid_, wid = __builtin_amdgcn_readfirstlane(tid >> 6), lane = tid & 63, r32 = lane & 31, hi = lane >> 5;
    constexpr float C2 = 1.4426950408889634f * Cfg<0>::SCALE;
    float* ws = (float*)(lds + OFF_WS) + wid * 64; float* li_l = ws; float* mi_l = (float*)(lds + OFF_X) + wid * 64;
    for (int item = blockIdx.x; item < 512; item += gridDim.x) {
        const int xcd = item & 7, k_ = item >> 3, h = 2 * xcd + (k_ >> 5), qb = k_ & 31, P0 = qb * QB, qpos = P0 + wid * QBLK + r32;
        bf16x8 qr[8];
#pragma unroll
        for (int d0 = 0; d0 < 8; ++d0) qr[d0] = load8(Q + (size_t)qpos * RS + h * 128 + d0 * 16 + hi * 8);
        float m_reg = -1e30f, l_reg = 0.f; f32x16 o[4] = {};
        moba_blk4<true>(lds, K + (size_t)P0 * RS + h * 128, V + (size_t)P0 * RS + h * 128, qr, moba_slope(h), P0, qpos, P0 + wid * QBLK, m_reg, l_reg, o, tid, wid, lane, r32, hi);
        if (hi == 0) { li_l[r32] = l_reg; mi_l[r32] = m_reg; } asm volatile("s_waitcnt lgkmcnt(0)" ::: "memory");
        int hi_e = hi; asm volatile("" : "+v"(hi_e));
        bf16* Ow = O + (size_t)(P0 + wid * QBLK) * RS + h * 128;
#pragma unroll
        for (int r = 0; r < 16; ++r) { const int row = crow(r, hi_e); const float l0 = li_l[row], m0 = mi_l[row];
            const size_t slot0 = (size_t)(h * 8192 + P0 + wid * QBLK + row) * 3; const float* pm = B.pml + slot0 * 2;
            const float m1 = pm[0], l1 = pm[1], m2 = pm[2], l2 = pm[3], m3 = pm[4], l3 = pm[5];
            const float M = fmaxf(fmaxf(m0, m1), fmaxf(m2, m3));
            const float e0 = __builtin_amdgcn_exp2f((m0 - M) * C2), e1 = l1 * __builtin_amdgcn_exp2f((m1 - M) * C2), e2 = l2 * __builtin_amdgcn_exp2f((m2 - M) * C2), e3 = l3 * __builtin_amdgcn_exp2f((m3 - M) * C2);
            const float rden = __builtin_amdgcn_rcpf(e0 * l0 + e1 + e2 + e3);
            typedef unsigned u32x2 __attribute__((ext_vector_type(2)));
            const u32x2* pb = (const u32x2*)(B.po + slot0 * 128) + r32;
            const u32x2 w1 = __builtin_nontemporal_load(pb), w2 = __builtin_nontemporal_load(pb + 32), w3 = __builtin_nontemporal_load(pb + 64);
            const float z1 = l1 > 0.f ? e1 : 0.f, z2 = l2 > 0.f ? e2 : 0.f, z3 = l3 > 0.f ? e3 : 0.f;
            const unsigned k1 = l1 > 0.f ? 0xffffffffu : 0u, k2 = l2 > 0.f ? 0xffffffffu : 0u, k3 = l3 > 0.f ? 0xffffffffu : 0u;
            float val[4];
#pragma unroll
            for (int d0 = 0; d0 < 4; ++d0) { float a = e0 * o[d0][r];
                const unsigned a1 = (d0 < 2 ? w1.x : w1.y) & k1, a2 = (d0 < 2 ? w2.x : w2.y) & k2, a3 = (d0 < 2 ? w3.x : w3.y) & k3;
                const float x1 = __uint_as_float((d0 & 1) ? (a1 & 0xffff0000u) : (a1 << 16)), x2 = __uint_as_float((d0 & 1) ? (a2 & 0xffff0000u) : (a2 << 16)), x3 = __uint_as_float((d0 & 1) ? (a3 & 0xffff0000u) : (a3 << 16));
                a = fmaf(z1, x1, a); a = fmaf(z2, x2, a); a = fmaf(z3, x3, a); val[d0] = a * rden; }
#pragma unroll
            for (int d0 = 0; d0 < 4; ++d0) o[d0][r] = val[d0]; }
        store_o_rows(o, lds + (wid < 4 ? OFF_V + SHM_V + wid * 4096 : OFF_K + SHM_K + (wid - 4) * 4096), Ow, RS, lane, r32, hi);
    }
}
#undef KSWZ
#undef KRSWZ
#undef SBAR
}
#define GAS __attribute__((address_space(1)))
#define LAS __attribute__((address_space(3)))
typedef unsigned short bf16;
typedef unsigned v4u __attribute__((ext_vector_type(4)));
typedef float f32x4 __attribute__((ext_vector_type(4)));
typedef short bf16x8 __attribute__((ext_vector_type(8)));
typedef GAS unsigned gu32;
typedef GAS unsigned long long gu64;
#define RLX_AGENT __ATOMIC_RELAXED, __HIP_MEMORY_SCOPE_AGENT
#define LDS_WAIT() asm volatile("s_waitcnt lgkmcnt(0)" ::: "memory")
#define VM_WAIT() asm volatile("s_waitcnt vmcnt(0)" ::: "memory")
__device__ __forceinline__ unsigned long long rt() { return __builtin_amdgcn_s_memrealtime(); }
__device__ __forceinline__ unsigned f2bf(float f) { unsigned u = __builtin_bit_cast(unsigned, f); return (u + 0x7fffu + ((u >> 16) & 1u)) >> 16; }
__device__ __forceinline__ unsigned pk2(float lo, float hi) { return f2bf(lo) | (f2bf(hi) << 16); }

#define XB_TMO      128
#define XB_XCNT(j)  (256  + 64 * (j))
#define XB_XSUB(j)  (1280 + 64 * (j))
#define XB_XGEN(j)  (2304 + 64 * (j))
#define XB_TOP      3328
#define XB_TOPGEN   3392
#define XCD_BAR_WORDS 3456
#define XB_SPIN_CAP (1u << 18)

__device__ __forceinline__ unsigned xb_ld(unsigned* p)              { return __hip_atomic_load(p, __ATOMIC_RELAXED, __HIP_MEMORY_SCOPE_AGENT); }
__device__ __forceinline__ unsigned xb_add(unsigned* p, unsigned v) { return __hip_atomic_fetch_add(p, v, __ATOMIC_RELAXED, __HIP_MEMORY_SCOPE_AGENT); }
__device__ __forceinline__ unsigned xb_xcc_id() { return (unsigned)__builtin_amdgcn_s_getreg((3 << 11) | 20) & 0xFu; }
#define XB_SPIN(cond, bar) do { unsigned _sp = 0; while (cond) { __builtin_amdgcn_s_sleep(1); \
    if ((++_sp & 255u) == 0u) { if (xb_ld(&(bar)[XB_TMO])) break; if (_sp > XB_SPIN_CAP) { atomicAdd(&(bar)[XB_TMO], 1u); break; } } } } while (0)

struct XcdBarrier {
    unsigned* bar; unsigned x;
    volatile LAS unsigned* st;
};

__device__ __forceinline__ XcdBarrier xcd_barrier_post(unsigned* bar, volatile LAS unsigned* st) {
    XcdBarrier b; b.bar = bar; b.x = xb_xcc_id(); b.st = st;
    if (threadIdx.x == 0) (void)xb_add(&bar[XB_XCNT(b.x)], 1u);
    return b;
}
__device__ __forceinline__ void xcd_barrier_complete(unsigned* bar, unsigned x, unsigned& nloc, unsigned& nx) {
    const unsigned G = gridDim.x * gridDim.y * gridDim.z;
    unsigned sum, cnt, mine, sp = 0u;
    for (;;) {
        sum = 0u; cnt = 0u; mine = 0u;
#pragma unroll
        for (unsigned j = 0; j < 16; ++j) { const unsigned c = xb_ld(&bar[XB_XCNT(j)]); sum += c; cnt += (c > 0u) ? 1u : 0u; mine = (j == x) ? c : mine; }
        if (sum == G) break;
        __builtin_amdgcn_s_sleep(1);
        if ((++sp & 255u) == 0u) { if (xb_ld(&bar[XB_TMO])) break; if (sp > XB_SPIN_CAP) { atomicAdd(&bar[XB_TMO], 1u); break; } }
    }
    nloc = mine > 0u ? mine : 1u; nx = cnt > 0u ? cnt : 1u;
}

__device__ __forceinline__ void xcd_barrier(const XcdBarrier& b) {
    asm volatile("s_waitcnt vmcnt(0)" ::: "memory");
    __syncthreads();
    if (threadIdx.x == 0) {
        unsigned* bar = b.bar;
        __builtin_amdgcn_s_waitcnt(0);
        unsigned nloc = b.st[0], nx = b.st[1];
        if (nloc == 0u) { xcd_barrier_complete(bar, b.x, nloc, nx); b.st[0] = nloc; b.st[1] = nx; }
        const unsigned old = xb_add(&bar[XB_XSUB(b.x)], 1u);
        const unsigned gen = old / nloc;
        if (old + 1u == (gen + 1u) * nloc) {
            __builtin_amdgcn_fence(__ATOMIC_RELEASE, "agent");
            asm volatile("s_waitcnt vmcnt(0)" ::: "memory");
            const unsigned og = xb_add(&bar[XB_TOP], 1u);
            const unsigned tg = og / nx;
            if (og + 1u == (tg + 1u) * nx) xb_add(&bar[XB_TOPGEN], 1u);
            else XB_SPIN(xb_ld(&bar[XB_TOPGEN]) == tg, bar);
            __builtin_amdgcn_fence(__ATOMIC_ACQUIRE, "agent");
            xb_add(&bar[XB_XGEN(b.x)], 1u);
            asm volatile("s_waitcnt vmcnt(0)" ::: "memory");
        } else {
            XB_SPIN(xb_ld(&bar[XB_XGEN(b.x)]) == gen, bar);
            __builtin_amdgcn_fence(__ATOMIC_ACQUIRE, "agent");
            asm volatile("s_waitcnt vmcnt(0)" ::: "memory");
        }
    }
    __syncthreads();
}
constexpr int NWAVES = 8;
#ifndef CONV_WAVES
#define CONV_WAVES 2
#endif
#ifndef FUSED_QUANT
#define FUSED_QUANT 1
#endif
#ifndef PROBE_REP
#define PROBE_REP 0
#endif
#define REPS(k) _Pragma("unroll 1") for (int rep_ = 0; rep_ < (PROBE_REP == (k) ? 2 : 1); ++rep_)
#ifndef MK_MULTI
#define MK_MULTI 0
#endif
#ifndef MOBA_GATHER
#define MOBA_GATHER 1
#endif
constexpr int SEQ = 8192, DM = 2048, FF = 5632, NPHASES = MOBA_GATHER ? 45 : 41;
constexpr size_t MiB = 1u << 20;
constexpr size_t WS_CTL = 0, WS_KMEAN = 1 * MiB, ZERO_BYTES = 2 * MiB;
constexpr size_t WS_SSQ = 2 * MiB, WS_SSQ_CQ = 3 * MiB, WS_SSQ_CKV = 4 * MiB, WS_COS = 5 * MiB, WS_SIN = 6 * MiB;
constexpr size_t WS_HB = 8 * MiB, WS_HID = 40 * MiB, WS_Q = 128 * MiB, WS_K = 160 * MiB, WS_V = 192 * MiB, WS_O = 224 * MiB, WS_QR = 256 * MiB, WS_KR = 272 * MiB, WS_CKV = 273 * MiB, WS_CQ = 281 * MiB;
constexpr size_t WS_FFN = 296 * MiB, FFN_SLOT = 69 * MiB, FFN_WD = 47 * MiB;
constexpr size_t WS_WQKV = 848 * MiB, WS_WO = 896 * MiB, WS_WUKV = 928 * MiB, WS_WDQ = 932 * MiB, WS_WUQ = 938 * MiB, WS_PO = 948 * MiB, WS_PML = 1044 * MiB, WS_LIST = 1048 * MiB, WS_END = 1056 * MiB;
constexpr size_t WS_AQ = 1056 * MiB, WS_ASC = 1072 * MiB, WS_AMX = 1073 * MiB, WS_END2 = 1074 * MiB;
static_assert((long)WS_AMX == pg8::EpiRes::QF_AMX && (long)WS_ASC == pg8::EpiRes::QF_ASC && (long)WS_AQ == pg8::EpiRes::QF_AQ && (long)WS_HB == pg8::EpiRes::QF_HB && (long)WS_SSQ == pg8::EpiRes::QF_SSQ && WS_CTL == 0, "fused quantisation offsets");
constexpr size_t WS_WAMAX = 256 * 1024;
constexpr size_t WS_MCNT = WS_KMEAN + 768 * 1024;
constexpr int CW_BAR = 4096, CW_CONV = 8192, CW_STRIP = 8256, CW_PCNT = 8448  ;
static_assert(CW_PCNT == pg8::EpiRes::QF_PCNT && CW_BAR + XB_TMO == pg8::EpiRes::QF_TMO && CW_PCNT + 32 * 16 <= 65536, "fused quantisation control words");
static_assert(WS_V - WS_K == WS_K - WS_Q, "q | k | v equally spaced");
constexpr int RING_OFF = 0, RING_BYTES = 131072, LDSCTL_OFF = RING_BYTES, MISC_OFF = LDSCTL_OFF + 320, RSTD_OFF = RING_BYTES + 1024, WTAB_OFF = RSTD_OFF + 8192, LDS_BYTES = 147456;
static_assert(att::LDS_BYTES <= RING_BYTES && MISC_OFF + 128 <= RSTD_OFF && WTAB_OFF + 6144 <= LDS_BYTES, "LDS map");

__device__ __forceinline__ float wave_sum(float v) {
#pragma unroll
    for (int o = 1; o < 64; o <<= 1) v += __shfl_xor(v, o);
    return v;
}
__device__ __forceinline__ int conv_src_col(int kind, int n0) {
    if (kind == 0) return n0;
    if (kind == 1) { const int pn = n0 >> 8, bj = (n0 >> 7) & 1, j = n0 & 127; return bj * FF + pn * 128 + j; }
    if (kind == 2) { if (n0 < 2048) { const int pn = n0 >> 8, hh = (n0 >> 7) & 1, j = n0 & 127; return (2 * pn + hh) * 192 + j; }
                     const int r = n0 - 2048, t = r >> 8, bj = (r >> 7) & 1, hh = (r >> 5) & 3; return (4 * t + hh) * 192 + 128 + 32 * bj; }
    if (n0 < 512) return n0; if (n0 == 512) return 512; if (n0 == 640) return 544; return -1;
}
__device__ __forceinline__ void conv_tile(const float* __restrict__ W, int K, int srcN, int N, const float* __restrict__ gain, bf16* __restrict__ WT, int kind, LAS unsigned char* wl, int lane, int it, const unsigned* __restrict__ wamax) {
    const int ngrp = N / 64, nkc = K / 128, c = lane & 15, q = lane >> 4;
    const int gs = (ngrp & 7) ? 4 : 8, g8 = it / gs, w8 = it - g8 * gs, b = g8 / nkc, kc = g8 - b * nkc, ng = ((b + kc) % (ngrp / gs)) * gs + w8;
    const int nd = ng * 64 + 4 * c, scg = conv_src_col(kind, nd & ~31);
    const bool valid = scg >= 0;
    const float* src = W + (size_t)(kc * 128 + 8 * q) * srcN + (valid ? scg + (nd & 31) : 0);
    f32x4 v[4][8], gv[4][2];
    if (gain) {
#pragma unroll
        for (int t = 0; t < 4; ++t) { gv[t][0] = *(const GAS f32x4*)(gain + kc * 128 + 8 * (q + 4 * t)); gv[t][1] = *(const GAS f32x4*)(gain + kc * 128 + 8 * (q + 4 * t) + 4); } }
#pragma unroll
    for (int t = 0; t < 4; ++t)
#pragma unroll
        for (int j = 0; j < 8; ++j) v[t][j] = __builtin_nontemporal_load((const GAS f32x4*)(src + (size_t)(32 * t + j) * srcN));
    if (kind == 3) { const float z = valid ? 1.f : 0.f;
#pragma unroll
        for (int t = 0; t < 4; ++t)
#pragma unroll
            for (int j = 0; j < 8; ++j) v[t][j] = v[t][j] * z; }
    if (gain) {
#pragma unroll
        for (int t = 0; t < 4; ++t) { const f32x4 g0 = gv[t][0], g1 = gv[t][1];
#pragma unroll
            for (int j = 0; j < 4; ++j) { v[t][j] = v[t][j] * g0[j]; v[t][4 + j] = v[t][4 + j] * g1[j]; } } }
    if (wamax) {
        const v4u ab = *(const v4u*)(wamax + nd); f32x4 sc;
#pragma unroll
        for (int i = 0; i < 4; ++i) { const float a = __uint_as_float(ab[i]); sc[i] = a > 0.f ? 127.0f / a : 0.f; }
#pragma unroll
        for (int t = 0; t < 4; ++t) { const int chunk = q + 4 * t;
#pragma unroll
            for (int i = 0; i < 4; ++i) { unsigned lo = 0u, hi2 = 0u;
#pragma unroll
                for (int j = 0; j < 4; ++j) { const int a0 = (int)__builtin_rintf(v[t][j][i] * sc[i]), a1 = (int)__builtin_rintf(v[t][4 + j][i] * sc[i]); lo |= ((unsigned)a0 & 0xffu) << (8 * j); hi2 |= ((unsigned)a1 & 0xffu) << (8 * j); }
                typedef unsigned u32x2 __attribute__((ext_vector_type(2)));
                *(LAS u32x2*)(wl + (4 * c + i) * 128 + 8 * (chunk ^ (2 * (c & 7)))) = (u32x2){lo, hi2}; } }
        LDS_WAIT(); asm volatile("" ::: "memory");
        unsigned char* dst = (unsigned char*)WT + (size_t)(ng * 64 + (lane >> 3)) * K + kc * 128 + 16 * (lane & 7); v4u ov[8];
#pragma unroll
        for (int st = 0; st < 8; ++st) { const int r = (lane >> 3) + 8 * st; ov[st] = *(const LAS v4u*)(wl + r * 128 + 8 * ((2 * (lane & 7)) ^ (2 * ((r >> 2) & 7)))); }
        LDS_WAIT(); asm volatile("" ::: "memory");
#pragma unroll
        for (int st = 0; st < 8; ++st) *(GAS v4u*)(dst + (size_t)(8 * st) * K) = ov[st];
        return;
    }
#pragma unroll
    for (int t = 0; t < 4; ++t) { const int chunk = q + 4 * t;
#pragma unroll
        for (int i = 0; i < 4; ++i) { v4u o; o.x = pg8::cvt_pk_bf16(v[t][0][i], v[t][1][i]); o.y = pg8::cvt_pk_bf16(v[t][2][i], v[t][3][i]); o.z = pg8::cvt_pk_bf16(v[t][4][i], v[t][5][i]); o.w = pg8::cvt_pk_bf16(v[t][6][i], v[t][7][i]);
            *(LAS v4u*)(wl + (4 * c + i) * 256 + 16 * (chunk ^ (c & 7))) = o; } }
    LDS_WAIT(); asm volatile("" ::: "memory");
    bf16* dst = WT + (size_t)(ng * 64 + q) * K + kc * 128 + 8 * c; v4u ov[16];
#pragma unroll
    for (int st = 0; st < 16; ++st) ov[st] = *(const LAS v4u*)(wl + (4 * st + q) * 256 + 16 * (c ^ (st & 7)));
    LDS_WAIT(); asm volatile("" ::: "memory");
#pragma unroll
    for (int st = 0; st < 16; ++st) *(GAS v4u*)(dst + (size_t)(4 * st) * K) = ov[st];
}
constexpr int IT_GU = 0, IT_D = 1408, IT_QKV = 0, IT_O = 512, IT_DKV = 0, IT_UKV = 256, IT_DQ = 192, IT_UQ = 288;
constexpr int IT_LA = 2 * IT_GU + 2 * IT_D + IT_QKV + IT_O;
constexpr int IT_L2 = 2 * IT_GU + 2 * IT_D + IT_DKV + IT_UKV + IT_DQ + IT_UQ + IT_O;
constexpr int IT_L3 = 2 * IT_GU + 2 * IT_D + IT_DQ + IT_UQ + IT_O;
constexpr int IT_B2 = 2 * IT_LA, IT_B3 = IT_B2 + IT_L2, IT_TOTAL = IT_B3 + IT_L3;
static_assert(IT_TOTAL == 40320 - 8 * 2816 - 192 - 2 * 1536, "conversion item count");
__device__ __forceinline__ int req_gu(int f) { const int l = f >> 1, w = f & 1; if (l < 2) return l * IT_LA + (w ? 2 * IT_GU + IT_D + IT_QKV + IT_O : IT_GU);
    if (l == 2) return IT_B2 + (w ? 2 * IT_GU + IT_DKV + IT_D + IT_UKV + IT_DQ + IT_UQ + IT_O : IT_GU + IT_DKV); return IT_B3 + (w ? 2 * IT_GU + IT_D + IT_DQ + IT_UQ + IT_O : IT_GU); }
__device__ __forceinline__ int req_d(int f) { return req_gu(f) + IT_D; }
__device__ __forceinline__ int req_qkv(int l) { return l * IT_LA + IT_GU + IT_D + IT_QKV; }
__device__ __forceinline__ int req_ukv() { return IT_B2 + IT_GU + IT_DKV + IT_D + IT_UKV; }
__device__ __forceinline__ int req_dq(int l) { return l == 2 ? req_ukv() + IT_DQ : IT_B3 + IT_GU + IT_D + IT_DQ; }
__device__ __forceinline__ int req_uq(int l) { return req_dq(l) + IT_UQ; }
__device__ __forceinline__ int req_o(int l) { return l < 2 ? req_qkv(l) + IT_O : req_uq(l) + IT_O; }

__device__ __forceinline__ void rstd_table_fill(LAS float* tab, const float* ssq, int fm, int tid, const float* rowfac = nullptr) {
#pragma unroll
    for (int j = 0; j < 4; ++j) { const int r = tid + 512 * j; float v = pg8::row_rstd<8>(ssq, fm * 256 + r, 1.0f / 2048.0f); if (rowfac) v *= rowfac[fm * 256 + r]; tab[r] = v; }
    __syncthreads();
}
__device__ __forceinline__ void quant_rows(const bf16* HB, signed char* AQ, float* asc, int gw, int NGW, int lane) {
    for (int m0 = gw * 4; m0 < SEQ; m0 += NGW * 4) {
        v4u w[4][4]; float mx[4];
#pragma unroll
        for (int r = 0; r < 4; ++r) { const GAS v4u* hr = (const GAS v4u*)(HB + (size_t)(m0 + r) * DM) + lane;
#pragma unroll
            for (int j = 0; j < 4; ++j) w[r][j] = hr[64 * j]; }
#pragma unroll
        for (int r = 0; r < 4; ++r) { float a = 0.f;
#pragma unroll
            for (int j = 0; j < 4; ++j)
#pragma unroll
                for (int e = 0; e < 4; ++e) { const unsigned u = w[r][j][e]; a = fmaxf(a, fmaxf(fabsf(__uint_as_float(u << 16)), fabsf(__uint_as_float(u & 0xffff0000u)))); }
            mx[r] = a; }
#pragma unroll
        for (int o = 1; o < 64; o <<= 1)
#pragma unroll
            for (int r = 0; r < 4; ++r) mx[r] = fmaxf(mx[r], __shfl_xor(mx[r], o));
#pragma unroll
        for (int r = 0; r < 4; ++r) { const float sc = mx[r] > 0.f ? 127.0f / mx[r] : 0.f;
            if (lane == 0) asc[m0 + r] = mx[r] * (1.0f / 127.0f);
            GAS unsigned long long* qo = (GAS unsigned long long*)(AQ + (size_t)(m0 + r) * DM) + lane;
#pragma unroll
            for (int j = 0; j < 4; ++j) { unsigned long long pk = 0ull;
#pragma unroll
                for (int e = 0; e < 4; ++e) { const unsigned u = w[r][j][e]; const int a0 = (int)__builtin_rintf(__uint_as_float(u << 16) * sc), a1 = (int)__builtin_rintf(__uint_as_float(u & 0xffff0000u) * sc);
                    pk |= (unsigned long long)(((unsigned)a0 & 0xffu) | (((unsigned)a1 & 0xffu) << 8)) << (16 * e); }
                qo[64 * j] = pk; } }
    }
}
__device__ __forceinline__ void wamax_job(const float* __restrict__ W, int srcN, int ncols, const float* __restrict__ gain, int kind, unsigned* __restrict__ amax, int gw, int NGW, int lane, int& rot) {
    const int ngrp = (ncols + 255) / 256, nitems = ngrp * (DM / 64);
    int w0 = gw - rot; if (w0 < 0) w0 += NGW; rot = (rot + nitems) % NGW;
    for (int it = w0; it < nitems; it += NGW) { const int kc = it / ngrp, ng = it - kc * ngrp, col = ng * 256 + 4 * lane;
        f32x4 mx = {0.f, 0.f, 0.f, 0.f};
        if (col >= ncols) continue;
#pragma unroll 8
        for (int j = 0; j < 64; ++j) { const f32x4 v = *(const GAS f32x4*)(W + (size_t)(kc * 64 + j) * srcN + col); const float g = gain[kc * 64 + j];
            mx[0] = fmaxf(mx[0], fabsf(v[0] * g)); mx[1] = fmaxf(mx[1], fabsf(v[1] * g)); mx[2] = fmaxf(mx[2], fabsf(v[2] * g)); mx[3] = fmaxf(mx[3], fabsf(v[3] * g)); }
#pragma unroll
        for (int e = 0; e < 4; ++e) { const int c = col + e; int n;
            if (kind == 1) { const int up = c >= FF, cc = up ? c - FF : c; n = (cc >> 7) * 256 + up * 128 + (cc & 127); } else { n = c < 512 ? c : 512 + ((c - 512) >> 5) * 128 + ((c - 512) & 31); }
            __hip_atomic_fetch_max(amax + n, __float_as_uint(mx[e]), __ATOMIC_RELAXED, __HIP_MEMORY_SCOPE_AGENT); } }
}
__device__ __forceinline__ void conv_strip(const float* __restrict__ W, int srcN, const float* __restrict__ gain, int kind, signed char* __restrict__ WQ, unsigned* __restrict__ wamax, int strip,
                                           LAS unsigned char* tile, LAS unsigned* mx, int tid) {
    const int c16 = tid & 15, kr = tid >> 4, nd = strip * 64 + 4 * c16, scg = conv_src_col(kind, nd & ~31);
    const bool valid = scg >= 0; const float z = valid ? 1.f : 0.f;
    const float* src = W + (size_t)(8 * kr) * srcN + (valid ? scg + (nd & 31) : 0);
    if (tid < 64) mx[tid] = 0u;
    __syncthreads();
    unsigned pk[8][4][4]; f32x4 mxl = {0.f, 0.f, 0.f, 0.f};
#pragma unroll
    for (int t = 0; t < 8; ++t) { f32x4 v[8];
        const f32x4 g0 = *(const GAS f32x4*)(gain + 8 * (kr + 32 * t)), g1 = *(const GAS f32x4*)(gain + 8 * (kr + 32 * t) + 4);
#pragma unroll
        for (int j = 0; j < 8; ++j) v[j] = __builtin_nontemporal_load((const GAS f32x4*)(src + (size_t)(256 * t + j) * srcN));
#pragma unroll
        for (int j = 0; j < 8; ++j) { const float gf = (j < 4 ? g0[j & 3] : g1[j & 3]) * z;
#pragma unroll
            for (int i = 0; i < 4; ++i) { v[j][i] = pg8::smul(v[j][i], gf); mxl[i] = fmaxf(mxl[i], fabsf(v[j][i])); } }
#pragma unroll
        for (int jp = 0; jp < 4; ++jp)
#pragma unroll
            for (int i = 0; i < 4; ++i) pk[t][jp][i] = pg8::cvt_pk_bf16(v[2 * jp][i], v[2 * jp + 1][i]); }
#pragma unroll
    for (int i = 0; i < 4; ++i) __hip_atomic_fetch_max(mx + 4 * c16 + i, __float_as_uint(mxl[i]), __ATOMIC_RELAXED, __HIP_MEMORY_SCOPE_WORKGROUP);
    __syncthreads();
    f32x4 sc;
#pragma unroll
    for (int i = 0; i < 4; ++i) { const float a = __uint_as_float(mx[4 * c16 + i]); sc[i] = a > 0.f ? 127.0f / a : 0.f; }
    if (tid < 64) wamax[strip * 64 + tid] = mx[tid];
#pragma unroll
    for (int t = 0; t < 8; ++t)
#pragma unroll
        for (int i = 0; i < 4; ++i) { unsigned tw[4];
#pragma unroll
            for (int jp = 0; jp < 4; ++jp) { const unsigned u = pk[t][jp][i]; const float f0 = __uint_as_float(u << 16), f1 = __uint_as_float(u & 0xffff0000u), magic = 12582912.0f; unsigned b0, b1;
                asm("v_fma_f32 %0, %1, %2, %3" : "=v"(b0) : "v"(f0), "v"(sc[i]), "v"(magic)); asm("v_fma_f32 %0, %1, %2, %3" : "=v"(b1) : "v"(f1), "v"(sc[i]), "v"(magic));
                tw[jp] = __builtin_amdgcn_perm(b1, b0, 0x0c0c0400u); }
            const unsigned lo = __builtin_amdgcn_perm(tw[1], tw[0], 0x05040100u), hi2 = __builtin_amdgcn_perm(tw[3], tw[2], 0x05040100u);
            typedef unsigned u32x2 __attribute__((ext_vector_type(2)));
            *(LAS u32x2*)(tile + (4 * c16 + i) * 2048 + 8 * ((kr + 32 * t) ^ (2 * c16))) = (u32x2){lo, hi2}; }
    __syncthreads();
#pragma unroll 4
    for (int it = 0; it < 16; ++it) { const int id = it * 512 + tid, row = id >> 7, g = id & 127;
        const v4u o = *(const LAS v4u*)(tile + row * 2048 + 8 * ((2 * g) ^ (2 * ((row >> 2) & 15))));
        *(GAS v4u*)(WQ + (size_t)(strip * 64 + row) * 2048 + 16 * g) = o; }
    __syncthreads();
}
constexpr int ST_GU = 176, ST_DKV = 12, ST_QKV = 96, ST_TOTAL = 8 * ST_GU + ST_DKV + 2 * ST_QKV;
constexpr int SB_GU0 = 0, SB_QKV0 = SB_GU0 + ST_GU, SB_GU1 = SB_QKV0 + ST_QKV, SB_GU2 = SB_GU1 + ST_GU, SB_QKV1 = SB_GU2 + ST_GU, SB_GU3 = SB_QKV1 + ST_QKV, SB_GU4 = SB_GU3 + ST_GU, SB_DKV = SB_GU4 + ST_GU,
              SB_GU5 = SB_DKV + ST_DKV, SB_GU6 = SB_GU5 + ST_GU, SB_GU7 = SB_GU6 + ST_GU;
static_assert(SB_GU7 + ST_GU == ST_TOTAL, "strip list");
__device__ __forceinline__ int req_strip_after_up(int f) { return f == 0 ? SB_GU2 : f == 1 ? SB_QKV1 : f == 2 ? SB_GU4 : f == 3 ? SB_GU5 : f == 4 ? SB_GU6 : f == 5 ? SB_GU7 : ST_TOTAL; }
constexpr int WAMAX_QKV = 8 * 12032;
struct Args { const float* in[19]; float* out; unsigned char* ws; int ph_lo, ph_hi; };
#define WGU(f) ((bf16*)(ws + WS_FFN + (size_t)(f) * FFN_SLOT))
#define WD(f) ((bf16*)(ws + WS_FFN + (size_t)(f) * FFN_SLOT + FFN_WD))
#define WQKV(l) ((bf16*)(ws + WS_WQKV + (size_t)(l) * 24 * MiB))
#define WO(l) ((bf16*)(ws + WS_WO + (size_t)(l) * 8 * MiB))
#define WUKV ((bf16*)(ws + WS_WUKV))
#define WDQ(j) ((bf16*)(ws + WS_WDQ + (size_t)(j) * 3 * MiB))
#define WUQ(j) ((bf16*)(ws + WS_WUQ + (size_t)(j) * 5 * MiB))
__device__ __forceinline__ void conv_item(const Args& args, unsigned char* ws, LAS unsigned char* wl, int lane, int idx) {
    int i = idx, K, sN, N, kind = 0; const float* src; const float* gain = nullptr; bf16* dst; const unsigned* wam = nullptr;
#define SET_GU(f_) do { const int l_ = (f_) >> 1, w_ = (f_) & 1; src = (w_ ? args.in[6] : args.in[2]) + (size_t)l_ * DM * 2 * FF; gain = (w_ ? args.in[5] : args.in[1]) + l_ * DM; dst = WGU(f_); K = DM; sN = 2 * FF; N = 2 * FF; kind = 1; wam = (const unsigned*)(ws + WS_WAMAX) + (f_) * 12032; } while (0)
#define SET_D(f_) do { const int l_ = (f_) >> 1, w_ = (f_) & 1; src = (w_ ? args.in[7] : args.in[3]) + (size_t)l_ * FF * DM; dst = WD(f_); K = FF; sN = DM; N = DM; } while (0)
#define SET_QKV(l_) do { src = args.in[8] + (size_t)(l_) * DM * 6144; gain = args.in[4] + (l_) * DM; dst = WQKV(l_); K = DM; sN = 6144; N = 6144; } while (0)
#define SET_O(l_) do { src = (l_) < 2 ? args.in[9] + (size_t)(l_) * DM * DM : args.in[17] + (size_t)((l_) - 2) * DM * DM; dst = WO(l_); K = DM; sN = DM; N = DM; } while (0)
#define SET_DKV() do { src = args.in[11]; gain = args.in[10]; dst = (bf16*)((unsigned char*)WGU(4) + (size_t)2 * FF * DM); K = DM; sN = 576; N = 768; kind = 3; wam = (const unsigned*)(ws + WS_WAMAX) + 4 * 12032 + 2 * FF; } while (0)
#define SET_UKV() do { src = args.in[13]; gain = args.in[12]; dst = WUKV; K = 512; sN = 4096; N = 4096; } while (0)
#define SET_DQ(j_) do { src = args.in[14] + (size_t)(j_) * DM * 768; gain = args.in[4] + (2 + (j_)) * DM; dst = WDQ(j_); K = DM; sN = 768; N = 768; } while (0)
#define SET_UQ(j_) do { src = args.in[16] + (size_t)(j_) * 768 * 3072; gain = args.in[15] + (j_) * 768; dst = WUQ(j_); K = 768; sN = 3072; N = 3072; kind = 2; } while (0)
    if (i < IT_B2) { const int l = i >= IT_LA ? 1 : 0; i -= l * IT_LA;
        if (i < IT_GU) SET_GU(2 * l); else if ((i -= IT_GU) < IT_D) SET_D(2 * l); else if ((i -= IT_D) < IT_QKV) SET_QKV(l); else if ((i -= IT_QKV) < IT_O) SET_O(l);
        else if ((i -= IT_O) < IT_GU) SET_GU(2 * l + 1); else { i -= IT_GU; SET_D(2 * l + 1); } }
    else if (i < IT_B3) { i -= IT_B2;
        if (i < IT_GU) SET_GU(4); else if ((i -= IT_GU) < IT_DKV) SET_DKV(); else if ((i -= IT_DKV) < IT_D) SET_D(4); else if ((i -= IT_D) < IT_UKV) SET_UKV(); else if ((i -= IT_UKV) < IT_DQ) SET_DQ(0);
        else if ((i -= IT_DQ) < IT_UQ) SET_UQ(0); else if ((i -= IT_UQ) < IT_O) SET_O(2); else if ((i -= IT_O) < IT_GU) SET_GU(5); else { i -= IT_GU; SET_D(5); } }
    else { i -= IT_B3;
        if (i < IT_GU) SET_GU(6); else if ((i -= IT_GU) < IT_D) SET_D(6); else if ((i -= IT_D) < IT_DQ) SET_DQ(1); else if ((i -= IT_DQ) < IT_UQ) SET_UQ(1); else if ((i -= IT_UQ) < IT_O) SET_O(3);
        else if ((i -= IT_O) < IT_GU) SET_GU(7); else { i -= IT_GU; SET_D(7); } }
#undef SET_GU
#undef SET_D
#undef SET_QKV
#undef SET_O
#undef SET_DKV
#undef SET_UKV
#undef SET_DQ
#undef SET_UQ
    conv_tile(src, K, sN, N, gain, dst, kind, wl, lane, i, wam);
}
__global__ void __launch_bounds__(NWAVES * 64, 2) yoco_fwd(Args args) {
    extern __shared__ __attribute__((aligned(16))) unsigned char lds[];
    LAS unsigned char* ldsl = (LAS unsigned char*)lds;
    const int tid = threadIdx.x, lane = tid & 63, wave = __builtin_amdgcn_readfirstlane(tid >> 6), G = gridDim.x;
    unsigned char* ws = args.ws;
    gu32* ctl = (gu32*)(ws + WS_CTL);
    for (int u = tid; u < (LDS_BYTES - LDSCTL_OFF) / 4; u += NWAVES * 64) ((LAS unsigned*)(ldsl + LDSCTL_OFF))[u] = 0u;
    __syncthreads();
    XcdBarrier bar = xcd_barrier_post((unsigned*)(ctl + CW_BAR), (volatile LAS unsigned*)(ldsl + MISC_OFF) + 8);
    const int lo = args.ph_lo, hi = args.ph_hi; int seq = 0;
#define PH_RUN (seq >= lo && seq < hi)
#define PH_END do { if (seq >= lo && seq + 1 < hi) { xcd_barrier(bar); if (PROBE_REP == 8) xcd_barrier(bar); } ++seq; } while (0)
#define STRIP_DRAIN(R_, SOFT_) do { const int RS__ = (R_), RSOFT__ = (SOFT_); gu32* sc_ = ctl + CW_STRIP; volatile LAS int* sidx_ = (volatile LAS int*)(ldsl + RSTD_OFF + 512); int tq_ = threadIdx.x; asm volatile("" : "+v"(tq_)); \
        for (int nth_ = 0;; ++nth_) { const int lim_ = nth_ == 0 ? RSOFT__ : RS__;     \
            if (tq_ == 0) { int v_ = 1 << 30; if ((int)__hip_atomic_load(sc_, RLX_AGENT) < lim_) v_ = (int)__hip_atomic_fetch_add(sc_, 1u, RLX_AGENT); *sidx_ = v_; } __syncthreads(); const int si_ = *sidx_; __syncthreads(); \
            if (si_ < ST_TOTAL) { unsigned* wab_ = (unsigned*)(ws + WS_WAMAX); LAS unsigned char* tl2_ = ldsl + RING_OFF; LAS unsigned* mx_ = (LAS unsigned*)(ldsl + RSTD_OFF); \
                if ((si_ >= SB_QKV0 && si_ < SB_GU1) || (si_ >= SB_QKV1 && si_ < SB_GU3)) { const int l_ = si_ >= SB_QKV1 ? 1 : 0, ls_ = si_ - (l_ ? SB_QKV1 : SB_QKV0); \
                    conv_strip(args.in[8] + (size_t)l_ * DM * 6144, 6144, args.in[4] + l_ * DM, 0, (signed char*)WQKV(l_), wab_ + WAMAX_QKV + l_ * 6144, ls_, tl2_, mx_, tq_); } \
                else if (si_ >= SB_DKV && si_ < SB_GU5) { conv_strip(args.in[11], 576, args.in[10], 3, (signed char*)WGU(4) + (size_t)2 * FF * DM, wab_ + 4 * 12032 + 2 * FF, si_ - SB_DKV, tl2_, mx_, tq_); } \
                else { const int f_ = si_ < SB_QKV0 ? 0 : si_ < SB_GU2 ? 1 : si_ < SB_QKV1 ? 2 : si_ < SB_GU4 ? 3 : si_ < SB_DKV ? 4 : si_ < SB_GU6 ? 5 : si_ < SB_GU7 ? 6 : 7; \
                    const int base_ = f_ == 0 ? SB_GU0 : f_ == 1 ? SB_GU1 : f_ == 2 ? SB_GU2 : f_ == 3 ? SB_GU3 : f_ == 4 ? SB_GU4 : f_ == 5 ? SB_GU5 : f_ == 6 ? SB_GU6 : SB_GU7, l_ = f_ >> 1, w_ = f_ & 1; \
                    conv_strip((w_ ? args.in[6] : args.in[2]) + (size_t)l_ * DM * 2 * FF, 2 * FF, (w_ ? args.in[5] : args.in[1]) + l_ * DM, 1, (signed char*)WGU(f_), wab_ + f_ * 12032, si_ - base_, tl2_, mx_, tq_); } } \
            if (si_ + 1 >= RS__) break; } } while (0)
#define CONV_DRAIN(R_) CONV_DRAIN_W(R_, CONV_WAVES)
#define CONV_DRAIN_W(R_, NW_) do { const int R__ = (R_); gu32* cc_ = ctl + CW_CONV; LAS unsigned char* wl_ = ldsl + RING_OFF + wave * 16384; int tl_ = threadIdx.x; asm volatile("" : "+v"(tl_)); const int ln_ = tl_ & 63; \
        if (wave < (NW_) && (int)__builtin_amdgcn_readfirstlane(__hip_atomic_load(cc_, RLX_AGENT)) < R__) { for (;;) { int idx_ = 0; if (ln_ == 0) idx_ = (int)__hip_atomic_fetch_add(cc_, 1u, RLX_AGENT); idx_ = __builtin_amdgcn_readfirstlane(idx_); \
            if (idx_ < IT_TOTAL) conv_item(args, ws, wl_, ln_, idx_); if (idx_ + 1 >= R__) break; } } } while (0)
    const float* x = args.in[0]; float* out = args.out;
    float* kmean = (float*)(ws + WS_KMEAN); float* ssq = (float*)(ws + WS_SSQ); float* ssq_cq = (float*)(ws + WS_SSQ_CQ); float* ssq_ckv = (float*)(ws + WS_SSQ_CKV);
    float* cos_t = (float*)(ws + WS_COS); float* sin_t = (float*)(ws + WS_SIN);
    bf16* HB = (bf16*)(ws + WS_HB); bf16* HID = (bf16*)(ws + WS_HID); bf16* QB_ = (bf16*)(ws + WS_Q); bf16* KB_ = (bf16*)(ws + WS_K); bf16* VB_ = (bf16*)(ws + WS_V); bf16* OB = (bf16*)(ws + WS_O);
    bf16* QR = (bf16*)(ws + WS_QR); bf16* KR = (bf16*)(ws + WS_KR); bf16* CKV = (bf16*)(ws + WS_CKV); bf16* CQ = (bf16*)(ws + WS_CQ);
    const int gw = (int)blockIdx.x * NWAVES + wave, NGW = G * NWAVES;

    if (PH_RUN) REPS(1) {
        STRIP_DRAIN(SB_QKV0, req_strip_after_up(0));
        for (int m = gw; m < SEQ; m += NGW) {
            const GAS f32x4* xr = (const GAS f32x4*)(x + (size_t)m * DM) + lane; GAS unsigned long long* o8 = (GAS unsigned long long*)(HB + (size_t)m * DM) + lane; float s = 0.f, mxa = 0.f; unsigned long long hb[8];
#pragma unroll
            for (int j = 0; j < 8; ++j) { const f32x4 v = __builtin_nontemporal_load(xr + 64 * j); s += (v.x * v.x + v.y * v.y) + (v.z * v.z + v.w * v.w); const unsigned p0_ = pk2(v.x, v.y), p1_ = pk2(v.z, v.w); hb[j] = (unsigned long long)p0_ | ((unsigned long long)p1_ << 32); o8[64 * j] = hb[j];
                mxa = fmaxf(fmaxf(mxa, fmaxf(fabsf(__uint_as_float(p0_ << 16)), fabsf(__uint_as_float(p0_ & 0xffff0000u)))), fmaxf(fabsf(__uint_as_float(p1_ << 16)), fabsf(__uint_as_float(p1_ & 0xffff0000u)))); }
            s = wave_sum(s); if (lane < 32) ssq[(size_t)m * 32 + lane] = lane == 0 ? s : 0.f;
#pragma unroll
            for (int o = 1; o < 64; o <<= 1) mxa = fmaxf(mxa, __shfl_xor(mxa, o));
            const float qs = mxa > 0.f ? 127.0f / mxa : 0.f; if (lane == 0) ((float*)(ws + WS_ASC))[m] = mxa * (1.0f / 127.0f);
            GAS unsigned* q4 = (GAS unsigned*)((signed char*)(ws + WS_AQ) + (size_t)m * DM) + lane;
#pragma unroll
            for (int j = 0; j < 8; ++j) { const unsigned p0_ = (unsigned)hb[j], p1_ = (unsigned)(hb[j] >> 32);
                const int a0 = (int)__builtin_rintf(__uint_as_float(p0_ << 16) * qs), a1 = (int)__builtin_rintf(__uint_as_float(p0_ & 0xffff0000u) * qs), a2 = (int)__builtin_rintf(__uint_as_float(p1_ << 16) * qs), a3 = (int)__builtin_rintf(__uint_as_float(p1_ & 0xffff0000u) * qs);
                q4[64 * j] = ((unsigned)a0 & 0xffu) | (((unsigned)a1 & 0xffu) << 8) | (((unsigned)a2 & 0xffu) << 16) | (((unsigned)a3 & 0xffu) << 24); } }
        for (int idx = (int)blockIdx.x * 512 + tid; idx < SEQ * 32; idx += G * 512) {
            const int pos = idx >> 5, i = idx & 31;
            const float pw = (float)exp2((double)(2 * i) * (13.287712379549449 / 64.0)), inv = 1.0f / pw, ang = (float)pos * inv;
            const double a = (double)ang, q = rint(a * 0.6366197723675814), r = (a - q * 1.5707963267948966) - q * 6.123233995736766e-17, r2 = r * r;
            const double sn = r + r * r2 * (-1.0 / 6 + r2 * (1.0 / 120 + r2 * (-1.0 / 5040 + r2 * (1.0 / 362880 + r2 * (-1.0 / 39916800)))));
            const double cs = 1.0 + r2 * (-0.5 + r2 * (1.0 / 24 + r2 * (-1.0 / 720 + r2 * (1.0 / 40320 + r2 * (-1.0 / 3628800 + r2 * (1.0 / 479001600))))));
            const int qi = (int)q & 3; const double c_ = qi == 0 ? cs : qi == 1 ? -sn : qi == 2 ? -cs : sn, s_ = qi == 0 ? sn : qi == 1 ? cs : qi == 2 ? -sn : -cs;
            cos_t[idx] = (float)c_; sin_t[idx] = (float)s_; }
    }
    PH_END;
    signed char* AQ = (signed char*)(ws + WS_AQ); float* asc = (float*)(ws + WS_ASC);
    const bool fuseq = FUSED_QUANT && G == 256; unsigned qk = 0u;

    for (int f = 0; f < 8; ++f) {
        const int l = f >> 1;
        if (f > 0 && !fuseq) { if (PH_RUN) { int t4 = threadIdx.x; asm volatile("" : "+v"(t4)); quant_rows(HB, AQ, asc, gw, NGW, t4 & 63); } PH_END; }
        if (PH_RUN) REPS(4) {
            pg8::Gemm g{(const pg8::bf16_t*)AQ, (const pg8::bf16_t*)WGU(f), SEQ, f == 4 ? 2 * FF + 768 : 2 * FF, DM / 2}; pg8::StaticOrder S; S.init(SEQ, g.N, G, (int)blockIdx.x);
            LAS float* rtab = (LAS float*)(ldsl + RSTD_OFF); LAS float* wtab = (LAS float*)(ldsl + WTAB_OFF); int pn0 = 0;
            { pg8::Unit u0; if (S.next(0, u0)) { int t3 = threadIdx.x; asm volatile("" : "+v"(t3)); pn0 = u0.pn; const unsigned* wam_ = (const unsigned*)(ws + WS_WAMAX) + f * 12032;
#pragma unroll
                  for (int ui_ = 0; ui_ < 6; ++ui_) { pg8::Unit uu; if (S.next(ui_, uu) && t3 < 256) wtab[((uu.pn - pn0) >> 2) * 256 + t3] = __uint_as_float(wam_[uu.pn * 256 + t3]) * (1.0f / 127.0f); }
                  rstd_table_fill(rtab, ssq, u0.pm & ~7, t3, asc); } }
            pg8::EpiUp E{(pg8::bf16_t*)HID, rtab, 44, (pg8::bf16_t*)CKV, ssq_ckv, (pg8::bf16_t*)KR, cos_t, sin_t, wtab, pn0};
            pg8::gemm_phase<pg8::EpiUp, pg8::StaticOrder, true, true>(ldsl + RING_OFF, g, S, E);
#if PROBE_REP == 6
            { pg8::EpiNull E0; pg8::gemm_phase<pg8::EpiNull, pg8::StaticOrder, true, true>(ldsl + RING_OFF, g, S, E0); }
#endif
            __syncthreads(); if (f < 7) STRIP_DRAIN(req_strip_after_up(f), req_strip_after_up(f + 1 < 7 ? f + 1 : 6)); CONV_DRAIN(f < 7 ? req_gu(f + 1) : IT_TOTAL);
        }
        PH_END;
        if (PH_RUN) {
            pg8::Gemm g{(const pg8::bf16_t*)HID, (const pg8::bf16_t*)WD(f), SEQ, DM, FF}; pg8::StaticOrder S; S.init(SEQ, DM, G, (int)blockIdx.x);
            const bool fq_here = fuseq && ((f & 1) ? f < 7 : l < 2);
            if (fuseq && f == 7) { pg8::EpiResT<1, true> E{ws, (LAS float*)(ldsl + RSTD_OFF), args.out, args.in[18], 8u * (qk + 1u)};
                pg8::gemm_phase<pg8::EpiResT<1, true>, pg8::StaticOrder, true, true>(ldsl + RING_OFF, g, S, E); }
            else { pg8::EpiResT<1> E{ws, (LAS float*)(ldsl + RSTD_OFF), nullptr, nullptr, fq_here ? 8u * (qk + 1u) : 0u};
            pg8::gemm_phase<pg8::EpiResT<1>, pg8::StaticOrder, true, true>(ldsl + RING_OFF, g, S, E); }
        }
        PH_END;
        if (fuseq && ((f & 1) ? true : l < 2)) ++qk;
        if (f & 1) continue;
        if (l < 2) {
            if (!fuseq) { if (PH_RUN) { int t4 = threadIdx.x; asm volatile("" : "+v"(t4)); quant_rows(HB, AQ, asc, gw, NGW, t4 & 63); }
            PH_END; }
            if (PH_RUN) {
                pg8::Gemm g{(const pg8::bf16_t*)AQ, (const pg8::bf16_t*)WQKV(l), SEQ, 6144, DM / 2}; pg8::StaticOrder S; S.init(SEQ, 6144, G, (int)blockIdx.x);
                LAS float* rtab = (LAS float*)(ldsl + RSTD_OFF); LAS float* wtab = (LAS float*)(ldsl + WTAB_OFF); int pn0 = 0;
                { pg8::Unit u0; if (S.next(0, u0)) { int t3 = threadIdx.x; asm volatile("" : "+v"(t3)); pn0 = u0.pn; const unsigned* wam_ = (const unsigned*)(ws + WS_WAMAX) + WAMAX_QKV + l * 6144;
                      for (int ui_ = 0; ui_ < 3; ++ui_) { pg8::Unit uu; if (S.next(ui_, uu) && t3 < 256) wtab[((uu.pn - pn0) >> 2) * 256 + t3] = __uint_as_float(wam_[uu.pn * 256 + t3]) * (1.0f / 127.0f); }
                      rstd_table_fill(rtab, ssq, u0.pm & ~7, t3, asc); } }
                pg8::EpiQKV E{(pg8::bf16_t*)QB_, (size_t)(WS_K - WS_Q) / 2, rtab, kmean + (size_t)l * 32 * DM, wtab, pn0};
                pg8::gemm_phase<pg8::EpiQKV, pg8::StaticOrder, true, true>(ldsl + RING_OFF, g, S, E);
            }
            PH_END;
#if MOBA_GATHER
            const att::MobaBufs MB{(unsigned*)(ws + WS_MCNT) + l * 512, (unsigned short*)(ws + WS_LIST), (att::bf16*)(ws + WS_PO), (float*)(ws + WS_PML)};
            if (PH_RUN) att::moba_gate_phase((char*)lds + RING_OFF, (const att::bf16*)QB_, kmean + (size_t)l * 32 * DM, MB);
            PH_END;
            if (PH_RUN) REPS(10) att::moba_sel_phase((char*)lds + RING_OFF, (const att::bf16*)QB_, (const att::bf16*)KB_, (const att::bf16*)VB_, MB);
            PH_END;
            if (PH_RUN) REPS(11) att::moba_own_phase((char*)lds + RING_OFF, (const att::bf16*)QB_, (const att::bf16*)KB_, (const att::bf16*)VB_, (att::bf16*)OB, MB);
            PH_END;
#else
            if (PH_RUN) REPS(2) { const att::Shared GS{(const att::bf16*)KR, kmean + (size_t)l * 32 * DM};
                att::attn_phase<0>((char*)lds + RING_OFF, (const att::bf16*)QB_, (const att::bf16*)QR, (const att::bf16*)KB_, (const att::bf16*)VB_, (att::bf16*)OB, GS); }
            PH_END;
#endif
        } else {
            if (PH_RUN) {
                if (l == 2 && (int)blockIdx.x >= 96 && G == 256) {
                    pg8::Gemm g{(const pg8::bf16_t*)CKV, (const pg8::bf16_t*)WUKV, SEQ, 4096, 512}; pg8::StaticOrder S; S.init(SEQ, 4096, 160, (int)blockIdx.x - 96);
                    pg8::EpiUKV E{(pg8::bf16_t*)KB_, (pg8::bf16_t*)VB_, ssq_ckv};
                    pg8::gemm_phase<pg8::EpiUKV, pg8::StaticOrder, true, true>(ldsl + RING_OFF, g, S, E);
                } else {
                    pg8::Gemm g{(const pg8::bf16_t*)HB, (const pg8::bf16_t*)WDQ(l - 2), SEQ, 768, DM}; pg8::StaticOrder S; S.init(SEQ, 768, G, (int)blockIdx.x);
                    LAS float* rtab = (LAS float*)(ldsl + RSTD_OFF); { pg8::Unit u0; if (S.next(0, u0)) { int t3 = threadIdx.x; asm volatile("" : "+v"(t3)); rstd_table_fill(rtab, ssq, u0.pm & ~7, t3); } }
                    pg8::EpiScaled E{(pg8::bf16_t*)CQ, 768, rtab, ssq_cq};
                    pg8::gemm_phase<pg8::EpiScaled, pg8::StaticOrder, true, true>(ldsl + RING_OFF, g, S, E);
                    { pg8::Unit u1; if (!S.next(0, u1) && l == 3) { __syncthreads(); CONV_DRAIN_W(IT_TOTAL, 2); } }
                    if (l == 2 && G != 256) {
                        pg8::Gemm g2{(const pg8::bf16_t*)CKV, (const pg8::bf16_t*)WUKV, SEQ, 4096, 512}; pg8::StaticOrder S2; S2.init(SEQ, 4096, G, (int)blockIdx.x);
                        pg8::EpiUKV E2{(pg8::bf16_t*)KB_, (pg8::bf16_t*)VB_, ssq_ckv};
                        pg8::gemm_phase<pg8::EpiUKV, pg8::StaticOrder, true, true>(ldsl + RING_OFF, g2, S2, E2); }
                }
            }
            PH_END;
            if (PH_RUN) {
                pg8::Gemm g{(const pg8::bf16_t*)CQ, (const pg8::bf16_t*)WUQ(l - 2), SEQ, 3072, 768}; pg8::StaticOrder S; S.init(SEQ, 3072, G, (int)blockIdx.x);
                pg8::EpiUQ E{(pg8::bf16_t*)QB_, (pg8::bf16_t*)QR, ssq_cq, cos_t, sin_t};
                pg8::gemm_phase<pg8::EpiUQ, pg8::StaticOrder, true, true>(ldsl + RING_OFF, g, S, E);
            }
            PH_END;
            if (PH_RUN) REPS(3) { const att::Shared GS{(const att::bf16*)KR, kmean};
                att::attn_phase<1>((char*)lds + RING_OFF, (const att::bf16*)QB_, (const att::bf16*)QR, (const att::bf16*)KB_, (const att::bf16*)VB_, (att::bf16*)OB, GS); }
            PH_END;
        }
        if (PH_RUN) {
            pg8::Gemm g{(const pg8::bf16_t*)OB, (const pg8::bf16_t*)WO(l), SEQ, DM, DM}; pg8::StaticOrder S; S.init(SEQ, DM, G, (int)blockIdx.x);
            pg8::EpiResT<0> E{ws, (LAS float*)(ldsl + RSTD_OFF), nullptr, nullptr, fuseq ? 8u * (qk + 1u) : 0u};
            pg8::gemm_phase<pg8::EpiResT<0>, pg8::StaticOrder, true, true>(ldsl + RING_OFF, g, S, E);
        }
        PH_END;
        if (fuseq) ++qk;
    }
    if (PH_RUN) {
        const bool bad = xb_ld((unsigned*)(ctl + CW_BAR) + XB_TMO) != 0u; const float poison = bad ? __builtin_nanf("") : 1.0f;
        int t2 = threadIdx.x; asm volatile("" : "+v"(t2)); const int ln = t2 & 63;
        const GAS f32x4* fn = (const GAS f32x4*)args.in[18] + ln;
        int gw2 = gw; asm volatile("" : "+s"(gw2));
        for (int m = gw2; m < SEQ; m += NGW) { const float rs = pg8::row_rstd<8>(ssq, m, 1.0f / 2048.0f) * poison; GAS f32x4* o = (GAS f32x4*)(out + (size_t)m * DM) + ln;
            const GAS unsigned long long* hb8 = (const GAS unsigned long long*)(HB + (size_t)m * DM) + ln;
#pragma unroll
            for (int j = 0; j < 8; ++j) { const unsigned long long hv = hb8[64 * j]; const unsigned lo = (unsigned)hv, hi2 = (unsigned)(hv >> 32); const f32x4 gn = fn[64 * j];
                const f32x4 v = {__uint_as_float(lo << 16), __uint_as_float(lo & 0xffff0000u), __uint_as_float(hi2 << 16), __uint_as_float(hi2 & 0xffff0000u)}; __builtin_nontemporal_store(v * rs * gn, o + 64 * j); } }
    }
#undef PH_RUN
#undef PH_END
}

extern "C" void kernel_launch(void* const* d_in, const int* in_sizes, int n_in, void* d_out, int out_size, void* d_ws, size_t ws_size, hipStream_t stream) {
    static int grid = 0;
    if (grid == 0) {
        if (n_in != 19 || in_sizes[0] != SEQ * DM || out_size != SEQ * DM || ws_size < WS_END2) { fprintf(stderr, "kernel_launch: unexpected shapes (n_in %d, in0 %d, out %d, ws %zu)\n", n_in, n_in > 0 ? in_sizes[0] : -1, out_size, ws_size); grid = -1; return; }
        int dev = 0, cus = 0, per_cu = 0;
        if (hipGetDevice(&dev) != hipSuccess || hipDeviceGetAttribute(&cus, hipDeviceAttributeMultiprocessorCount, dev) != hipSuccess) { grid = -1; return; }
        if (hipFuncSetAttribute((const void*)yoco_fwd, hipFuncAttributeMaxDynamicSharedMemorySize, LDS_BYTES) != hipSuccess) { fprintf(stderr, "kernel_launch: hipFuncSetAttribute failed\n"); grid = -1; return; }
        if (hipOccupancyMaxActiveBlocksPerMultiprocessor(&per_cu, (const void*)yoco_fwd, NWAVES * 64, LDS_BYTES) != hipSuccess || per_cu < 1) { fprintf(stderr, "kernel_launch: occupancy query reports %d workgroups per CU\n", per_cu); per_cu = 1; }
        (void)hipGetLastError();
        grid = cus;
    }
    if (grid < 0) return;
    if (hipMemsetAsync((char*)d_ws + WS_CTL, 0, ZERO_BYTES, stream) != hipSuccess) return;
    Args a{};
    for (int i = 0; i < 19; ++i) a.in[i] = (const float*)d_in[i];
    a.out = (float*)d_out; a.ws = (unsigned char*)d_ws;
#if MK_MULTI
    for (int k = 0; k < NPHASES; ++k) { a.ph_lo = k; a.ph_hi = k + 1; hipLaunchKernelGGL(yoco_fwd, dim3(grid), dim3(NWAVES * 64), LDS_BYTES, stream, a); }
#else
    a.ph_lo = 0; a.ph_hi = (FUSED_QUANT && grid == 256) ? NPHASES - 10 : NPHASES;
    hipLaunchKernelGGL(yoco_fwd, dim3(grid), dim3(NWAVES * 64), LDS_BYTES, stream, a);
#endif
    const hipError_t le = hipPeekAtLastError();
    if (le != hipSuccess) fprintf(stderr, "kernel_launch: launch failed: %s\n", hipGetErrorName(le));
}
```

```cpp
#include <hip/hip_runtime.h>
#include <hip/hip_bf16.h>
#include <cstdio>
#include <cstdint>
namespace pg8 {
#define PG8_LAS __attribute__((address_space(3)))
typedef unsigned short bf16_t;
typedef short bf16x8 __attribute__((ext_vector_type(8)));
typedef float f32x4 __attribute__((ext_vector_type(4)));
typedef unsigned u32x4 __attribute__((ext_vector_type(4)));
typedef int i32x4 __attribute__((ext_vector_type(4)));
constexpr int BM = 256, BK = 64, HALF = 128, HTB = HALF * BK * 2  , STAGE_BYTES = 8 * HTB, NXCD = 8, WGM = 8;

__host__ __device__ __forceinline__ int lds_byte(int r, int c) { const int st = (r >> 4) * 2 + (c >> 5), rr = r & 15, cc = c & 31, ob = rr * 64 + cc * 2; return st * 1024 + (ob ^ (((ob >> 9) & 1) << 5)); }
__host__ __device__ __forceinline__ void stage_rc(int b, int& R, int& C) { const int st = b / 1024, sb = b % 1024, swz = sb ^ (((sb >> 9) & 1) << 5); R = (st >> 1) * 16 + swz / 64; C = (st & 1) * 32 + (swz % 64) / 2; }
__host__ __device__ __forceinline__ int perm32(int rho) { const int n = rho >> 4, i = rho & 15; return 8 * (i >> 2) + 4 * n + (i & 3); }

struct Unit { int pm, pn; };
struct Gemm { const bf16_t* A; const bf16_t* Bt; int M, N, K; };

struct StaticOrder {
    int nM, nN, nwg, G, c;
    __host__ __device__ void init(int M, int N, int G_, int c_) { nM = M / BM; nN = N / BM; nwg = nM * nN; G = G_; c = c_; }
    __host__ __device__ __forceinline__ bool next(int i, Unit& u) const {
        const long L = (long)i * G + c; if (L >= nwg) return false;
        int wgid = (int)L; { const int q = nwg / NXCD, r = nwg % NXCD, xcd = wgid % NXCD, off = wgid / NXCD; wgid = (xcd < r ? xcd * (q + 1) : r * (q + 1) + (xcd - r) * q) + off; }
        const int nig = WGM * nN, gid = wgid / nig, fm = gid * WGM, gsz = (nM - fm) < WGM ? (nM - fm) : WGM;
        u.pm = fm + ((wgid % nig) % gsz); u.pn = (wgid % nig) / gsz; return true;
    }
    __device__ __forceinline__ void a_ready(const Unit&) const {}
    __device__ __forceinline__ void done(const Unit&) const {}
};

__device__ __forceinline__ unsigned cvt_pk_bf16(float lo, float hi) { unsigned r; asm volatile("v_cvt_pk_bf16_f32 %0, %1, %2" : "=v"(r) : "v"(lo), "v"(hi)); return r; }
__device__ __forceinline__ unsigned cvt_pk_bf16_nv(float lo, float hi) { unsigned r; asm("v_cvt_pk_bf16_f32 %0, %1, %2" : "=v"(r) : "v"(lo), "v"(hi)); return r; }
__device__ __forceinline__ float smul(float a, float b) { float r; asm("v_mul_f32 %0, %1, %2" : "=v"(r) : "v"(a), "v"(b)); return r; }
__device__ __forceinline__ void smul4t(float (&r)[4], const float (&a)[4], const float (&t)[4]) {
    asm("s_nop 0\n\tv_mul_f32 %0, %4, %8\n\tv_mul_f32 %1, %5, %9\n\tv_mul_f32 %2, %6, %10\n\tv_mul_f32 %3, %7, %11"
        : "=&v"(r[0]), "=&v"(r[1]), "=&v"(r[2]), "=&v"(r[3]) : "v"(a[0]), "v"(a[1]), "v"(a[2]), "v"(a[3]), "v"(t[0]), "v"(t[1]), "v"(t[2]), "v"(t[3]));
}
__device__ __forceinline__ f32x4 smul4(f32x4 v, float r) { return (f32x4){smul(v[0], r), smul(v[1], r), smul(v[2], r), smul(v[3], r)}; }
typedef float f32x2 __attribute__((ext_vector_type(2)));
constexpr int SSQ_STRIDE = 32;
constexpr float RMS_EPS = 1e-6f;
__device__ __forceinline__ u32x4 pack8f(f32x4 a, f32x4 b) { u32x4 w; w.x = cvt_pk_bf16(a[0], a[1]); w.y = cvt_pk_bf16(a[2], a[3]); w.z = cvt_pk_bf16(b[0], b[1]); w.w = cvt_pk_bf16(b[2], b[3]); return w; }
template <int NP4> __device__ __forceinline__ float row_rstd(const float* ssq, int row, float inv_dim) {
    const f32x4* p = (const f32x4*)(ssq + (size_t)row * SSQ_STRIDE); float s = 0.f;
#pragma unroll
    for (int j = 0; j < NP4; ++j) { const f32x4 v = p[j]; s += (v[0] + v[1]) + (v[2] + v[3]); }
    return 1.0f / sqrtf(s * inv_dim + RMS_EPS);
}
template <int NP4> __device__ __forceinline__ void lane_rstd(float (&rs)[2][4], const float* ssq, int row0w, int fr, int fq, float inv_dim) {
    const float mine0 = row_rstd<NP4>(ssq, row0w + 16 * fq + fr, inv_dim), mine1 = row_rstd<NP4>(ssq, row0w + HALF + 16 * fq + fr, inv_dim);
#pragma unroll
    for (int m = 0; m < 4; ++m) { rs[0][m] = __shfl(mine0, fr + 16 * m); rs[1][m] = __shfl(mine1, fr + 16 * m); }
    asm volatile("" ::: "memory");
}
__device__ __forceinline__ void lane_rstd_tab(float (&rs)[2][4], const PG8_LAS float* tab, int rloc  ) {
#pragma unroll
    for (int ai = 0; ai < 2; ++ai)
#pragma unroll
        for (int m = 0; m < 4; ++m) rs[ai][m] = tab[rloc + ai * HALF + m * 16];
}
__device__ __forceinline__ float sumsq4(f32x4 v) { return (v[0] * v[0] + v[1] * v[1]) + (v[2] * v[2] + v[3] * v[3]); }
__device__ __forceinline__ float silu_mul(float g, float u) { return g * u * __builtin_amdgcn_rcpf(1.0f + __builtin_amdgcn_exp2f(-1.4426950408889634f * g)); }

__device__ __forceinline__ void store_scaled_tile(const f32x4 (&acc)[2][2][4][2], const float (&rs)[2][4], bf16_t* out, int ldo, int row0, int ocol0, float* ssq_out, int slot, int fq) {
#pragma unroll
    for (int ai = 0; ai < 2; ++ai)
#pragma unroll
        for (int m = 0; m < 4; ++m) { const int row = row0 + ai * HALF + m * 16; const float r = rs[ai][m]; float s = 0.f;
#pragma unroll
            for (int bj = 0; bj < 2; ++bj) { const f32x4 v0 = smul4(acc[ai][bj][m][0], r), v1 = smul4(acc[ai][bj][m][1], r); s += sumsq4(v0) + sumsq4(v1);
                *(u32x4*)(out + (size_t)row * ldo + ocol0 + bj * HALF) = pack8f(v0, v1); }
            if (ssq_out) { s += __shfl_xor(s, 16); s += __shfl_xor(s, 32); if (fq == 0) ssq_out[(size_t)row * SSQ_STRIDE + slot] = s; }
            asm volatile("" ::: "memory"); }
}

struct EpiUp {
    static constexpr bool PERM = true, AFTER_DRAIN = false, HAS_INIT = false, I8 = true;
    bf16_t* hid; const PG8_LAS float* rtab; int n_ffn;
    bf16_t* ckv; float* ssq_ckv; bf16_t* kr; const float* cos_t; const float* sin_t; const PG8_LAS float* wtab; int pn0;
    __device__ __forceinline__ void operator()(f32x4 (&acc)[2][2][4][2], const Unit& u, int wr, int wc, int fr, int fq) const {
        const int row0 = u.pm * BM + wr * 64 + fr; float rs[2][4]; lane_rstd_tab(rs, rtab, (u.pm & 7) * BM + wr * 64 + fr);
#pragma unroll
        for (int bj = 0; bj < 2; ++bj)
#pragma unroll
            for (int n = 0; n < 2; ++n) { const f32x4 wf = *(const PG8_LAS f32x4*)(wtab + ((u.pn - pn0) >> 2) * BM + bj * HALF + wc * 32 + 8 * fq + 4 * n);
#pragma unroll
                for (int ai = 0; ai < 2; ++ai)
#pragma unroll
                    for (int m = 0; m < 4; ++m) { const i32x4 iv = __builtin_bit_cast(i32x4, acc[ai][bj][m][n]); acc[ai][bj][m][n] = (f32x4){smul((float)iv.x, wf[0]), smul((float)iv.y, wf[1]), smul((float)iv.z, wf[2]), smul((float)iv.w, wf[3])}; } }
        if (u.pn < n_ffn) {
            const int col0 = u.pn * HALF + wc * 32 + 8 * fq;
#pragma unroll
            for (int ai = 0; ai < 2; ++ai)
#pragma unroll
                for (int m = 0; m < 4; ++m) { const float r = rs[ai][m], rn = r * -1.4426950408889634f, r2 = r * r;
                    f32x4 h[2];
#pragma unroll
                    for (int n = 0; n < 2; ++n) {
                        const f32x4 xg = acc[ai][0][m][n], xu = acc[ai][1][m][n]; float e[4], rc[4];
#pragma unroll
                        for (int k = 0; k < 4; ++k) e[k] = __builtin_amdgcn_exp2f(smul(xg[k], rn));
#pragma unroll
                        for (int k = 0; k < 4; ++k) rc[k] = __builtin_amdgcn_rcpf(e[k] + 1.0f);
                        float p2[4], hh[4];
#pragma unroll
                        for (int k = 0; k < 4; ++k) p2[k] = smul(smul(xg[k], xu[k]), r2);
                        smul4t(hh, p2, rc);
#pragma unroll
                        for (int k = 0; k < 4; ++k) h[n][k] = hh[k];
                    }
                    u32x4 w; w.x = cvt_pk_bf16_nv(h[0][0], h[0][1]); w.y = cvt_pk_bf16_nv(h[0][2], h[0][3]); w.z = cvt_pk_bf16_nv(h[1][0], h[1][1]); w.w = cvt_pk_bf16_nv(h[1][2], h[1][3]);
                    *(u32x4*)(hid + (size_t)(row0 + ai * HALF + m * 16) * 5632 + col0) = w; asm volatile("" ::: "memory"); __builtin_amdgcn_sched_barrier(0); }
        } else if (u.pn < n_ffn + 2) {
            const int t = u.pn - n_ffn;
            store_scaled_tile(acc, rs, ckv, 512, row0, t * BM + wc * 32 + 8 * fq, ssq_ckv, t * 4 + wc, fq);
        } else if (wc == 0) {
#pragma unroll
            for (int ai = 0; ai < 2; ++ai)
#pragma unroll
                for (int m = 0; m < 4; ++m) { const int row = row0 + ai * HALF + m * 16; const float r = rs[ai][m];
                    const f32x4 c0 = *(const f32x4*)(cos_t + (size_t)row * 32 + 8 * fq), c1 = *(const f32x4*)(cos_t + (size_t)row * 32 + 8 * fq + 4);
                    const f32x4 s0 = *(const f32x4*)(sin_t + (size_t)row * 32 + 8 * fq), s1 = *(const f32x4*)(sin_t + (size_t)row * 32 + 8 * fq + 4);
                    const f32x4 a0 = acc[ai][0][m][0] * r, a1 = acc[ai][0][m][1] * r, b0 = acc[ai][1][m][0] * r, b1 = acc[ai][1][m][1] * r;
                    *(u32x4*)(kr + (size_t)row * 64 + 8 * fq) = pack8f(a0 * c0 - b0 * s0, a1 * c1 - b1 * s1);
                    *(u32x4*)(kr + (size_t)row * 64 + 32 + 8 * fq) = pack8f(a0 * s0 + b0 * c0, a1 * s1 + b1 * c1); asm volatile("" ::: "memory"); }
        }
    }
};
template <int HALF_STEP, bool FIN = false> struct EpiResT {
    static constexpr bool PERM = true, AFTER_DRAIN = false, HAS_INIT = true, I8 = false;
    static constexpr float alpha = HALF_STEP ? 0.5f : 1.0f, inv_alpha = HALF_STEP ? 2.0f : 1.0f;
    static __device__ __forceinline__ f32x4 sa(f32x4 v) { if constexpr (HALF_STEP) return (f32x4){__builtin_ldexpf(v[0], -1), __builtin_ldexpf(v[1], -1), __builtin_ldexpf(v[2], -1), __builtin_ldexpf(v[3], -1)}; else return v; }
    static __device__ __forceinline__ f32x4 si(f32x4 v) { if constexpr (HALF_STEP) return (f32x4){__builtin_ldexpf(v[0], 1), __builtin_ldexpf(v[1], 1), __builtin_ldexpf(v[2], 1), __builtin_ldexpf(v[3], 1)}; else return v; }
    unsigned char* wsb;
    PG8_LAS float* sm;
    float* out; const float* gain;
    unsigned target;
    static constexpr long QF_MiB = 1l << 20, QF_HB = 8 * QF_MiB, QF_SSQ = 2 * QF_MiB, QF_AMX = 1073 * QF_MiB, QF_ASC = 1072 * QF_MiB, QF_AQ = 1056 * QF_MiB  , QF_PCNT = 8448, QF_TMO = 4096 + 128  ;
    __device__ __forceinline__ void init(f32x4 (&acc)[2][2][4][2], const Unit& u, int wr, int wc, int fr, int fq) const {
        const int row0 = u.pm * BM + wr * 64 + fr, col0 = u.pn * BM + wc * 32 + 8 * fq;
#pragma unroll
        for (int ai = 0; ai < 2; ++ai)
#pragma unroll
            for (int m = 0; m < 4; ++m)
#pragma unroll
                for (int bj = 0; bj < 2; ++bj) { const u32x4 rb = *(const u32x4*)((const bf16_t*)(wsb + QF_HB) + (size_t)(row0 + ai * HALF + m * 16) * 2048 + col0 + bj * HALF);
                    acc[ai][bj][m][0] = si((f32x4){__uint_as_float(rb.x << 16), __uint_as_float(rb.x & 0xffff0000u), __uint_as_float(rb.y << 16), __uint_as_float(rb.y & 0xffff0000u)});
                    acc[ai][bj][m][1] = si((f32x4){__uint_as_float(rb.z << 16), __uint_as_float(rb.z & 0xffff0000u), __uint_as_float(rb.w << 16), __uint_as_float(rb.w & 0xffff0000u)}); }
    }
    static __device__ __forceinline__ float absmax8(u32x4 w) {
        float a = fmaxf(fabsf(__uint_as_float(w.x << 16)), fabsf(__uint_as_float(w.x & 0xffff0000u)));
        a = fmaxf(a, fmaxf(fabsf(__uint_as_float(w.y << 16)), fabsf(__uint_as_float(w.y & 0xffff0000u))));
        a = fmaxf(a, fmaxf(fabsf(__uint_as_float(w.z << 16)), fabsf(__uint_as_float(w.z & 0xffff0000u))));
        return fmaxf(a, fmaxf(fabsf(__uint_as_float(w.w << 16)), fabsf(__uint_as_float(w.w & 0xffff0000u))));
    }
    static __device__ __forceinline__ unsigned q2(unsigned u, float sc) {
        const int a0 = (int)__builtin_rintf(__uint_as_float(u << 16) * sc), a1 = (int)__builtin_rintf(__uint_as_float(u & 0xffff0000u) * sc);
        return ((unsigned)a0 & 0xffu) | (((unsigned)a1 & 0xffu) << 8);
    }
    __device__ __forceinline__ void operator()(const f32x4 (&acc)[2][2][4][2], const Unit& u, int wr, int wc, int fr, int fq) const {
        const int row0 = u.pm * BM + wr * 64 + fr, col0 = u.pn * BM + wc * 32 + 8 * fq;
        const bool fuse = target != 0u; constexpr bool last = FIN;
        bf16_t* hb = (bf16_t*)(wsb + QF_HB); float* ssq = (float*)(wsb + QF_SSQ);
#pragma unroll
        for (int ai = 0; ai < 2; ++ai)
#pragma unroll
            for (int m = 0; m < 4; ++m) { const int row = row0 + ai * HALF + m * 16; float s = 0.f, mxa = 0.f;
#pragma unroll
                for (int bj = 0; bj < 2; ++bj) { const f32x4 v0 = sa(acc[ai][bj][m][0]), v1 = sa(acc[ai][bj][m][1]); s += sumsq4(v0) + sumsq4(v1);
                    const u32x4 w = pack8f(v0, v1); mxa = fmaxf(mxa, absmax8(w));
                    if (!last) *(u32x4*)(hb + (size_t)row * 2048 + col0 + bj * HALF) = w; }
                s += __shfl_xor(s, 16); s += __shfl_xor(s, 32); if (fq == 0) ssq[(size_t)row * SSQ_STRIDE + u.pn * 4 + wc] = s;
                if (fuse) { mxa = fmaxf(mxa, __shfl_xor(mxa, 16)); mxa = fmaxf(mxa, __shfl_xor(mxa, 32));
                    if (fq == 0) sm[wc * BM + wr * 64 + ai * HALF + m * 16 + fr] = last ? s : mxa; } }
        if (!fuse) return;
        __syncthreads();
        int tq = threadIdx.x; asm volatile("" : "+v"(tq));
        float* amx = (float*)(wsb + QF_AMX);
        unsigned* tmo = (unsigned*)wsb + QF_TMO;
        if (tq < 64) {
            f32x4 a = *(const PG8_LAS f32x4*)(sm + 4 * tq);
#pragma unroll
            for (int w = 1; w < 4; ++w) { const f32x4 v = *(const PG8_LAS f32x4*)(sm + w * BM + 4 * tq);
                if constexpr (last) a = a + v; else { a[0] = fmaxf(a[0], v[0]); a[1] = fmaxf(a[1], v[1]); a[2] = fmaxf(a[2], v[2]); a[3] = fmaxf(a[3], v[3]); } }
            float* dst = amx + (size_t)(u.pm * 8 + u.pn) * BM + 4 * tq;
            asm volatile("global_store_dwordx4 %0, %1, off sc1\n\ts_nop 1" :: "v"(dst), "v"(a) : "memory");
            asm volatile("s_waitcnt vmcnt(0)" ::: "memory");
            if (tq == 0) { unsigned* pc = (unsigned*)wsb + QF_PCNT + u.pm * 16;
                (void)__hip_atomic_fetch_add(pc, 1u, __ATOMIC_RELAXED, __HIP_MEMORY_SCOPE_AGENT);
                unsigned sp = 0u;
                while (__hip_atomic_load(pc, __ATOMIC_RELAXED, __HIP_MEMORY_SCOPE_AGENT) < target) { __builtin_amdgcn_s_sleep(1);
                    if ((++sp & 255u) == 0u) { if (__hip_atomic_load(tmo, __ATOMIC_RELAXED, __HIP_MEMORY_SCOPE_AGENT)) break; if (sp > (1u << 18)) { atomicAdd(tmo, 1u); break; } } }
                __builtin_amdgcn_fence(__ATOMIC_ACQUIRE, "agent");
                asm volatile("s_waitcnt vmcnt(0)" ::: "memory"); } }
        __syncthreads();
        { const f32x4 v = *(const f32x4*)(amx + (size_t)(u.pm * 8 + (tq >> 6)) * BM + 4 * (tq & 63)); *(PG8_LAS f32x4*)(sm + (tq >> 6) * BM + 4 * (tq & 63)) = v; }
        __syncthreads();
        if (tq < BM) { float a = sm[tq];
#pragma unroll
            for (int t = 1; t < 8; ++t) { if constexpr (last) a += sm[t * BM + tq]; else a = fmaxf(a, sm[t * BM + tq]); }
            if constexpr (last) { a = 1.0f / sqrtf(a * (1.0f / 2048.0f) + RMS_EPS);
                if (__hip_atomic_load(tmo, __ATOMIC_RELAXED, __HIP_MEMORY_SCOPE_AGENT) != 0u) a = __builtin_nanf(""); }
            else if (u.pn == 0) ((float*)(wsb + QF_ASC))[u.pm * BM + tq] = a * (1.0f / 127.0f);
            sm[8 * BM + tq] = a; }
        __syncthreads();
        if (!last) {
            signed char* aq = (signed char*)(wsb + QF_AQ);
#pragma unroll
            for (int ai = 0; ai < 2; ++ai)
#pragma unroll
                for (int m = 0; m < 4; ++m) { const int row = row0 + ai * HALF + m * 16; const float rm = sm[8 * BM + wr * 64 + ai * HALF + m * 16 + fr], sc = rm > 0.f ? 127.0f / rm : 0.f;
#pragma unroll
                    for (int bj = 0; bj < 2; ++bj) { const u32x4 w = pack8f(sa(acc[ai][bj][m][0]), sa(acc[ai][bj][m][1]));
                        typedef unsigned u32x2 __attribute__((ext_vector_type(2)));
                        *(u32x2*)(aq + (size_t)row * 2048 + col0 + bj * HALF) = (u32x2){q2(w.x, sc) | (q2(w.y, sc) << 16), q2(w.z, sc) | (q2(w.w, sc) << 16)}; } }
        } else {
#pragma unroll
            for (int bj = 0; bj < 2; ++bj) { const f32x4 g0 = *(const f32x4*)(gain + col0 + bj * HALF), g1 = *(const f32x4*)(gain + col0 + bj * HALF + 4);
#pragma unroll
                for (int ai = 0; ai < 2; ++ai)
#pragma unroll
                    for (int m = 0; m < 4; ++m) { const int row = row0 + ai * HALF + m * 16; const float rs = sm[8 * BM + wr * 64 + ai * HALF + m * 16 + fr] * alpha;
                        float* o = out + (size_t)row * 2048 + col0 + bj * HALF;
                        const f32x4 a0 = smul4(acc[ai][bj][m][0], rs), a1 = smul4(acc[ai][bj][m][1], rs);
                        __builtin_nontemporal_store((f32x4){smul(a0[0], g0[0]), smul(a0[1], g0[1]), smul(a0[2], g0[2]), smul(a0[3], g0[3])}, (f32x4*)o); __builtin_nontemporal_store((f32x4){smul(a1[0], g1[0]), smul(a1[1], g1[1]), smul(a1[2], g1[2]), smul(a1[3], g1[3])}, (f32x4*)(o + 4)); asm volatile("" ::: "memory"); } }
        }
    }
};
typedef EpiResT<1> EpiRes;
struct EpiQKV {
    static constexpr bool PERM = true, AFTER_DRAIN = false, HAS_INIT = false, I8 = true;
    bf16_t* qkv; size_t tstride; const PG8_LAS float* rtab; float* kmean; const PG8_LAS float* wtab; int pn0;
    __device__ __forceinline__ void operator()(f32x4 (&acc)[2][2][4][2], const Unit& u, int wr, int wc, int fr, int fq) const {
        const int row0 = u.pm * BM + wr * 64 + fr; float rs[2][4]; lane_rstd_tab(rs, rtab, (u.pm & 7) * BM + wr * 64 + fr);
#pragma unroll
        for (int bj = 0; bj < 2; ++bj)
#pragma unroll
            for (int n = 0; n < 2; ++n) { const f32x4 wf = *(const PG8_LAS f32x4*)(wtab + ((u.pn - pn0) >> 2) * BM + bj * HALF + wc * 32 + 8 * fq + 4 * n);
#pragma unroll
                for (int ai = 0; ai < 2; ++ai)
#pragma unroll
                    for (int m = 0; m < 4; ++m) { const i32x4 iv = __builtin_bit_cast(i32x4, acc[ai][bj][m][n]); acc[ai][bj][m][n] = (f32x4){smul((float)iv.x, wf[0]), smul((float)iv.y, wf[1]), smul((float)iv.z, wf[2]), smul((float)iv.w, wf[3])}; } }
        const int t = u.pn >> 3, ocol0 = (u.pn & 7) * BM + wc * 32 + 8 * fq; bf16_t* dst = qkv + (size_t)t * tstride;
        store_scaled_tile(acc, rs, dst, 2048, row0, ocol0, nullptr, 0, fq);
        if (t == 1) {
#pragma unroll
            for (int bj = 0; bj < 2; ++bj)
#pragma unroll
                for (int n = 0; n < 2; ++n)
#pragma unroll
                    for (int e = 0; e < 4; ++e) { float s = 0.f;
#pragma unroll
                        for (int ai = 0; ai < 2; ++ai)
#pragma unroll
                            for (int m = 0; m < 4; ++m) s += acc[ai][bj][m][n][e] * rs[ai][m];
                        s += __shfl_xor(s, 1); s += __shfl_xor(s, 2); s += __shfl_xor(s, 4); s += __shfl_xor(s, 8);
                        if (fr == 0) __hip_atomic_fetch_add(kmean + (size_t)u.pm * 2048 + ocol0 + bj * HALF + 4 * n + e, s, __ATOMIC_RELAXED, __HIP_MEMORY_SCOPE_AGENT); }
        }
    }
};
struct EpiScaled {
    static constexpr bool PERM = true, AFTER_DRAIN = false, HAS_INIT = false, I8 = false;
    bf16_t* out; int ldo; const PG8_LAS float* rtab; float* ssq_out;
    __device__ __forceinline__ void operator()(const f32x4 (&acc)[2][2][4][2], const Unit& u, int wr, int wc, int fr, int fq) const {
        const int row0 = u.pm * BM + wr * 64 + fr; float rs[2][4]; lane_rstd_tab(rs, rtab, (u.pm & 7) * BM + wr * 64 + fr);
        store_scaled_tile(acc, rs, out, ldo, row0, u.pn * BM + wc * 32 + 8 * fq, ssq_out, u.pn * 4 + wc, fq);
    }
};
struct EpiUQ {
    static constexpr bool PERM = true, AFTER_DRAIN = false, HAS_INIT = false, I8 = false;
    bf16_t* qn; bf16_t* qr; const float* ssq_cq; const float* cos_t; const float* sin_t;
    __device__ __forceinline__ void operator()(const f32x4 (&acc)[2][2][4][2], const Unit& u, int wr, int wc, int fr, int fq) const {
        const int row0 = u.pm * BM + wr * 64 + fr; float rs[2][4]; lane_rstd<3>(rs, ssq_cq, row0 - fr, fr, fq, 1.0f / 768.0f);
        if (u.pn < 8) { store_scaled_tile(acc, rs, qn, 2048, row0, u.pn * BM + wc * 32 + 8 * fq, nullptr, 0, fq); }
        else { const int head = (u.pn - 8) * 4 + wc;
#pragma unroll
            for (int ai = 0; ai < 2; ++ai)
#pragma unroll
                for (int m = 0; m < 4; ++m) { const int row = row0 + ai * HALF + m * 16; const float r = rs[ai][m];
                    const f32x4 c0 = *(const f32x4*)(cos_t + (size_t)row * 32 + 8 * fq), c1 = *(const f32x4*)(cos_t + (size_t)row * 32 + 8 * fq + 4);
                    const f32x4 s0 = *(const f32x4*)(sin_t + (size_t)row * 32 + 8 * fq), s1 = *(const f32x4*)(sin_t + (size_t)row * 32 + 8 * fq + 4);
                    const f32x4 a0 = acc[ai][0][m][0] * r, a1 = acc[ai][0][m][1] * r, b0 = acc[ai][1][m][0] * r, b1 = acc[ai][1][m][1] * r;
                    *(u32x4*)(qr + (size_t)row * 1024 + head * 64 + 8 * fq) = pack8f(a0 * c0 - b0 * s0, a1 * c1 - b1 * s1);
                    *(u32x4*)(qr + (size_t)row * 1024 + head * 64 + 32 + 8 * fq) = pack8f(a0 * s0 + b0 * c0, a1 * s1 + b1 * c1); asm volatile("" ::: "memory"); } }
    }
};
struct EpiNull { static constexpr bool PERM = true, AFTER_DRAIN = false, HAS_INIT = false, I8 = false;
    __device__ __forceinline__ void operator()(const f32x4 (&acc)[2][2][4][2], const Unit&, int, int, int, int) const {
#pragma unroll
        for (int a = 0; a < 2; ++a)
#pragma unroll
            for (int b = 0; b < 2; ++b)
#pragma unroll
                for (int m = 0; m < 4; ++m)
#pragma unroll
                    for (int n = 0; n < 2; ++n) asm volatile("" :: "v"(acc[a][b][m][n])); } };
struct EpiUKV {
    static constexpr bool PERM = true, AFTER_DRAIN = false, HAS_INIT = false, I8 = false;
    bf16_t* kn; bf16_t* v; const float* ssq_ckv;
    __device__ __forceinline__ void operator()(const f32x4 (&acc)[2][2][4][2], const Unit& u, int wr, int wc, int fr, int fq) const {
        const int row0 = u.pm * BM + wr * 64 + fr; float rs[2][4]; lane_rstd<2>(rs, ssq_ckv, row0 - fr, fr, fq, 1.0f / 512.0f);
        const int ocol = u.pn * HALF + wc * 32 + 8 * fq;
#pragma unroll
        for (int ai = 0; ai < 2; ++ai)
#pragma unroll
            for (int m = 0; m < 4; ++m) { const size_t off = (size_t)(row0 + ai * HALF + m * 16) * 2048 + ocol; const float r = rs[ai][m];
                *(u32x4*)(kn + off) = pack8f(acc[ai][0][m][0] * r, acc[ai][0][m][1] * r); *(u32x4*)(v + off) = pack8f(acc[ai][1][m][0] * r, acc[ai][1][m][1] * r); }
    }
};

template <class Epi, class Sched, bool ALIGN_EPI = false, bool SP2 = false>
__device__ __forceinline__ void gemm_phase(PG8_LAS unsigned char* lds, const Gemm g, const Sched& S, const Epi& E) {
    int tid_ = threadIdx.x; asm volatile("" : "+v"(tid_));
    const int tid = tid_, wid = __builtin_amdgcn_readfirstlane(tid >> 6), lane = tid & 63, wr = wid >> 2, wc = wid & 3, fr = lane & 15, fq = lane >> 4;
    const int K = g.K, nt = K / BK;
    unsigned voffA[2], voffB[2];
#pragma unroll
    for (int i = 0; i < 2; ++i) { int R, C; stage_rc(tid * 16 + i * 8192, R, C); const int Rb = Epi::PERM ? ((R & ~31) + perm32(R & 31)) : R;
        voffA[i] = (unsigned)(R * K + C) * 2u; voffB[i] = (unsigned)(Rb * K + C) * 2u; }
    const size_t kstep = (size_t)(BK * 2);
    const size_t hstep = (size_t)HALF * K * 2;
    const size_t tstep = 2 * hstep;
    const unsigned ldsw = (unsigned)wid * 1024u;
    const int aoff = lds_byte(wr * 64 + fr, fq * 8), boff = lds_byte(wc * 32 + fr, fq * 8);
#define PG8_SA(b, h) (((b) * 2 + (h)) * HTB)
#define PG8_SB(b, h) ((4 + (b) * 2 + (h)) * HTB)
#define PG8_STAGE(bufoff, gbase, voff) do { _Pragma("unroll") for (int _i = 0; _i < 2; ++_i) \
        __builtin_amdgcn_global_load_lds((const unsigned*)((const char*)(gbase) + (voff)[_i]), (PG8_LAS unsigned*)(lds + (bufoff) + ldsw + _i * 8192), 16, 0, 0); } while (0)
#define PG8_LDA(dst, b, h) do { _Pragma("unroll") for (int m = 0; m < 4; ++m) _Pragma("unroll") for (int k = 0; k < 2; ++k) dst[m][k] = *(const PG8_LAS bf16x8*)(lds + PG8_SA(b, h) + aoff + m * 2048 + k * 1024); } while (0)
#define PG8_LDB(dst, b, h) do { _Pragma("unroll") for (int n = 0; n < 2; ++n) _Pragma("unroll") for (int k = 0; k < 2; ++k) dst[n][k] = *(const PG8_LAS bf16x8*)(lds + PG8_SB(b, h) + boff + n * 2048 + k * 1024); } while (0)
#define PG8_MMA(ai, bj, At, Bt) do { __builtin_amdgcn_s_setprio(1); _Pragma("unroll") for (int m = 0; m < 4; ++m) _Pragma("unroll") for (int n = 0; n < 2; ++n) _Pragma("unroll") for (int k = 0; k < 2; ++k) { \
        if constexpr (Epi::I8) acc[ai][bj][m][n] = __builtin_bit_cast(f32x4, __builtin_amdgcn_mfma_i32_16x16x64_i8(__builtin_bit_cast(i32x4, Bt[n][k]), __builtin_bit_cast(i32x4, At[m][k]), __builtin_bit_cast(i32x4, acc[ai][bj][m][n]), 0, 0, 0)); \
        else acc[ai][bj][m][n] = __builtin_amdgcn_mfma_f32_16x16x32_bf16(Bt[n][k], At[m][k], acc[ai][bj][m][n], 0, 0, 0); } __builtin_amdgcn_s_setprio(0); } while (0)
#define PG8_WAIT_V(n) asm volatile("s_waitcnt vmcnt(" #n ")" ::: "memory")
#define PG8_WAIT_L(n) asm volatile("s_waitcnt lgkmcnt(" #n ")" ::: "memory")
#define PG8_BAR __builtin_amdgcn_s_barrier()
#define PG8_SCHED __builtin_amdgcn_sched_barrier(0)
#define PG8_INIT(unit_) do { if constexpr (Epi::HAS_INIT) { E.init(acc, (unit_), wr, wc, fr, fq); } else { _Pragma("unroll") for (int a_ = 0; a_ < 2; ++a_) _Pragma("unroll") for (int b_ = 0; b_ < 2; ++b_) _Pragma("unroll") for (int m_ = 0; m_ < 4; ++m_) _Pragma("unroll") for (int n_ = 0; n_ < 2; ++n_) acc[a_][b_][m_][n_] = (f32x4){0.f, 0.f, 0.f, 0.f}; } } while (0)
    Unit cur, nxt; int ui = 0;
    if (!S.next(0, cur)) return;
    f32x4 acc[2][2][4][2];
    bf16x8 At[4][2], B0[2][2], B1[2][2];
    const char* cA = (const char*)g.A + (size_t)cur.pm * tstep; const char* cB = (const char*)g.Bt + (size_t)cur.pn * tstep;
    S.a_ready(cur);
    if constexpr (SP2) {
        PG8_STAGE(PG8_SB(0, 0), cB, voffB); PG8_STAGE(PG8_SB(0, 1), cB + hstep, voffB); PG8_STAGE(PG8_SA(0, 0), cA, voffA); PG8_STAGE(PG8_SA(0, 1), cA + hstep, voffA);
        PG8_INIT(cur);
        if (wr == 1) PG8_BAR;
        PG8_WAIT_V(2); PG8_BAR;
        PG8_STAGE(PG8_SB(1, 0), cB + kstep, voffB); PG8_STAGE(PG8_SA(1, 0), cA + kstep, voffA); PG8_STAGE(PG8_SB(1, 1), cB + hstep + kstep, voffB);
        PG8_WAIT_V(6); PG8_BAR;
    } else {
        PG8_STAGE(PG8_SB(0, 0), cB, voffB); PG8_STAGE(PG8_SA(0, 0), cA, voffA); PG8_STAGE(PG8_SB(0, 1), cB + hstep, voffB); PG8_STAGE(PG8_SA(0, 1), cA + hstep, voffA);
        PG8_INIT(cur);
        if (wr == 1) PG8_BAR;
        PG8_WAIT_V(4); PG8_BAR;
        PG8_STAGE(PG8_SB(1, 0), cB + kstep, voffB); PG8_STAGE(PG8_SA(1, 0), cA + kstep, voffA); PG8_STAGE(PG8_SB(1, 1), cB + hstep + kstep, voffB);
        PG8_WAIT_V(6); PG8_BAR;
    }
    for (;;) {
        const bool has_next = S.next(ui + 1, nxt);
        const char* nA = has_next ? (const char*)g.A + (size_t)nxt.pm * tstep : cA; const char* nB = has_next ? (const char*)g.Bt + (size_t)nxt.pn * tstep : cB;
        for (int t = 0; t < nt; t += 2) {
            const bool last = (t == nt - 2);
            const char* a1 = cA + (size_t)(t + 1) * kstep;
            const char* a2 = last ? nA : cA + (size_t)(t + 2) * kstep; const char* b2 = last ? nB : cB + (size_t)(t + 2) * kstep;
            const char* a3 = a2 + kstep; const char* b3 = b2 + kstep;
            if (last && has_next) S.a_ready(nxt);
            if constexpr (SP2) {
            PG8_LDB(B0, 0, 0); PG8_LDB(B1, 0, 1); PG8_SCHED; PG8_LDA(At, 0, 0); PG8_STAGE(PG8_SA(1, 1), a1 + hstep, voffA);
            PG8_WAIT_V(8); PG8_WAIT_L(0); PG8_BAR; PG8_MMA(0, 0, At, B0); PG8_MMA(0, 1, At, B1); PG8_BAR; PG8_SCHED;
            PG8_LDA(At, 0, 1); PG8_STAGE(PG8_SB(0, 0), b2, voffB); PG8_STAGE(PG8_SB(0, 1), b2 + hstep, voffB); PG8_STAGE(PG8_SA(0, 0), a2, voffA);
            PG8_WAIT_V(8); PG8_WAIT_L(0); PG8_BAR; PG8_MMA(1, 0, At, B0); PG8_MMA(1, 1, At, B1); PG8_BAR; PG8_SCHED;
            PG8_LDB(B0, 1, 0); PG8_LDB(B1, 1, 1); PG8_SCHED; PG8_LDA(At, 1, 0); PG8_STAGE(PG8_SA(0, 1), a2 + hstep, voffA);
            PG8_WAIT_V(8); PG8_WAIT_L(0); PG8_BAR; PG8_MMA(0, 0, At, B0); PG8_MMA(0, 1, At, B1); PG8_BAR; PG8_SCHED;
            PG8_LDA(At, 1, 1); PG8_STAGE(PG8_SB(1, 0), b3, voffB); PG8_STAGE(PG8_SB(1, 1), b3 + hstep, voffB); PG8_STAGE(PG8_SA(1, 0), a3, voffA);
            PG8_WAIT_V(8); PG8_WAIT_L(0); PG8_BAR; PG8_MMA(1, 0, At, B0); PG8_MMA(1, 1, At, B1); PG8_BAR; PG8_SCHED;
            } else {
            PG8_LDB(B0, 0, 0); PG8_SCHED; PG8_LDA(At, 0, 0); PG8_STAGE(PG8_SA(1, 1), a1 + hstep, voffA);
            PG8_WAIT_L(8); PG8_BAR; PG8_WAIT_L(0); PG8_MMA(0, 0, At, B0); PG8_BAR; PG8_SCHED;
            PG8_LDB(B1, 0, 1); PG8_STAGE(PG8_SB(0, 0), b2, voffB);
            PG8_BAR; PG8_WAIT_L(0); PG8_MMA(0, 1, At, B1); PG8_BAR;
            PG8_LDA(At, 0, 1); PG8_STAGE(PG8_SA(0, 0), a2, voffA);
            PG8_BAR; PG8_WAIT_L(0); PG8_MMA(1, 0, At, B0); PG8_BAR; PG8_SCHED;
            PG8_STAGE(PG8_SB(0, 1), b2 + hstep, voffB);
            PG8_WAIT_V(6); PG8_BAR; PG8_MMA(1, 1, At, B1); PG8_BAR;
            PG8_LDB(B0, 1, 0); PG8_SCHED; PG8_LDA(At, 1, 0); PG8_STAGE(PG8_SA(0, 1), a2 + hstep, voffA);
            PG8_WAIT_L(8); PG8_BAR; PG8_WAIT_L(0); PG8_MMA(0, 0, At, B0); PG8_BAR; PG8_SCHED;
            PG8_LDB(B1, 1, 1); PG8_STAGE(PG8_SB(1, 0), b3, voffB);
            PG8_BAR; PG8_WAIT_L(0); PG8_MMA(0, 1, At, B1); PG8_BAR;
            PG8_LDA(At, 1, 1); PG8_STAGE(PG8_SA(1, 0), a3, voffA);
            PG8_BAR; PG8_WAIT_L(0); PG8_MMA(1, 0, At, B0); PG8_BAR; PG8_SCHED;
            PG8_STAGE(PG8_SB(1, 1), b3 + hstep, voffB);
            PG8_WAIT_V(6); PG8_BAR; PG8_MMA(1, 1, At, B1); PG8_BAR;
            }
        }
        if constexpr (ALIGN_EPI) { if (wr == 0) PG8_BAR; }
        if constexpr (!Epi::AFTER_DRAIN) { E(acc, cur, wr, wc, fr, fq); S.done(cur); }
        if (!has_next) break;
        PG8_INIT(nxt);
        cur = nxt; cA = nA; cB = nB; ++ui;
        if constexpr (ALIGN_EPI) { if (wr == 1) PG8_BAR; }
    }
    PG8_WAIT_V(0);
    if constexpr (!ALIGN_EPI) { if (wr == 0) PG8_BAR; }
    PG8_BAR;
    if constexpr (Epi::AFTER_DRAIN) { E.fused(acc, cur, wr, wc, fr, fq, lds, wid, lane); S.done(cur); }
#undef PG8_SA
#undef PG8_SB
#undef PG8_STAGE
#undef PG8_LDA
#undef PG8_LDB
#undef PG8_MMA
#undef PG8_WAIT_V
#undef PG8_WAIT_L
#undef PG8_BAR
#undef PG8_SCHED
#undef PG8_INIT
}
}
namespace att {
using bf16 = __hip_bfloat16;
typedef short bf16x8 __attribute__((ext_vector_type(8)));
typedef short s16x4 __attribute__((ext_vector_type(4)));
typedef float f32x16 __attribute__((ext_vector_type(16)));
typedef float f32x4 __attribute__((ext_vector_type(4)));
typedef unsigned u32x4 __attribute__((ext_vector_type(4)));
constexpr int NW = 8, QBLK = 32, KVBLK = 64, QB = NW * QBLK, D = 128;
constexpr int RS = 2048, RS_QR = 1024, RS_KR = 64;
constexpr int SHM_V = KVBLK * D * 2, SHM_K = KVBLK * D * 2, SHM_KR = KVBLK * 64 * 2;
constexpr int OFF_V = 0, OFF_K = 2 * SHM_V, OFF_WS = OFF_K + 2 * SHM_K, OFF_KR = OFF_WS + NW * 64 * 4, OFF_KM = OFF_KR + 2 * SHM_KR, LDS_BYTES = OFF_KM + 32 * 256;
constexpr float THR = 8.f;
template <int MODE> struct Cfg { static constexpr float SCALE = MODE == 0 ? 0.08838834764831845f : 0.07216878364870323f; static constexpr int NQ = MODE == 0 ? 8 : 12; };

#define KSWZ(row, colB) ((row) * 256 + ((colB) ^ (((row) & 7) << 4)))
#define KRSWZ(row, colB) ((row) * 128 + ((colB) ^ ((((row) >> 1) & 7) << 4)))
#define SBAR() __builtin_amdgcn_sched_barrier(0)
__device__ __forceinline__ int v_st(int k, int c) { const int kk = (k & ~0xC) | ((k & 4) << 1) | ((k & 8) >> 1); return ((kk >> 3) * 4 + (c >> 5)) * 512 + ((kk & 7) * 32 + (c & 31)) * 2; }
__device__ __forceinline__ int v_rd_base(int lane) { return ((lane & 3) << 3) | (((lane >> 2) & 3) << 6) | (((lane >> 4) & 1) << 5) | (((lane >> 5) & 1) << 8); }
constexpr int v_rd_off(int d0, int ks, int half) { return d0 * 512 + ks * 4096 + half * 2048; }
__device__ __forceinline__ int crow(int r, int hi) { return (r & 3) + 8 * (r >> 2) + 4 * hi; }
__device__ __forceinline__ unsigned cvtpk(float lo, float hi) { unsigned r; asm volatile("v_cvt_pk_bf16_f32 %0, %1, %2" : "=v"(r) : "v"(lo), "v"(hi)); return r; }
__device__ __forceinline__ bf16x8 pack8(f32x4 a, f32x4 b) { u32x4 w = {cvtpk(a[0], a[1]), cvtpk(a[2], a[3]), cvtpk(b[0], b[1]), cvtpk(b[2], b[3])}; return *reinterpret_cast<bf16x8*>(&w); }
__device__ __forceinline__ bf16x8 load8(const bf16* p) { return *reinterpret_cast<const bf16x8*>(p); }
__device__ __forceinline__ void mask_tile(f32x16& p0, f32x16& p1, int dq) {
    const float NEG = -__builtin_inff();
#pragma unroll
    for (int r = 0; r < 16; ++r) { const int c = (r & 3) + 8 * (r >> 2); if (dq - c < 0) p0[r] = NEG; if (dq - c - 32 < 0) p1[r] = NEG; }
}
template <int MODE, bool PERROW = false> __device__ __forceinline__ void partialSM(f32x16& p0, f32x16& p1, float& m_reg, float& mn, float& alpha) {
    constexpr float SCALE = Cfg<MODE>::SCALE;
    float pmax = p0[0]; for (int r = 1; r < 16; ++r) pmax = fmaxf(pmax, p0[r]); for (int r = 0; r < 16; ++r) pmax = fmaxf(pmax, p1[r]);
    { auto rr = __builtin_amdgcn_permlane32_swap(__float_as_uint(pmax), __float_as_uint(pmax), false, false);
      pmax = fmaxf(__uint_as_float(rr[0]), __uint_as_float(rr[1])); }
    constexpr float C2 = 1.4426950408889634f * SCALE;
    if constexpr (PERROW) {
        const bool keep = (pmax - m_reg) * SCALE <= THR; mn = keep ? m_reg : fmaxf(m_reg, pmax); alpha = keep ? 1.f : __builtin_amdgcn_exp2f((m_reg - mn) * C2); m_reg = mn; }
    else if (__builtin_expect(__all((pmax - m_reg) * SCALE <= THR), 1)) { mn = m_reg; alpha = 1.f; }
    else { mn = fmaxf(m_reg, pmax); alpha = __builtin_amdgcn_exp2f((m_reg - mn) * C2); m_reg = mn; }
    const float mnL = -mn * C2;
    for (int r = 0; r < 16; ++r) p0[r] = fmaf(p0[r], C2, mnL); for (int r = 0; r < 16; ++r) p1[r] = fmaf(p1[r], C2, mnL);
    for (int r = 0; r < 16; ++r) p0[r] = __builtin_amdgcn_exp2f(p0[r]);
}
__device__ __forceinline__ void finishSM(f32x16& p0, f32x16& p1, float alpha, float& l_reg, bf16x8& pa0, bf16x8& pa1, bf16x8& pa2, bf16x8& pa3) {
    for (int r = 0; r < 16; ++r) p1[r] = __builtin_amdgcn_exp2f(p1[r]);
    float ps = 0; for (int r = 0; r < 16; ++r) ps += p0[r]; for (int r = 0; r < 16; ++r) ps += p1[r];
    { auto rr = __builtin_amdgcn_permlane32_swap(__float_as_uint(ps), __float_as_uint(ps), false, false);
      ps = __uint_as_float(rr[0]) + __uint_as_float(rr[1]); }
    l_reg = l_reg * alpha + ps;
#define PK4(P, B_, OUT) do { unsigned a0 = cvtpk(P[B_+0], P[B_+1]), a1 = cvtpk(P[B_+2], P[B_+3]);                          \
        unsigned b0 = cvtpk(P[B_+4], P[B_+5]), b1 = cvtpk(P[B_+6], P[B_+7]);                                             \
        auto r0 = __builtin_amdgcn_permlane32_swap(a0, b0, false, false); auto r1 = __builtin_amdgcn_permlane32_swap(a1, b1, false, false); \
        u32x4 w = {r0[0], r1[0], r0[1], r1[1]}; OUT = *reinterpret_cast<bf16x8*>(&w); } while (0)
    PK4(p0, 0, pa0); PK4(p0, 8, pa1); PK4(p1, 0, pa2); PK4(p1, 8, pa3);
#undef PK4
}
template <int MODE, int KB>
__device__ __forceinline__ void qkt(f32x16& p0, f32x16& p1, const char* K_lds, const char* KR_lds, int r32, int hi, const bf16x8* qr, float slopeP, float tb) {
    if constexpr (MODE == 0) {
#pragma unroll
        for (int r = 0; r < 16; ++r) { const int c = (r & 3) + 8 * (r >> 2); p0[r] = fmaf(slopeP, (float)c, tb); p1[r] = fmaf(slopeP, (float)(c + 32), tb); }
    } else { p0 = f32x16{}; p1 = f32x16{}; }
    const char* kb[4];
#pragma unroll
    for (int dd = 0; dd < 4; ++dd) kb[dd] = K_lds + KB * SHM_K + KSWZ(r32, (dd * 16 + hi * 8) * 2);
    constexpr int NS = MODE == 1 ? 12 : 8;
    bf16x8 f0[2], f1[2];
#define QK_RD(d, s_) do { if ((d) < 8) { const char* a_ = kb[(d) & 3] + ((d) >> 2) * 128; f0[s_] = *reinterpret_cast<const bf16x8*>(a_); f1[s_] = *reinterpret_cast<const bf16x8*>(a_ + 32 * 256); }   \
        else { const char* a_ = KR_lds + KB * SHM_KR + KRSWZ(r32, ((((d) - 8) & 3) * 16 + hi * 8) * 2); f0[s_] = *reinterpret_cast<const bf16x8*>(a_); f1[s_] = *reinterpret_cast<const bf16x8*>(a_ + 32 * 128); } } while (0)
    QK_RD(0, 0);
#pragma unroll
    for (int d = 0; d < NS; ++d) {
        if (d + 1 < NS) QK_RD(d + 1, (d + 1) & 1);
        SBAR();
        p0 = __builtin_amdgcn_mfma_f32_32x32x16_bf16(f0[d & 1], qr[d], p0, 0, 0, 0);
        p1 = __builtin_amdgcn_mfma_f32_32x32x16_bf16(f1[d & 1], qr[d], p1, 0, 0, 0);
        SBAR();
    }
#undef QK_RD
}
template <int VB>
__device__ __forceinline__ void pv_tile(f32x16* o, int vb0, bf16x8 pa0, bf16x8 pa1, bf16x8 pa2, bf16x8 pa3) {
#define TRRD(dst, off) asm volatile("ds_read_b64_tr_b16 %0, %1 offset:%2" : "=&v"(dst) : "v"(vb0), "i"(off) : "memory")
#define PV_D0(d0) do { s16x4 l0, l1, l2, l3, h0, h1, h2, h3; constexpr int b_ = VB * SHM_V + v_rd_off(d0, 0, 0);   \
        TRRD(l0, b_); TRRD(h0, b_ + 2048); TRRD(l1, b_ + 4096); TRRD(h1, b_ + 6144); TRRD(l2, b_ + 8192); TRRD(h2, b_ + 10240); TRRD(l3, b_ + 12288); TRRD(h3, b_ + 14336); \
        asm volatile("s_waitcnt lgkmcnt(0)" ::: "memory"); SBAR();   \
        o[d0] = __builtin_amdgcn_mfma_f32_32x32x16_bf16(pa0, (bf16x8){l0[0], l0[1], l0[2], l0[3], h0[0], h0[1], h0[2], h0[3]}, o[d0], 0, 0, 0);   \
        o[d0] = __builtin_amdgcn_mfma_f32_32x32x16_bf16(pa1, (bf16x8){l1[0], l1[1], l1[2], l1[3], h1[0], h1[1], h1[2], h1[3]}, o[d0], 0, 0, 0);   \
        o[d0] = __builtin_amdgcn_mfma_f32_32x32x16_bf16(pa2, (bf16x8){l2[0], l2[1], l2[2], l2[3], h2[0], h2[1], h2[2], h2[3]}, o[d0], 0, 0, 0);   \
        o[d0] = __builtin_amdgcn_mfma_f32_32x32x16_bf16(pa3, (bf16x8){l3[0], l3[1], l3[2], l3[3], h3[0], h3[1], h3[2], h3[3]}, o[d0], 0, 0, 0); } while (0)
    PV_D0(0); PV_D0(1); PV_D0(2); PV_D0(3);
#undef PV_D0
#undef TRRD
}

__device__ __forceinline__ void store_o_rows(const f32x16* o, char* stg, bf16* Ow, size_t ldo, int lane, int r32, int hi) {
#pragma unroll
    for (int p = 0; p < 2; ++p) {
#pragma unroll
        for (int rr = 0; rr < 8; ++rr) { const int r = 8 * p + rr, lrow = (rr & 3) + 8 * (rr >> 2) + 4 * hi;
#pragma unroll
            for (int d0 = 0; d0 < 4; ++d0) *(unsigned short*)(stg + lrow * 256 + (d0 * 32 + r32) * 2) = (unsigned short)cvtpk(o[d0][r], 0.f); }
        asm volatile("s_waitcnt lgkmcnt(0)" ::: "memory");
#pragma unroll
        for (int i = 0; i < 4; ++i) { const int row = 4 * i + (lane >> 4), ch = lane & 15; const u32x4 v = *(const u32x4*)(stg + row * 256 + ch * 16);
            *(u32x4*)(Ow + (size_t)(16 * p + row) * ldo + ch * 8) = v; }
        asm volatile("s_waitcnt lgkmcnt(0)" ::: "memory");
    }
}
struct BlockRef { const bf16* Q; const bf16* QR; const bf16* K; const bf16* V; bf16* O; int P0; int h; };
template <int MODE> struct Seam { bf16x8 qr[Cfg<MODE>::NQ]; bf16x8 st_v0, st_v1, st_k0, st_k1, st_kr; };
struct Shared { const bf16* KR; const float* kmean; };

#define ROW(p, k0, rr) ((p) + (size_t)((k0) + (rr)) * RS + sc)
#define VMW() asm volatile("s_waitcnt vmcnt(0)" ::: "memory")
#define VMWN(n) asm volatile("s_waitcnt vmcnt(%0)" :: "i"(n) : "memory")
#define SLOAD_H(Kp, Vp, k0) do { S.st_v0 = load8(ROW(Vp, k0, sr)); S.st_v1 = load8(ROW(Vp, k0, 32 + sr));              \
                         S.st_k0 = load8(ROW(Kp, k0, sr)); S.st_k1 = load8(ROW(Kp, k0, 32 + sr));                       \
                         if constexpr (MODE == 1) S.st_kr = load8(G.KR + (size_t)((k0) + krr) * RS_KR + krc); } while (0)
#define SWRITE_HK(bf) do { *(bf16x8*)(K_lds + (bf) * SHM_K + kws) = S.st_k0; *(bf16x8*)(K_lds + (bf) * SHM_K + kws + 32 * 256) = S.st_k1; \
                           if constexpr (MODE == 1) *(bf16x8*)(KR_lds + (bf) * SHM_KR + krws) = S.st_kr; } while (0)
#define SWRITE_HV(bf) do { *(bf16x8*)(V_lds + (bf) * SHM_V + vst0) = S.st_v0; *(bf16x8*)(V_lds + (bf) * SHM_V + vst1) = S.st_v1; } while (0)
#define SWRITE_H(bf) do { SWRITE_HV(bf); SWRITE_HK(bf); } while (0)
#define QLOAD(Sq, ref) do { _Pragma("unroll") for (int d0 = 0; d0 < 8; ++d0) Sq.qr[d0] = load8((ref).Q + (size_t)(wid * QBLK + r32) * RS + d0 * 16 + hi * 8);    \
        if constexpr (MODE == 1) { _Pragma("unroll") for (int d0 = 0; d0 < 4; ++d0) Sq.qr[8 + d0] = load8((ref).QR + (size_t)(wid * QBLK + r32) * RS_QR + d0 * 16 + hi * 8); } } while (0)

template <int MODE>
__device__ __forceinline__ void attn_prime(const BlockRef& cur, const Shared& G, char* lds, Seam<MODE>& S) {
    int tid_ = threadIdx.x; asm volatile("" : "+v"(tid_));
    const int tid = tid_, wid = __builtin_amdgcn_readfirstlane(tid >> 6), lane = tid & 63, r32 = lane & 31, hi = lane >> 5;
    const int sr = tid >> 4, sc = (tid & 15) * 8, vst0 = v_st(sr, sc), vst1 = v_st(32 + sr, sc), kws = KSWZ(sr, sc * 2);
    char* V_lds = lds + OFF_V; char* K_lds = lds + OFF_K; char* KR_lds = lds + OFF_KR;
    const int krr = tid >> 3, krc = (tid & 7) * 8, krws = KRSWZ(krr, krc * 2);
    QLOAD(S, cur);
    SLOAD_H(cur.K, cur.V, 0); VMW(); SWRITE_H(0);
    __syncthreads();
}
template <int MODE>
__device__ __forceinline__ void attn_block(const BlockRef& cur, const BlockRef& nxt, const Shared& G, char* lds, Seam<MODE>& S) {
    constexpr float SCALE = Cfg<MODE>::SCALE;
    int tid_ = threadIdx.x; asm volatile("" : "+v"(tid_));
    const int tid = tid_, wid = __builtin_amdgcn_readfirstlane(tid >> 6), lane = tid & 63, r32 = lane & 31, hi = lane >> 5;
    const int NT = (cur.P0 + QB) / KVBLK;
    const int qlo = cur.P0 + wid * QBLK, qm = qlo + r32 - 4 * hi;
    char* V_lds = lds + OFF_V; char* K_lds = lds + OFF_K; char* KR_lds = lds + OFF_KR;
    float* ws = (float*)(lds + OFF_WS) + wid * 64; float* li_l = ws, * al_l = ws + 32;
    float m_reg = -1e30f, l_reg = 0; f32x16 o[4] = {};
    const int sr = tid >> 4, sc = (tid & 15) * 8, vst0 = v_st(sr, sc), vst1 = v_st(32 + sr, sc), kws = KSWZ(sr, sc * 2);
    const int krr = tid >> 3, krc = (tid & 7) * 8, krws = KRSWZ(krr, krc * 2);
    const int vb0 = (int)(uintptr_t)V_lds + v_rd_base(lane);
    const bf16* Kh = cur.K; const bf16* Vh = cur.V;
    unsigned selmask = 0u; float slopeP = 0.f;
    if constexpr (MODE == 0) {
        { const int e_ = cur.h + 1; slopeP = __builtin_ldexpf((e_ & 1) ? 0.70710678118654752f : 1.0f, -(e_ >> 1)) * (1.0f / SCALE); }
        { const int row = tid >> 4, c8 = (tid & 15) * 8; const float* src = G.kmean + (size_t)row * 2048 + cur.h * 128 + c8;
          const f32x4 a = *(const f32x4*)src * (1.0f / 256.0f), b = *(const f32x4*)(src + 4) * (1.0f / 256.0f);
          *(bf16x8*)(lds + OFF_KM + KSWZ(row, c8 * 2)) = pack8(a, b); }
        __syncthreads();
        f32x16 g = {};
#pragma unroll
        for (int d0 = 0; d0 < 8; ++d0) { const bf16x8 kf = *reinterpret_cast<const bf16x8*>(lds + OFF_KM + KSWZ(r32, (d0 * 16 + hi * 8) * 2)); g = __builtin_amdgcn_mfma_f32_32x32x16_bf16(kf, S.qr[d0], g, 0, 0, 0); }
        const int qb = cur.P0 >> 8; const float NEG = -__builtin_inff();
        float gv[16];
#pragma unroll
        for (int r = 0; r < 16; ++r) gv[r] = (crow(r, hi) < qb) ? g[r] : NEG;
        float a1 = NEG, a2 = NEG, a3 = NEG;
#pragma unroll
        for (int r = 0; r < 16; ++r) a1 = fmaxf(a1, gv[r]);
#pragma unroll
        for (int r = 0; r < 16; ++r) a2 = fmaxf(a2, gv[r] < a1 ? gv[r] : NEG);
#pragma unroll
        for (int r = 0; r < 16; ++r) a3 = fmaxf(a3, gv[r] < a2 ? gv[r] : NEG);
        const float b1 = __shfl_xor(a1, 32), b2 = __shfl_xor(a2, 32), b3 = __shfl_xor(a3, 32);
        const float T = fmaxf(fmaxf(a3, b3), fmaxf(fminf(a2, b1), fminf(a1, b2)));
        unsigned msk = 0u;
#pragma unroll
        for (int r = 0; r < 16; ++r) if (gv[r] >= T && crow(r, hi) < qb) msk |= 1u << crow(r, hi);
        selmask = msk | (unsigned)__shfl_xor((int)msk, 32);
    }
#define RESC(a) do { if (__any((a) < 1.f)) { if (hi == 0) al_l[r32] = (a); asm volatile("s_waitcnt lgkmcnt(0)" ::: "memory");              \
                     for (int d_ = 0; d_ < 4; ++d_) for (int r = 0; r < 16; ++r) o[d_][r] *= al_l[crow(r, hi)]; } } while (0)
#define KBASE(t) ((t) * KVBLK)
#define TB(t) (slopeP * (float)(KBASE(t) - cur.P0 + 4 * hi))
#define MASKT(P0_, P1_, t) do { const int kb_ = KBASE(t);                                                                                     \
        if (MODE == 0 && kb_ < cur.P0) { if (!((selmask >> (kb_ >> 8)) & 1u)) { const float NEG_ = -__builtin_inff();                        \
                _Pragma("unroll") for (int r = 0; r < 16; ++r) { P0_[r] = NEG_; P1_[r] = NEG_; } } }                                          \
        else if (kb_ + KVBLK - 1 > qlo) mask_tile(P0_, P1_, qm - kb_); } while (0)
    f32x16 p0, p1; float mn, al; bf16x8 pa0, pa1, pa2, pa3;
#define TILE(t, B) do {                                                                                                       \
        const bool lastt_ = (t) + 1 >= NT;                                                                                    \
        if (!lastt_) { SLOAD_H(Kh, Vh, KBASE((t) + 1)); } else { SLOAD_H(nxt.K, nxt.V, 0); }                                  \
        SBAR(); qkt<MODE, B>(p0, p1, K_lds, KR_lds, r32, hi, S.qr, slopeP, TB(t)); SBAR();                                    \
        if (lastt_) { QLOAD(S, nxt); SBAR(); }                                                                                \
        MASKT(p0, p1, (t)); partialSM<MODE>(p0, p1, m_reg, mn, al); RESC(al);                                                 \
        finishSM(p0, p1, al, l_reg, pa0, pa1, pa2, pa3); SBAR();                                                              \
        pv_tile<B>(o, vb0, pa0, pa1, pa2, pa3); SBAR();                                                                       \
        SWRITE_H((B) ^ 1);                                                                                                    \
        __syncthreads(); } while (0)
    for (int t = 0; t < NT; t += 2) { TILE(t, 0); TILE(t + 1, 1); }
    if (hi == 0) li_l[r32] = l_reg; asm volatile("s_waitcnt lgkmcnt(0)" ::: "memory");
    float rli[16];
#pragma unroll
    for (int r = 0; r < 16; ++r) rli[r] = __builtin_amdgcn_rcpf(li_l[crow(r, hi)]);
#pragma unroll
    for (int r = 0; r < 16; ++r)
#pragma unroll
        for (int d0 = 0; d0 < 4; ++d0) o[d0][r] *= rli[r];
    store_o_rows(o, lds + (wid < 4 ? OFF_V + SHM_V + wid * 4096 : OFF_K + SHM_K + (wid - 4) * 4096), cur.O + (size_t)(wid * QBLK) * RS, RS, lane, r32, hi);
    __syncthreads();
#undef RESC
#undef KBASE
#undef TB
#undef MASKT
#undef TILE
}
#undef ROW
#undef VMW
#undef VMWN
#undef SLOAD_H
#undef SWRITE_HK
#undef SWRITE_HV
#undef SWRITE_H
#undef QLOAD

__device__ __forceinline__ BlockRef mkref(const bf16* Q, const bf16* QRp, const bf16* K, const bf16* V, bf16* O, int L_, int pass) {
    const int xcd = L_ & 7, k = L_ >> 3, h = 2 * xcd + (k >> 4), s = k & 15, qb = pass ? 31 - s : s;
    BlockRef r; r.Q = Q + (size_t)qb * QB * RS + h * 128; r.QR = QRp + (size_t)qb * QB * RS_QR + h * 64; r.K = K + h * 128; r.V = V + h * 128; r.O = O + (size_t)qb * QB * RS + h * 128; r.P0 = qb * QB; r.h = h; return r;
}
template <int MODE>
__device__ __forceinline__ void attn_phase(char* lds, const bf16* Q, const bf16* QRp, const bf16* K, const bf16* V, bf16* O, const Shared& G) {
    const int total = 256, stride = gridDim.x;
    int L = blockIdx.x; if (L >= total) return;
    int pass = 0; BlockRef cur = mkref(Q, QRp, K, V, O, L, 0);
    Seam<MODE> S;
    attn_prime<MODE>(cur, G, lds, S);
    for (;;) {
        const bool more_pass = pass == 0, more_item = L + stride < total, last = !more_pass && !more_item;
        int passn = pass + 1, Ln = L;
        if (!more_pass) { passn = 0; Ln = more_item ? L + stride : L; }
        const BlockRef nxt = last ? cur : mkref(Q, QRp, K, V, O, Ln, passn);
        attn_block<MODE>(cur, nxt, G, lds, S);
        if (last) break;
        cur = nxt; pass = passn; L = Ln;
    }
}
struct MobaBufs { unsigned* cnt; unsigned short* list; bf16* po; float* pml; };
constexpr int OFF_SCAN = OFF_KM;
constexpr int OFF_X = OFF_KM + 4096;

__device__ __forceinline__ unsigned moba_top3(const f32x16& g, int qb, int hi) {
    const float NEG = -__builtin_inff(); int hi_g = hi; asm volatile("" : "+v"(hi_g));
    float gv[16];
#pragma unroll
    for (int r = 0; r < 16; ++r) gv[r] = (crow(r, hi_g) < qb) ? g[r] : NEG;
    float a1 = NEG, a2 = NEG, a3 = NEG;
#pragma unroll
    for (int r = 0; r < 16; ++r) a1 = fmaxf(a1, gv[r]);
#pragma unroll
    for (int r = 0; r < 16; ++r) a2 = fmaxf(a2, gv[r] < a1 ? gv[r] : NEG);
#pragma unroll
    for (int r = 0; r < 16; ++r) a3 = fmaxf(a3, gv[r] < a2 ? gv[r] : NEG);
    const float b1 = __shfl_xor(a1, 32), b2 = __shfl_xor(a2, 32), b3 = __shfl_xor(a3, 32);
    const float T = fmaxf(fmaxf(a3, b3), fmaxf(fminf(a2, b1), fminf(a1, b2)));
    unsigned msk = 0u;
#pragma unroll
    for (int r = 0; r < 16; ++r) if (gv[r] >= T && crow(r, hi_g) < qb) msk |= 1u << crow(r, hi_g);
    return msk | (unsigned)__shfl_xor((int)msk, 32);
}
__device__ __forceinline__ void moba_gate_phase(char* lds, const bf16* Q, const float* kmean, const MobaBufs& B) {
    int tid_ = threadIdx.x; asm volatile("" : "+v"(tid_));
    const int tid = tid_, wid = __builtin_amdgcn_readfirstlane(tid >> 6), lane = tid & 63, r32 = lane & 31, hi = lane >> 5;
    for (int item = blockIdx.x; item < 512; item += gridDim.x) {
        const int h = item >> 5, qb = item & 31;
        { const int row = tid >> 4, c8 = (tid & 15) * 8; const float* src = kmean + (size_t)row * 2048 + h * 128 + c8;
          const f32x4 a = *(const f32x4*)src * (1.0f / 256.0f), b = *(const f32x4*)(src + 4) * (1.0f / 256.0f);
          *(bf16x8*)(lds + OFF_KM + KSWZ(row, c8 * 2)) = pack8(a, b); }
        __syncthreads();
        const int q = qb * QB + wid * QBLK + r32; const bf16* Qw = Q + (size_t)q * RS + h * 128;
        f32x16 g = {};
#pragma unroll
        for (int d0 = 0; d0 < 8; ++d0) { const bf16x8 kf = *reinterpret_cast<const bf16x8*>(lds + OFF_KM + KSWZ(r32, (d0 * 16 + hi * 8) * 2)); g = __builtin_amdgcn_mfma_f32_32x32x16_bf16(kf, load8(Qw + d0 * 16 + hi * 8), g, 0, 0, 0); }
        const unsigned m = moba_top3(g, qb, hi);
        unsigned* lcnt = (unsigned*)(lds + OFF_WS); unsigned* gbase = lcnt + 32;
        if (tid < 32) lcnt[tid] = 0u;
        __syncthreads();
        unsigned pk[3] = {0u, 0u, 0u}; int npk = 0;
        if (hi == 0) { unsigned mm = m;
#pragma unroll
            for (int jj = 0; jj < 3; ++jj) if (mm) { const int n = __builtin_ctz(mm); mm &= mm - 1u; const unsigned lr = __hip_atomic_fetch_add(lcnt + n, 1u, __ATOMIC_RELAXED, __HIP_MEMORY_SCOPE_WORKGROUP); pk[jj] = (unsigned)n | (lr << 8); npk = jj + 1; } }
        __syncthreads();
        if (tid < 32) { const unsigned c = lcnt[tid]; gbase[tid] = c ? __hip_atomic_fetch_add(B.cnt + h * 32 + tid, c, __ATOMIC_RELAXED, __HIP_MEMORY_SCOPE_AGENT) : 0u; }
        __syncthreads();
        if (hi == 0) {
            float* pm = B.pml + ((size_t)(h * 8192 + q) * 3) * 2;
            float ninf_ = -1e30f, zero_ = 0.f; asm volatile("" : "+v"(ninf_), "+v"(zero_));
#pragma unroll
            for (int jj = 0; jj < 3; ++jj) { pm[2 * jj] = ninf_; pm[2 * jj + 1] = zero_; }
#pragma unroll
            for (int jj = 0; jj < 3; ++jj) if (jj < npk) { const int n = pk[jj] & 31u; B.list[(size_t)(h * 32 + n) * 8192 + gbase[n] + (pk[jj] >> 8)] = (unsigned short)(q | (jj << 13)); }
        }
        __syncthreads();
    }
}
template <bool CAUSAL>
__device__ __forceinline__ void moba_blk4(char* lds, const bf16* Kb, const bf16* Vb, const bf16x8* qr, float slopeP, int kabs0, int qpos, int qlo, float& m_reg, float& l_reg, f32x16* o,
                                          int tid, int wid, int lane, int r32, int hi, bool act = true) {
    char* V_lds = lds + OFF_V; char* K_lds = lds + OFF_K; float* al_l = (float*)(lds + OFF_WS) + wid * 64 + 32;
    const int sr = tid >> 4, sc = (tid & 15) * 8, vst0 = v_st(sr, sc), vst1 = v_st(32 + sr, sc), kws = KSWZ(sr, sc * 2);
    const unsigned soff0 = (unsigned)(sr * RS + sc), soff1 = soff0 + 32u * RS;
    const int vb0 = (int)(uintptr_t)V_lds + v_rd_base(lane);
    const float tb0 = slopeP * (float)(kabs0 + 4 * hi - qpos); const int qm = qpos - 4 * hi;
    bf16x8 st_v0, st_v1, st_k0, st_k1; f32x16 p0, p1; float mn, al; bf16x8 pa0, pa1, pa2, pa3;
#define LOADT(t) do { const bf16* kb_ = Kb + (size_t)((t) * KVBLK) * RS; const bf16* vb_ = Vb + (size_t)((t) * KVBLK) * RS; st_v0 = load8(vb_ + soff0); st_v1 = load8(vb_ + soff1); st_k0 = load8(kb_ + soff0); st_k1 = load8(kb_ + soff1); } while (0)
#define WRITET(bf) do { *(bf16x8*)(V_lds + (bf) * SHM_V + vst0) = st_v0; *(bf16x8*)(V_lds + (bf) * SHM_V + vst1) = st_v1; *(bf16x8*)(K_lds + (bf) * SHM_K + kws) = st_k0; *(bf16x8*)(K_lds + (bf) * SHM_K + kws + 32 * 256) = st_k1; } while (0)
#define RESC4(a) do { if (__any((a) < 1.f)) { if (hi == 0) al_l[r32] = (a); asm volatile("s_waitcnt lgkmcnt(0)" ::: "memory"); int hi_r = hi; asm volatile("" : "+v"(hi_r));   \
                      for (int d_ = 0; d_ < 4; ++d_) for (int r = 0; r < 16; ++r) o[d_][r] *= al_l[crow(r, hi_r)]; } } while (0)
#define T4(t, Bf) do { if ((t) < 3) LOADT((t) + 1);                                                                                           \
        if (act) {                                                                                                                            \
        SBAR(); qkt<0, Bf>(p0, p1, K_lds, K_lds, r32, hi, qr, slopeP, tb0 + slopeP * (float)((t) * KVBLK)); SBAR();                           \
        if (CAUSAL) { const int kb_ = kabs0 + (t) * KVBLK; if (kb_ + KVBLK - 1 > qlo) mask_tile(p0, p1, qm - kb_); }                          \
        partialSM<0, true>(p0, p1, m_reg, mn, al); RESC4(al); finishSM(p0, p1, al, l_reg, pa0, pa1, pa2, pa3); SBAR();                              \
        pv_tile<Bf>(o, vb0, pa0, pa1, pa2, pa3); SBAR(); }                                                                                    \
        if ((t) < 3) WRITET((Bf) ^ 1);                                                                                                        \
        __syncthreads(); } while (0)
    LOADT(0); WRITET(0); __syncthreads();
    T4(0, 0); T4(1, 1); T4(2, 0); T4(3, 1);
#undef LOADT
#undef WRITET
#undef RESC4
#undef T4
}
__device__ __forceinline__ float moba_slope(int h) { const int e_ = h + 1; return __builtin_ldexpf((e_ & 1) ? 0.70710678118654752f : 1.0f, -(e_ >> 1)) * (1.0f / Cfg<0>::SCALE); }
__device__ __forceinline__ void moba_sel_phase(char* lds, const bf16* Q, const bf16* K, const bf16* V, const MobaBufs& B) {
    int tid_ = threadIdx.x; asm volatile("" : "+v"(tid_));
    const int tid = tid_, wid = __builtin_amdgcn_readfirstlane(tid >> 6), lane = tid & 63, r32 = lane & 31, hi = lane >> 5;
    unsigned* pre = (unsigned*)(lds + OFF_SCAN);
    { unsigned v = (B.cnt[tid] + 255u) >> 8;
#pragma unroll
      for (int o_ = 1; o_ < 64; o_ <<= 1) { const unsigned t = (unsigned)__shfl_up((int)v, o_); if (lane >= o_) v += t; }
      if (lane == 63) pre[512 + wid] = v;
      __syncthreads();
      unsigned off = 0u;
#pragma unroll
      for (int w = 0; w < 8; ++w) off += (w < wid) ? pre[512 + w] : 0u;
      pre[tid] = v + off; __syncthreads(); }
    const unsigned U = pre[511];
    float* ws = (float*)(lds + OFF_WS) + wid * 64; float* li_l = ws; unsigned* ent_l = (unsigned*)(lds + OFF_X) + wid * 64;
    const unsigned gsz_ = gridDim.x, vb_ = (gsz_ & 7u) ? blockIdx.x : (blockIdx.x & 7u) * (gsz_ >> 3) + (blockIdx.x >> 3);
    for (unsigned u = vb_; u < U; u += gsz_) {
        int lo_ = 0, hi_ = 511; while (lo_ < hi_) { const int mid = (lo_ + hi_) >> 1; if (pre[mid] > u) hi_ = mid; else lo_ = mid + 1; }
        const int b = __builtin_amdgcn_readfirstlane(lo_), h = b >> 5, n = b & 31, slice = (int)(u - (b ? pre[b - 1] : 0u));
        const int cntb = (int)B.cnt[b]; int valid = cntb - slice * 256; if (valid > 256) valid = 256;
        const int e = wid * QBLK + r32; const unsigned ent = B.list[(size_t)b * 8192 + slice * 256 + (e < valid ? e : valid - 1)];
        const int q = ent & 8191; const bool rowvalid = e < valid;
        bf16x8 qr[8];
#pragma unroll
        for (int d0 = 0; d0 < 8; ++d0) qr[d0] = load8(Q + (size_t)q * RS + h * 128 + d0 * 16 + hi * 8);
        float m_reg = -1e30f, l_reg = 0.f; f32x16 o[4] = {};
        moba_blk4<false>(lds, K + (size_t)(n * 256) * RS + h * 128, V + (size_t)(n * 256) * RS + h * 128, qr, moba_slope(h), n * 256, q, 0, m_reg, l_reg, o, tid, wid, lane, r32, hi, wid * QBLK < valid);
        if (hi == 0) { li_l[r32] = l_reg; ent_l[r32] = ent | (rowvalid ? 0x8000u : 0u); } asm volatile("s_waitcnt lgkmcnt(0)" ::: "memory");
        int hi_e = hi; asm volatile("" : "+v"(hi_e));
#pragma unroll
        for (int r = 0; r < 16; ++r) { const int row = crow(r, hi_e); const float rl = __builtin_amdgcn_rcpf(li_l[row]); const unsigned er = ent_l[row];
            bf16* pb = B.po + ((size_t)(h * 8192 + (int)(er & 8191u)) * 3 + ((er >> 13) & 3u)) * 128;
            typedef unsigned u32x2 __attribute__((ext_vector_type(2)));
            const u32x2 w = {cvtpk(o[0][r] * rl, o[1][r] * rl), cvtpk(o[2][r] * rl, o[3][r] * rl)};
            if (er & 0x8000u) __builtin_nontemporal_store(w, (u32x2*)(pb + r32 * 4)); }
        if (hi == 0 && rowvalid) { float* pm = B.pml + ((size_t)(h * 8192 + q) * 3 + (ent >> 13)) * 2; pm[0] = m_reg; pm[1] = l_reg; }
    }
}
__device__ __forceinline__ void moba_own_phase(char* lds, const bf16* Q, const bf16* K, const bf16* V, bf16* O, const MobaBufs& B) {
    int tid_ = threadIdx.x; asm volatile("" : "+v"(tid_));
    const int tid = tid_, wid = __builtin_amdgcn_readfirstlane(tid >> 6), lane = tid & 63, r32 = lane & 31, hi = lane >> 5;
    constexpr float C2 = 1.4426950408889634f * Cfg<0>::SCALE;
    float* ws = (float*)(lds + OFF_WS) + wid * 64; float* li_l = ws; float* mi_l = (float*)(lds + OFF_X) + wid * 64;
    for (int item = blockIdx.x; item < 512; item += gridDim.x) {
        const int xcd = item & 7, k_ = item >> 3, h = 2 * xcd + (k_ >> 5), qb = k_ & 31, P0 = qb * QB, qpos = P0 + wid * QBLK + r32;
        bf16x8 qr[8];
#pragma unroll
        for (int d0 = 0; d0 < 8; ++d0) qr[d0] = load8(Q + (size_t)qpos * RS + h * 128 + d0 * 16 + hi * 8);
        float m_reg = -1e30f, l_reg = 0.f; f32x16 o[4] = {};
        moba_blk4<true>(lds, K + (size_t)P0 * RS + h * 128, V + (size_t)P0 * RS + h * 128, qr, moba_slope(h), P0, qpos, P0 + wid * QBLK, m_reg, l_reg, o, tid, wid, lane, r32, hi);
        if (hi == 0) { li_l[r32] = l_reg; mi_l[r32] = m_reg; } asm volatile("s_waitcnt lgkmcnt(0)" ::: "memory");
        int hi_e = hi; asm volatile("" : "+v"(hi_e));
        bf16* Ow = O + (size_t)(P0 + wid * QBLK) * RS + h * 128;
#pragma unroll
        for (int r = 0; r < 16; ++r) { const int row = crow(r, hi_e); const float l0 = li_l[row], m0 = mi_l[row];
            const size_t slot0 = (size_t)(h * 8192 + P0 + wid * QBLK + row) * 3; const float* pm = B.pml + slot0 * 2;
            const float m1 = pm[0], l1 = pm[1], m2 = pm[2], l2 = pm[3], m3 = pm[4], l3 = pm[5];
            const float M = fmaxf(fmaxf(m0, m1), fmaxf(m2, m3));
            const float e0 = __builtin_amdgcn_exp2f((m0 - M) * C2), e1 = l1 * __builtin_amdgcn_exp2f((m1 - M) * C2), e2 = l2 * __builtin_amdgcn_exp2f((m2 - M) * C2), e3 = l3 * __builtin_amdgcn_exp2f((m3 - M) * C2);
            const float rden = __builtin_amdgcn_rcpf(e0 * l0 + e1 + e2 + e3);
            typedef unsigned u32x2 __attribute__((ext_vector_type(2)));
            const u32x2* pb = (const u32x2*)(B.po + slot0 * 128) + r32;
            const u32x2 w1 = __builtin_nontemporal_load(pb), w2 = __builtin_nontemporal_load(pb + 32), w3 = __builtin_nontemporal_load(pb + 64);
            const float z1 = l1 > 0.f ? e1 : 0.f, z2 = l2 > 0.f ? e2 : 0.f, z3 = l3 > 0.f ? e3 : 0.f;
            const unsigned k1 = l1 > 0.f ? 0xffffffffu : 0u, k2 = l2 > 0.f ? 0xffffffffu : 0u, k3 = l3 > 0.f ? 0xffffffffu : 0u;
            float val[4];
#pragma unroll
            for (int d0 = 0; d0 < 4; ++d0) { float a = e0 * o[d0][r];
                const unsigned a1 = (d0 < 2 ? w1.x : w1.y) & k1, a2 = (d0 < 2 ? w2.x : w2.y) & k2, a3 = (d0 < 2 ? w3.x : w3.y) & k3;
                const float x1 = __uint_as_float((d0 & 1) ? (a1 & 0xffff0000u) : (a1 << 16)), x2 = __uint_as_float((d0 & 1) ? (a2 & 0xffff0000u) : (a2 << 16)), x3 = __uint_as_float((d0 & 1) ? (a3 & 0xffff0000u) : (a3 << 16));
                a = fmaf(z1, x1, a); a = fmaf(z2, x2, a); a = fmaf(z3, x3, a); val[d0] = a * rden; }
#pragma unroll
            for (int d0 = 0; d0 < 4; ++d0) o[d0][r] = val[d0]; }
        store_o_rows(o, lds + (wid < 4 ? OFF_V + SHM_V + wid * 4096 : OFF_K + SHM_K + (wid - 4) * 4096), Ow, RS, lane, r32, hi);
    }
}
#undef KSWZ
#undef KRSWZ
#undef SBAR
}
#define GAS __attribute__((address_space(1)))
#define LAS __attribute__((address_space(3)))
typedef unsigned short bf16;
typedef unsigned v4u __attribute__((ext_vector_type(4)));
typedef float f32x4 __attribute__((ext_vector_type(4)));
typedef short bf16x8 __attribute__((ext_vector_type(8)));
typedef GAS unsigned gu32;
typedef GAS unsigned long long gu64;
#define RLX_AGENT __ATOMIC_RELAXED, __HIP_MEMORY_SCOPE_AGENT
#define LDS_WAIT() asm volatile("s_waitcnt lgkmcnt(0)" ::: "memory")
#define VM_WAIT() asm volatile("s_waitcnt vmcnt(0)" ::: "memory")
__device__ __forceinline__ unsigned long long rt() { return __builtin_amdgcn_s_memrealtime(); }
__device__ __forceinline__ unsigned f2bf(float f) { unsigned u = __builtin_bit_cast(unsigned, f); return (u + 0x7fffu + ((u >> 16) & 1u)) >> 16; }
__device__ __forceinline__ unsigned pk2(float lo, float hi) { return f2bf(lo) | (f2bf(hi) << 16); }

#define XB_TMO      128
#define XB_XCNT(j)  (256  + 64 * (j))
#define XB_XSUB(j)  (1280 + 64 * (j))
#define XB_XGEN(j)  (2304 + 64 * (j))
#define XB_TOP      3328
#define XB_TOPGEN   3392
#define XCD_BAR_WORDS 3456
#define XB_SPIN_CAP (1u << 18)

__device__ __forceinline__ unsigned xb_ld(unsigned* p)              { return __hip_atomic_load(p, __ATOMIC_RELAXED, __HIP_MEMORY_SCOPE_AGENT); }
__device__ __forceinline__ unsigned xb_add(unsigned* p, unsigned v) { return __hip_atomic_fetch_add(p, v, __ATOMIC_RELAXED, __HIP_MEMORY_SCOPE_AGENT); }
__device__ __forceinline__ unsigned xb_xcc_id() { return (unsigned)__builtin_amdgcn_s_getreg((3 << 11) | 20) & 0xFu; }
#define XB_SPIN(cond, bar) do { unsigned _sp = 0; while (cond) { __builtin_amdgcn_s_sleep(1); \
    if ((++_sp & 255u) == 0u) { if (xb_ld(&(bar)[XB_TMO])) break; if (_sp > XB_SPIN_CAP) { atomicAdd(&(bar)[XB_TMO], 1u); break; } } } } while (0)

struct XcdBarrier {
    unsigned* bar; unsigned x;
    volatile LAS unsigned* st;
};

__device__ __forceinline__ XcdBarrier xcd_barrier_post(unsigned* bar, volatile LAS unsigned* st) {
    XcdBarrier b; b.bar = bar; b.x = xb_xcc_id(); b.st = st;
    if (threadIdx.x == 0) (void)xb_add(&bar[XB_XCNT(b.x)], 1u);
    return b;
}
__device__ __forceinline__ void xcd_barrier_complete(unsigned* bar, unsigned x, unsigned& nloc, unsigned& nx) {
    const unsigned G = gridDim.x * gridDim.y * gridDim.z;
    unsigned sum, cnt, mine, sp = 0u;
    for (;;) {
        sum = 0u; cnt = 0u; mine = 0u;
#pragma unroll
        for (unsigned j = 0; j < 16; ++j) { const unsigned c = xb_ld(&bar[XB_XCNT(j)]); sum += c; cnt += (c > 0u) ? 1u : 0u; mine = (j == x) ? c : mine; }
        if (sum == G) break;
        __builtin_amdgcn_s_sleep(1);
        if ((++sp & 255u) == 0u) { if (xb_ld(&bar[XB_TMO])) break; if (sp > XB_SPIN_CAP) { atomicAdd(&bar[XB_TMO], 1u); break; } }
    }
    nloc = mine > 0u ? mine : 1u; nx = cnt > 0u ? cnt : 1u;
}

__device__ __forceinline__ void xcd_barrier(const XcdBarrier& b) {
    asm volatile("s_waitcnt vmcnt(0)" ::: "memory");
    __syncthreads();
    if (threadIdx.x == 0) {
        unsigned* bar = b.bar;
        __builtin_amdgcn_s_waitcnt(0);
        unsigned nloc = b.st[0], nx = b.st[1];
        if (nloc == 0u) { xcd_barrier_complete(bar, b.x, nloc, nx); b.st[0] = nloc; b.st[1] = nx; }
        const unsigned old = xb_add(&bar[XB_XSUB(b.x)], 1u);
        const unsigned gen = old / nloc;
        if (old + 1u == (gen + 1u) * nloc) {
            __builtin_amdgcn_fence(__ATOMIC_RELEASE, "agent");
            asm volatile("s_waitcnt vmcnt(0)" ::: "memory");
            const unsigned og = xb_add(&bar[XB_TOP], 1u);
            const unsigned tg = og / nx;
            if (og + 1u == (tg + 1u) * nx) xb_add(&bar[XB_TOPGEN], 1u);
            else XB_SPIN(xb_ld(&bar[XB_TOPGEN]) == tg, bar);
            __builtin_amdgcn_fence(__ATOMIC_ACQUIRE, "agent");
            xb_add(&bar[XB_XGEN(b.x)], 1u);
            asm volatile("s_waitcnt vmcnt(0)" ::: "memory");
        } else {
            XB_SPIN(xb_ld(&bar[XB_XGEN(b.x)]) == gen, bar);
            __builtin_amdgcn_fence(__ATOMIC_ACQUIRE, "agent");
            asm volatile("s_waitcnt vmcnt(0)" ::: "memory");
        }
    }
    __syncthreads();
}
constexpr int NWAVES = 8;
#ifndef CONV_WAVES
#define CONV_WAVES 2
#endif
#ifndef FUSED_QUANT
#define FUSED_QUANT 1
#endif
#ifndef PROBE_REP
#define PROBE_REP 0
#endif
#define REPS(k) _Pragma("unroll 1") for (int rep_ = 0; rep_ < (PROBE_REP == (k) ? 2 : 1); ++rep_)
#ifndef MK_MULTI
#define MK_MULTI 0
#endif
#ifndef MOBA_GATHER
#define MOBA_GATHER 1
#endif
constexpr int SEQ = 8192, DM = 2048, FF = 5632, NPHASES = MOBA_GATHER ? 45 : 41;
constexpr size_t MiB = 1u << 20;
constexpr size_t WS_CTL = 0, WS_KMEAN = 1 * MiB, ZERO_BYTES = 2 * MiB;
constexpr size_t WS_SSQ = 2 * MiB, WS_SSQ_CQ = 3 * MiB, WS_SSQ_CKV = 4 * MiB, WS_COS = 5 * MiB, WS_SIN = 6 * MiB;
constexpr size_t WS_HB = 8 * MiB, WS_HID = 40 * MiB, WS_Q = 128 * MiB, WS_K = 160 * MiB, WS_V = 192 * MiB, WS_O = 224 * MiB, WS_QR = 256 * MiB, WS_KR = 272 * MiB, WS_CKV = 273 * MiB, WS_CQ = 281 * MiB;
constexpr size_t WS_FFN = 296 * MiB, FFN_SLOT = 69 * MiB, FFN_WD = 47 * MiB;
constexpr size_t WS_WQKV = 848 * MiB, WS_WO = 896 * MiB, WS_WUKV = 928 * MiB, WS_WDQ = 932 * MiB, WS_WUQ = 938 * MiB, WS_PO = 948 * MiB, WS_PML = 1044 * MiB, WS_LIST = 1048 * MiB, WS_END = 1056 * MiB;
constexpr size_t WS_AQ = 1056 * MiB, WS_ASC = 1072 * MiB, WS_AMX = 1073 * MiB, WS_END2 = 1074 * MiB;
static_assert((long)WS_AMX == pg8::EpiRes::QF_AMX && (long)WS_ASC == pg8::EpiRes::QF_ASC && (long)WS_AQ == pg8::EpiRes::QF_AQ && (long)WS_HB == pg8::EpiRes::QF_HB && (long)WS_SSQ == pg8::EpiRes::QF_SSQ && WS_CTL == 0, "fused quantisation offsets");
constexpr size_t WS_WAMAX = 256 * 1024;
constexpr size_t WS_MCNT = WS_KMEAN + 768 * 1024;
constexpr int CW_BAR = 4096, CW_CONV = 8192, CW_STRIP = 8256, CW_PCNT = 8448  ;
static_assert(CW_PCNT == pg8::EpiRes::QF_PCNT && CW_BAR + XB_TMO == pg8::EpiRes::QF_TMO && CW_PCNT + 32 * 16 <= 65536, "fused quantisation control words");
static_assert(WS_V - WS_K == WS_K - WS_Q, "q | k | v equally spaced");
constexpr int RING_OFF = 0, RING_BYTES = 131072, LDSCTL_OFF = RING_BYTES, MISC_OFF = LDSCTL_OFF + 320, RSTD_OFF = RING_BYTES + 1024, WTAB_OFF = RSTD_OFF + 8192, LDS_BYTES = 147456;
static_assert(att::LDS_BYTES <= RING_BYTES && MISC_OFF + 128 <= RSTD_OFF && WTAB_OFF + 6144 <= LDS_BYTES, "LDS map");

__device__ __forceinline__ float wave_sum(float v) {
#pragma unroll
    for (int o = 1; o < 64; o <<= 1) v += __shfl_xor(v, o);
    return v;
}
__device__ __forceinline__ int conv_src_col(int kind, int n0) {
    if (kind == 0) return n0;
    if (kind == 1) { const int pn = n0 >> 8, bj = (n0 >> 7) & 1, j = n0 & 127; return bj * FF + pn * 128 + j; }
    if (kind == 2) { if (n0 < 2048) { const int pn = n0 >> 8, hh = (n0 >> 7) & 1, j = n0 & 127; return (2 * pn + hh) * 192 + j; }
                     const int r = n0 - 2048, t = r >> 8, bj = (r >> 7) & 1, hh = (r >> 5) & 3; return (4 * t + hh) * 192 + 128 + 32 * bj; }
    if (n0 < 512) return n0; if (n0 == 512) return 512; if (n0 == 640) return 544; return -1;
}
__device__ __forceinline__ void conv_tile(const float* __restrict__ W, int K, int srcN, int N, const float* __restrict__ gain, bf16* __restrict__ WT, int kind, LAS unsigned char* wl, int lane, int it, const unsigned* __restrict__ wamax) {
    const int ngrp = N / 64, nkc = K / 128, c = lane & 15, q = lane >> 4;
    const int gs = (ngrp & 7) ? 4 : 8, g8 = it / gs, w8 = it - g8 * gs, b = g8 / nkc, kc = g8 - b * nkc, ng = ((b + kc) % (ngrp / gs)) * gs + w8;
    const int nd = ng * 64 + 4 * c, scg = conv_src_col(kind, nd & ~31);
    const bool valid = scg >= 0;
    const float* src = W + (size_t)(kc * 128 + 8 * q) * srcN + (valid ? scg + (nd & 31) : 0);
    f32x4 v[4][8], gv[4][2];
    if (gain) {
#pragma unroll
        for (int t = 0; t < 4; ++t) { gv[t][0] = *(const GAS f32x4*)(gain + kc * 128 + 8 * (q + 4 * t)); gv[t][1] = *(const GAS f32x4*)(gain + kc * 128 + 8 * (q + 4 * t) + 4); } }
#pragma unroll
    for (int t = 0; t < 4; ++t)
#pragma unroll
        for (int j = 0; j < 8; ++j) v[t][j] = __builtin_nontemporal_load((const GAS f32x4*)(src + (size_t)(32 * t + j) * srcN));
    if (kind == 3) { const float z = valid ? 1.f : 0.f;
#pragma unroll
        for (int t = 0; t < 4; ++t)
#pragma unroll
            for (int j = 0; j < 8; ++j) v[t][j] = v[t][j] * z; }
    if (gain) {
#pragma unroll
        for (int t = 0; t < 4; ++t) { const f32x4 g0 = gv[t][0], g1 = gv[t][1];
#pragma unroll
            for (int j = 0; j < 4; ++j) { v[t][j] = v[t][j] * g0[j]; v[t][4 + j] = v[t][4 + j] * g1[j]; } } }
    if (wamax) {
        const v4u ab = *(const v4u*)(wamax + nd); f32x4 sc;
#pragma unroll
        for (int i = 0; i < 4; ++i) { const float a = __uint_as_float(ab[i]); sc[i] = a > 0.f ? 127.0f / a : 0.f; }
#pragma unroll
        for (int t = 0; t < 4; ++t) { const int chunk = q + 4 * t;
#pragma unroll
            for (int i = 0; i < 4; ++i) { unsigned lo = 0u, hi2 = 0u;
#pragma unroll
                for (int j = 0; j < 4; ++j) { const int a0 = (int)__builtin_rintf(v[t][j][i] * sc[i]), a1 = (int)__builtin_rintf(v[t][4 + j][i] * sc[i]); lo |= ((unsigned)a0 & 0xffu) << (8 * j); hi2 |= ((unsigned)a1 & 0xffu) << (8 * j); }
                typedef unsigned u32x2 __attribute__((ext_vector_type(2)));
                *(LAS u32x2*)(wl + (4 * c + i) * 128 + 8 * (chunk ^ (2 * (c & 7)))) = (u32x2){lo, hi2}; } }
        LDS_WAIT(); asm volatile("" ::: "memory");
        unsigned char* dst = (unsigned char*)WT + (size_t)(ng * 64 + (lane >> 3)) * K + kc * 128 + 16 * (lane & 7); v4u ov[8];
#pragma unroll
        for (int st = 0; st < 8; ++st) { const int r = (lane >> 3) + 8 * st; ov[st] = *(const LAS v4u*)(wl + r * 128 + 8 * ((2 * (lane & 7)) ^ (2 * ((r >> 2) & 7)))); }
        LDS_WAIT(); asm volatile("" ::: "memory");
#pragma unroll
        for (int st = 0; st < 8; ++st) *(GAS v4u*)(dst + (size_t)(8 * st) * K) = ov[st];
        return;
    }
#pragma unroll
    for (int t = 0; t < 4; ++t) { const int chunk = q + 4 * t;
#pragma unroll
        for (int i = 0; i < 4; ++i) { v4u o; o.x = pg8::cvt_pk_bf16(v[t][0][i], v[t][1][i]); o.y = pg8::cvt_pk_bf16(v[t][2][i], v[t][3][i]); o.z = pg8::cvt_pk_bf16(v[t][4][i], v[t][5][i]); o.w = pg8::cvt_pk_bf16(v[t][6][i], v[t][7][i]);
            *(LAS v4u*)(wl + (4 * c + i) * 256 + 16 * (chunk ^ (c & 7))) = o; } }
    LDS_WAIT(); asm volatile("" ::: "memory");
    bf16* dst = WT + (size_t)(ng * 64 + q) * K + kc * 128 + 8 * c; v4u ov[16];
#pragma unroll
    for (int st = 0; st < 16; ++st) ov[st] = *(const LAS v4u*)(wl + (4 * st + q) * 256 + 16 * (c ^ (st & 7)));
    LDS_WAIT(); asm volatile("" ::: "memory");
#pragma unroll
    for (int st = 0; st < 16; ++st) *(GAS v4u*)(dst + (size_t)(4 * st) * K) = ov[st];
}
constexpr int IT_GU = 0, IT_D = 1408, IT_QKV = 0, IT_O = 512, IT_DKV = 0, IT_UKV = 256, IT_DQ = 192, IT_UQ = 288;
constexpr int IT_LA = 2 * IT_GU + 2 * IT_D + IT_QKV + IT_O;
constexpr int IT_L2 = 2 * IT_GU + 2 * IT_D + IT_DKV + IT_UKV + IT_DQ + IT_UQ + IT_O;
constexpr int IT_L3 = 2 * IT_GU + 2 * IT_D + IT_DQ + IT_UQ + IT_O;
constexpr int IT_B2 = 2 * IT_LA, IT_B3 = IT_B2 + IT_L2, IT_TOTAL = IT_B3 + IT_L3;
static_assert(IT_TOTAL == 40320 - 8 * 2816 - 192 - 2 * 1536, "conversion item count");
__device__ __forceinline__ int req_gu(int f) { const int l = f >> 1, w = f & 1; if (l < 2) return l * IT_LA + (w ? 2 * IT_GU + IT_D + IT_QKV + IT_O : IT_GU);
    if (l == 2) return IT_B2 + (w ? 2 * IT_GU + IT_DKV + IT_D + IT_UKV + IT_DQ + IT_UQ + IT_O : IT_GU + IT_DKV); return IT_B3 + (w ? 2 * IT_GU + IT_D + IT_DQ + IT_UQ + IT_O : IT_GU); }
__device__ __forceinline__ int req_d(int f) { return req_gu(f) + IT_D; }
__device__ __forceinline__ int req_qkv(int l) { return l * IT_LA + IT_GU + IT_D + IT_QKV; }
__device__ __forceinline__ int req_ukv() { return IT_B2 + IT_GU + IT_DKV + IT_D + IT_UKV; }
__device__ __forceinline__ int req_dq(int l) { return l == 2 ? req_ukv() + IT_DQ : IT_B3 + IT_GU + IT_D + IT_DQ; }
__device__ __forceinline__ int req_uq(int l) { return req_dq(l) + IT_UQ; }
__device__ __forceinline__ int req_o(int l) { return l < 2 ? req_qkv(l) + IT_O : req_uq(l) + IT_O; }

__device__ __forceinline__ void rstd_table_fill(LAS float* tab, const float* ssq, int fm, int tid, const float* rowfac = nullptr) {
#pragma unroll
    for (int j = 0; j < 4; ++j) { const int r = tid + 512 * j; float v = pg8::row_rstd<8>(ssq, fm * 256 + r, 1.0f / 2048.0f); if (rowfac) v *= rowfac[fm * 256 + r]; tab[r] = v; }
    __syncthreads();
}
__device__ __forceinline__ void quant_rows(const bf16* HB, signed char* AQ, float* asc, int gw, int NGW, int lane) {
    for (int m0 = gw * 4; m0 < SEQ; m0 += NGW * 4) {
        v4u w[4][4]; float mx[4];
#pragma unroll
        for (int r = 0; r < 4; ++r) { const GAS v4u* hr = (const GAS v4u*)(HB + (size_t)(m0 + r) * DM) + lane;
#pragma unroll
            for (int j = 0; j < 4; ++j) w[r][j] = hr[64 * j]; }
#pragma unroll
        for (int r = 0; r < 4; ++r) { float a = 0.f;
#pragma unroll
            for (int j = 0; j < 4; ++j)
#pragma unroll
                for (int e = 0; e < 4; ++e) { const unsigned u = w[r][j][e]; a = fmaxf(a, fmaxf(fabsf(__uint_as_float(u << 16)), fabsf(__uint_as_float(u & 0xffff0000u)))); }
            mx[r] = a; }
#pragma unroll
        for (int o = 1; o < 64; o <<= 1)
#pragma unroll
            for (int r = 0; r < 4; ++r) mx[r] = fmaxf(mx[r], __shfl_xor(mx[r], o));
#pragma unroll
        for (int r = 0; r < 4; ++r) { const float sc = mx[r] > 0.f ? 127.0f / mx[r] : 0.f;
            if (lane == 0) asc[m0 + r] = mx[r] * (1.0f / 127.0f);
            GAS unsigned long long* qo = (GAS unsigned long long*)(AQ + (size_t)(m0 + r) * DM) + lane;
#pragma unroll
            for (int j = 0; j < 4; ++j) { unsigned long long pk = 0ull;
#pragma unroll
                for (int e = 0; e < 4; ++e) { const unsigned u = w[r][j][e]; const int a0 = (int)__builtin_rintf(__uint_as_float(u << 16) * sc), a1 = (int)__builtin_rintf(__uint_as_float(u & 0xffff0000u) * sc);
                    pk |= (unsigned long long)(((unsigned)a0 & 0xffu) | (((unsigned)a1 & 0xffu) << 8)) << (16 * e); }
                qo[64 * j] = pk; } }
    }
}
__device__ __forceinline__ void wamax_job(const float* __restrict__ W, int srcN, int ncols, const float* __restrict__ gain, int kind, unsigned* __restrict__ amax, int gw, int NGW, int lane, int& rot) {
    const int ngrp = (ncols + 255) / 256, nitems = ngrp * (DM / 64);
    int w0 = gw - rot; if (w0 < 0) w0 += NGW; rot = (rot + nitems) % NGW;
    for (int it = w0; it < nitems; it += NGW) { const int kc = it / ngrp, ng = it - kc * ngrp, col = ng * 256 + 4 * lane;
        f32x4 mx = {0.f, 0.f, 0.f, 0.f};
        if (col >= ncols) continue;
#pragma unroll 8
        for (int j = 0; j < 64; ++j) { const f32x4 v = *(const GAS f32x4*)(W + (size_t)(kc * 64 + j) * srcN + col); const float g = gain[kc * 64 + j];
            mx[0] = fmaxf(mx[0], fabsf(v[0] * g)); mx[1] = fmaxf(mx[1], fabsf(v[1] * g)); mx[2] = fmaxf(mx[2], fabsf(v[2] * g)); mx[3] = fmaxf(mx[3], fabsf(v[3] * g)); }
#pragma unroll
        for (int e = 0; e < 4; ++e) { const int c = col + e; int n;
            if (kind == 1) { const int up = c >= FF, cc = up ? c - FF : c; n = (cc >> 7) * 256 + up * 128 + (cc & 127); } else { n = c < 512 ? c : 512 + ((c - 512) >> 5) * 128 + ((c - 512) & 31); }
            __hip_atomic_fetch_max(amax + n, __float_as_uint(mx[e]), __ATOMIC_RELAXED, __HIP_MEMORY_SCOPE_AGENT); } }
}
__device__ __forceinline__ void conv_strip(const float* __restrict__ W, int srcN, const float* __restrict__ gain, int kind, signed char* __restrict__ WQ, unsigned* __restrict__ wamax, int strip,
                                           LAS unsigned char* tile, LAS unsigned* mx, int tid) {
    const int c16 = tid & 15, kr = tid >> 4, nd = strip * 64 + 4 * c16, scg = conv_src_col(kind, nd & ~31);
    const bool valid = scg >= 0; const float z = valid ? 1.f : 0.f;
    const float* src = W + (size_t)(8 * kr) * srcN + (valid ? scg + (nd & 31) : 0);
    if (tid < 64) mx[tid] = 0u;
    __syncthreads();
    unsigned pk[8][4][4]; f32x4 mxl = {0.f, 0.f, 0.f, 0.f};
#pragma unroll
    for (int t = 0; t < 8; ++t) { f32x4 v[8];
        const f32x4 g0 = *(const GAS f32x4*)(gain + 8 * (kr + 32 * t)), g1 = *(const GAS f32x4*)(gain + 8 * (kr + 32 * t) + 4);
#pragma unroll
        for (int j = 0; j < 8; ++j) v[j] = __builtin_nontemporal_load((const GAS f32x4*)(src + (size_t)(256 * t + j) * srcN));
#pragma unroll
        for (int j = 0; j < 8; ++j) { const float gf = (j < 4 ? g0[j & 3] : g1[j & 3]) * z;
#pragma unroll
            for (int i = 0; i < 4; ++i) { v[j][i] = pg8::smul(v[j][i], gf); mxl[i] = fmaxf(mxl[i], fabsf(v[j][i])); } }
#pragma unroll
        for (int jp = 0; jp < 4; ++jp)
#pragma unroll
            for (int i = 0; i < 4; ++i) pk[t][jp][i] = pg8::cvt_pk_bf16(v[2 * jp][i], v[2 * jp + 1][i]); }
#pragma unroll
    for (int i = 0; i < 4; ++i) __hip_atomic_fetch_max(mx + 4 * c16 + i, __float_as_uint(mxl[i]), __ATOMIC_RELAXED, __HIP_MEMORY_SCOPE_WORKGROUP);
    __syncthreads();
    f32x4 sc;
#pragma unroll
    for (int i = 0; i < 4; ++i) { const float a = __uint_as_float(mx[4 * c16 + i]); sc[i] = a > 0.f ? 127.0f / a : 0.f; }
    if (tid < 64) wamax[strip * 64 + tid] = mx[tid];
#pragma unroll
    for (int t = 0; t < 8; ++t)
#pragma unroll
        for (int i = 0; i < 4; ++i) { unsigned tw[4];
#pragma unroll
            for (int jp = 0; jp < 4; ++jp) { const unsigned u = pk[t][jp][i]; const float f0 = __uint_as_float(u << 16), f1 = __uint_as_float(u & 0xffff0000u), magic = 12582912.0f; unsigned b0, b1;
                asm("v_fma_f32 %0, %1, %2, %3" : "=v"(b0) : "v"(f0), "v"(sc[i]), "v"(magic)); asm("v_fma_f32 %0, %1, %2, %3" : "=v"(b1) : "v"(f1), "v"(sc[i]), "v"(magic));
                tw[jp] = __builtin_amdgcn_perm(b1, b0, 0x0c0c0400u); }
            const unsigned lo = __builtin_amdgcn_perm(tw[1], tw[0], 0x05040100u), hi2 = __builtin_amdgcn_perm(tw[3], tw[2], 0x05040100u);
            typedef unsigned u32x2 __attribute__((ext_vector_type(2)));
            *(LAS u32x2*)(tile + (4 * c16 + i) * 2048 + 8 * ((kr + 32 * t) ^ (2 * c16))) = (u32x2){lo, hi2}; }
    __syncthreads();
#pragma unroll 4
    for (int it = 0; it < 16; ++it) { const int id = it * 512 + tid, row = id >> 7, g = id & 127;
        const v4u o = *(const LAS v4u*)(tile + row * 2048 + 8 * ((2 * g) ^ (2 * ((row >> 2) & 15))));
        *(GAS v4u*)(WQ + (size_t)(strip * 64 + row) * 2048 + 16 * g) = o; }
    __syncthreads();
}
constexpr int ST_GU = 176, ST_DKV = 12, ST_QKV = 96, ST_TOTAL = 8 * ST_GU + ST_DKV + 2 * ST_QKV;
constexpr int SB_GU0 = 0, SB_QKV0 = SB_GU0 + ST_GU, SB_GU1 = SB_QKV0 + ST_QKV, SB_GU2 = SB_GU1 + ST_GU, SB_QKV1 = SB_GU2 + ST_GU, SB_GU3 = SB_QKV1 + ST_QKV, SB_GU4 = SB_GU3 + ST_GU, SB_DKV = SB_GU4 + ST_GU,
              SB_GU5 = SB_DKV + ST_DKV, SB_GU6 = SB_GU5 + ST_GU, SB_GU7 = SB_GU6 + ST_GU;
static_assert(SB_GU7 + ST_GU == ST_TOTAL, "strip list");
__device__ __forceinline__ int req_strip_after_up(int f) { return f == 0 ? SB_GU2 : f == 1 ? SB_QKV1 : f == 2 ? SB_GU4 : f == 3 ? SB_GU5 : f == 4 ? SB_GU6 : f == 5 ? SB_GU7 : ST_TOTAL; }
constexpr int WAMAX_QKV = 8 * 12032;
struct Args { const float* in[19]; float* out; unsigned char* ws; int ph_lo, ph_hi; };
#define WGU(f) ((bf16*)(ws + WS_FFN + (size_t)(f) * FFN_SLOT))
#define WD(f) ((bf16*)(ws + WS_FFN + (size_t)(f) * FFN_SLOT + FFN_WD))
#define WQKV(l) ((bf16*)(ws + WS_WQKV + (size_t)(l) * 24 * MiB))
#define WO(l) ((bf16*)(ws + WS_WO + (size_t)(l) * 8 * MiB))
#define WUKV ((bf16*)(ws + WS_WUKV))
#define WDQ(j) ((bf16*)(ws + WS_WDQ + (size_t)(j) * 3 * MiB))
#define WUQ(j) ((bf16*)(ws + WS_WUQ + (size_t)(j) * 5 * MiB))
__device__ __forceinline__ void conv_item(const Args& args, unsigned char* ws, LAS unsigned char* wl, int lane, int idx) {
    int i = idx, K, sN, N, kind = 0; const float* src; const float* gain = nullptr; bf16* dst; const unsigned* wam = nullptr;
#define SET_GU(f_) do { const int l_ = (f_) >> 1, w_ = (f_) & 1; src = (w_ ? args.in[6] : args.in[2]) + (size_t)l_ * DM * 2 * FF; gain = (w_ ? args.in[5] : args.in[1]) + l_ * DM; dst = WGU(f_); K = DM; sN = 2 * FF; N = 2 * FF; kind = 1; wam = (const unsigned*)(ws + WS_WAMAX) + (f_) * 12032; } while (0)
#define SET_D(f_) do { const int l_ = (f_) >> 1, w_ = (f_) & 1; src = (w_ ? args.in[7] : args.in[3]) + (size_t)l_ * FF * DM; dst = WD(f_); K = FF; sN = DM; N = DM; } while (0)
#define SET_QKV(l_) do { src = args.in[8] + (size_t)(l_) * DM * 6144; gain = args.in[4] + (l_) * DM; dst = WQKV(l_); K = DM; sN = 6144; N = 6144; } while (0)
#define SET_O(l_) do { src = (l_) < 2 ? args.in[9] + (size_t)(l_) * DM * DM : args.in[17] + (size_t)((l_) - 2) * DM * DM; dst = WO(l_); K = DM; sN = DM; N = DM; } while (0)
#define SET_DKV() do { src = args.in[11]; gain = args.in[10]; dst = (bf16*)((unsigned char*)WGU(4) + (size_t)2 * FF * DM); K = DM; sN = 576; N = 768; kind = 3; wam = (const unsigned*)(ws + WS_WAMAX) + 4 * 12032 + 2 * FF; } while (0)
#define SET_UKV() do { src = args.in[13]; gain = args.in[12]; dst = WUKV; K = 512; sN = 4096; N = 4096; } while (0)
#define SET_DQ(j_) do { src = args.in[14] + (size_t)(j_) * DM * 768; gain = args.in[4] + (2 + (j_)) * DM; dst = WDQ(j_); K = DM; sN = 768; N = 768; } while (0)
#define SET_UQ(j_) do { src = args.in[16] + (size_t)(j_) * 768 * 3072; gain = args.in[15] + (j_) * 768; dst = WUQ(j_); K = 768; sN = 3072; N = 3072; kind = 2; } while (0)
    if (i < IT_B2) { const int l = i >= IT_LA ? 1 : 0; i -= l * IT_LA;
        if (i < IT_GU) SET_GU(2 * l); else if ((i -= IT_GU) < IT_D) SET_D(2 * l); else if ((i -= IT_D) < IT_QKV) SET_QKV(l); else if ((i -= IT_QKV) < IT_O) SET_O(l);
        else if ((i -= IT_O) < IT_GU) SET_GU(2 * l + 1); else { i -= IT_GU; SET_D(2 * l + 1); } }
    else if (i < IT_B3) { i -= IT_B2;
        if (i < IT_GU) SET_GU(4); else if ((i -= IT_GU) < IT_DKV) SET_DKV(); else if ((i -= IT_DKV) < IT_D) SET_D(4); else if ((i -= IT_D) < IT_UKV) SET_UKV(); else if ((i -= IT_UKV) < IT_DQ) SET_DQ(0);
        else if ((i -= IT_DQ) < IT_UQ) SET_UQ(0); else if ((i -= IT_UQ) < IT_O) SET_O(2); else if ((i -= IT_O) < IT_GU) SET_GU(5); else { i -= IT_GU; SET_D(5); } }
    else { i -= IT_B3;
        if (i < IT_GU) SET_GU(6); else if ((i -= IT_GU) < IT_D) SET_D(6); else if ((i -= IT_D) < IT_DQ) SET_DQ(1); else if ((i -= IT_DQ) < IT_UQ) SET_UQ(1); else if ((i -= IT_UQ) < IT_O) SET_O(3);
        else if ((i -= IT_O) < IT_GU) SET_GU(7); else { i -= IT_GU; SET_D(7); } }
#undef SET_GU
#undef SET_D
#undef SET_QKV
#undef SET_O
#undef SET_DKV
#undef SET_UKV
#undef SET_DQ
#undef SET_UQ
    conv_tile(src, K, sN, N, gain, dst, kind, wl, lane, i, wam);
}
__global__ void __launch_bounds__(NWAVES * 64, 2) yoco_fwd(Args args) {
    extern __shared__ __attribute__((aligned(16))) unsigned char lds[];
    LAS unsigned char* ldsl = (LAS unsigned char*)lds;
    const int tid = threadIdx.x, lane = tid & 63, wave = __builtin_amdgcn_readfirstlane(tid >> 6), G = gridDim.x;
    unsigned char* ws = args.ws;
    gu32* ctl = (gu32*)(ws + WS_CTL);
    for (int u = tid; u < (LDS_BYTES - LDSCTL_OFF) / 4; u += NWAVES * 64) ((LAS unsigned*)(ldsl + LDSCTL_OFF))[u] = 0u;
    __syncthreads();
    XcdBarrier bar = xcd_barrier_post((unsigned*)(ctl + CW_BAR), (volatile LAS unsigned*)(ldsl + MISC_OFF) + 8);
    const int lo = args.ph_lo, hi = args.ph_hi; int seq = 0;
#define PH_RUN (seq >= lo && seq < hi)
#define PH_END do { if (seq >= lo && seq + 1 < hi) { xcd_barrier(bar); if (PROBE_REP == 8) xcd_barrier(bar); } ++seq; } while (0)
#define STRIP_DRAIN(R_, SOFT_) do { const int RS__ = (R_), RSOFT__ = (SOFT_); gu32* sc_ = ctl + CW_STRIP; volatile LAS int* sidx_ = (volatile LAS int*)(ldsl + RSTD_OFF + 512); int tq_ = threadIdx.x; asm volatile("" : "+v"(tq_)); \
        for (int nth_ = 0;; ++nth_) { const int lim_ = nth_ == 0 ? RSOFT__ : RS__;     \
            if (tq_ == 0) { int v_ = 1 << 30; if ((int)__hip_atomic_load(sc_, RLX_AGENT) < lim_) v_ = (int)__hip_atomic_fetch_add(sc_, 1u, RLX_AGENT); *sidx_ = v_; } __syncthreads(); const int si_ = *sidx_; __syncthreads(); \
            if (si_ < ST_TOTAL) { unsigned* wab_ = (unsigned*)(ws + WS_WAMAX); LAS unsigned char* tl2_ = ldsl + RING_OFF; LAS unsigned* mx_ = (LAS unsigned*)(ldsl + RSTD_OFF); \
                if ((si_ >= SB_QKV0 && si_ < SB_GU1) || (si_ >= SB_QKV1 && si_ < SB_GU3)) { const int l_ = si_ >= SB_QKV1 ? 1 : 0, ls_ = si_ - (l_ ? SB_QKV1 : SB_QKV0); \
                    conv_strip(args.in[8] + (size_t)l_ * DM * 6144, 6144, args.in[4] + l_ * DM, 0, (signed char*)WQKV(l_), wab_ + WAMAX_QKV + l_ * 6144, ls_, tl2_, mx_, tq_); } \
                else if (si_ >= SB_DKV && si_ < SB_GU5) { conv_strip(args.in[11], 576, args.in[10], 3, (signed char*)WGU(4) + (size_t)2 * FF * DM, wab_ + 4 * 12032 + 2 * FF, si_ - SB_DKV, tl2_, mx_, tq_); } \
                else { const int f_ = si_ < SB_QKV0 ? 0 : si_ < SB_GU2 ? 1 : si_ < SB_QKV1 ? 2 : si_ < SB_GU4 ? 3 : si_ < SB_DKV ? 4 : si_ < SB_GU6 ? 5 : si_ < SB_GU7 ? 6 : 7; \
                    const int base_ = f_ == 0 ? SB_GU0 : f_ == 1 ? SB_GU1 : f_ == 2 ? SB_GU2 : f_ == 3 ? SB_GU3 : f_ == 4 ? SB_GU4 : f_ == 5 ? SB_GU5 : f_ == 6 ? SB_GU6 : SB_GU7, l_ = f_ >> 1, w_ = f_ & 1; \
                    conv_strip((w_ ? args.in[6] : args.in[2]) + (size_t)l_ * DM * 2 * FF, 2 * FF, (w_ ? args.in[5] : args.in[1]) + l_ * DM, 1, (signed char*)WGU(f_), wab_ + f_ * 12032, si_ - base_, tl2_, mx_, tq_); } } \
            if (si_ + 1 >= RS__) break; } } while (0)
#define CONV_DRAIN(R_) CONV_DRAIN_W(R_, CONV_WAVES)
#define CONV_DRAIN_W(R_, NW_) do { const int R__ = (R_); gu32* cc_ = ctl + CW_CONV; LAS unsigned char* wl_ = ldsl + RING_OFF + wave * 16384; int tl_ = threadIdx.x; asm volatile("" : "+v"(tl_)); const int ln_ = tl_ & 63; \
        if (wave < (NW_) && (int)__builtin_amdgcn_readfirstlane(__hip_atomic_load(cc_, RLX_AGENT)) < R__) { for (;;) { int idx_ = 0; if (ln_ == 0) idx_ = (int)__hip_atomic_fetch_add(cc_, 1u, RLX_AGENT); idx_ = __builtin_amdgcn_readfirstlane(idx_); \
            if (idx_ < IT_TOTAL) conv_item(args, ws, wl_, ln_, idx_); if (idx_ + 1 >= R__) break; } } } while (0)
    const float* x = args.in[0]; float* out = args.out;
    float* kmean = (float*)(ws + WS_KMEAN); float* ssq = (float*)(ws + WS_SSQ); float* ssq_cq = (float*)(ws + WS_SSQ_CQ); float* ssq_ckv = (float*)(ws + WS_SSQ_CKV);
    float* cos_t = (float*)(ws + WS_COS); float* sin_t = (float*)(ws + WS_SIN);
    bf16* HB = (bf16*)(ws + WS_HB); bf16* HID = (bf16*)(ws + WS_HID); bf16* QB_ = (bf16*)(ws + WS_Q); bf16* KB_ = (bf16*)(ws + WS_K); bf16* VB_ = (bf16*)(ws + WS_V); bf16* OB = (bf16*)(ws + WS_O);
    bf16* QR = (bf16*)(ws + WS_QR); bf16* KR = (bf16*)(ws + WS_KR); bf16* CKV = (bf16*)(ws + WS_CKV); bf16* CQ = (bf16*)(ws + WS_CQ);
    const int gw = (int)blockIdx.x * NWAVES + wave, NGW = G * NWAVES;

    if (PH_RUN) REPS(1) {
        STRIP_DRAIN(SB_QKV0, req_strip_after_up(0));
        for (int m = gw; m < SEQ; m += NGW) {
            const GAS f32x4* xr = (const GAS f32x4*)(x + (size_t)m * DM) + lane; GAS unsigned long long* o8 = (GAS unsigned long long*)(HB + (size_t)m * DM) + lane; float s = 0.f, mxa = 0.f; unsigned long long hb[8];
#pragma unroll
            for (int j = 0; j < 8; ++j) { const f32x4 v = __builtin_nontemporal_load(xr + 64 * j); s += (v.x * v.x + v.y * v.y) + (v.z * v.z + v.w * v.w); const unsigned p0_ = pk2(v.x, v.y), p1_ = pk2(v.z, v.w); hb[j] = (unsigned long long)p0_ | ((unsigned long long)p1_ << 32); o8[64 * j] = hb[j];
                mxa = fmaxf(fmaxf(mxa, fmaxf(fabsf(__uint_as_float(p0_ << 16)), fabsf(__uint_as_float(p0_ & 0xffff0000u)))), fmaxf(fabsf(__uint_as_float(p1_ << 16)), fabsf(__uint_as_float(p1_ & 0xffff0000u)))); }
            s = wave_sum(s); if (lane < 32) ssq[(size_t)m * 32 + lane] = lane == 0 ? s : 0.f;
#pragma unroll
            for (int o = 1; o < 64; o <<= 1) mxa = fmaxf(mxa, __shfl_xor(mxa, o));
            const float qs = mxa > 0.f ? 127.0f / mxa : 0.f; if (lane == 0) ((float*)(ws + WS_ASC))[m] = mxa * (1.0f / 127.0f);
            GAS unsigned* q4 = (GAS unsigned*)((signed char*)(ws + WS_AQ) + (size_t)m * DM) + lane;
#pragma unroll
            for (int j = 0; j < 8; ++j) { const unsigned p0_ = (unsigned)hb[j], p1_ = (unsigned)(hb[j] >> 32);
                const int a0 = (int)__builtin_rintf(__uint_as_float(p0_ << 16) * qs), a1 = (int)__builtin_rintf(__uint_as_float(p0_ & 0xffff0000u) * qs), a2 = (int)__builtin_rintf(__uint_as_float(p1_ << 16) * qs), a3 = (int)__builtin_rintf(__uint_as_float(p1_ & 0xffff0000u) * qs);
                q4[64 * j] = ((unsigned)a0 & 0xffu) | (((unsigned)a1 & 0xffu) << 8) | (((unsigned)a2 & 0xffu) << 16) | (((unsigned)a3 & 0xffu) << 24); } }
        for (int idx = (int)blockIdx.x * 512 + tid; idx < SEQ * 32; idx += G * 512) {
            const int pos = idx >> 5, i = idx & 31;
            const float pw = (float)exp2((double)(2 * i) * (13.287712379549449 / 64.0)), inv = 1.0f / pw, ang = (float)pos * inv;
            const double a = (double)ang, q = rint(a * 0.6366197723675814), r = (a - q * 1.5707963267948966) - q * 6.123233995736766e-17, r2 = r * r;
            const double sn = r + r * r2 * (-1.0 / 6 + r2 * (1.0 / 120 + r2 * (-1.0 / 5040 + r2 * (1.0 / 362880 + r2 * (-1.0 / 39916800)))));
            const double cs = 1.0 + r2 * (-0.5 + r2 * (1.0 / 24 + r2 * (-1.0 / 720 + r2 * (1.0 / 40320 + r2 * (-1.0 / 3628800 + r2 * (1.0 / 479001600))))));
            const int qi = (int)q & 3; const double c_ = qi == 0 ? cs : qi == 1 ? -sn : qi == 2 ? -cs : sn, s_ = qi == 0 ? sn : qi == 1 ? cs : qi == 2 ? -sn : -cs;
            cos_t[idx] = (float)c_; sin_t[idx] = (float)s_; }
    }
    PH_END;
    signed char* AQ = (signed char*)(ws + WS_AQ); float* asc = (float*)(ws + WS_ASC);
    const bool fuseq = FUSED_QUANT && G == 256; unsigned qk = 0u;

    for (int f = 0; f < 8; ++f) {
        const int l = f >> 1;
        if (f > 0 && !fuseq) { if (PH_RUN) { int t4 = threadIdx.x; asm volatile("" : "+v"(t4)); quant_rows(HB, AQ, asc, gw, NGW, t4 & 63); } PH_END; }
        if (PH_RUN) REPS(4) {
            pg8::Gemm g{(const pg8::bf16_t*)AQ, (const pg8::bf16_t*)WGU(f), SEQ, f == 4 ? 2 * FF + 768 : 2 * FF, DM / 2}; pg8::StaticOrder S; S.init(SEQ, g.N, G, (int)blockIdx.x);
            LAS float* rtab = (LAS float*)(ldsl + RSTD_OFF); LAS float* wtab = (LAS float*)(ldsl + WTAB_OFF); int pn0 = 0;
            { pg8::Unit u0; if (S.next(0, u0)) { int t3 = threadIdx.x; asm volatile("" : "+v"(t3)); pn0 = u0.pn; const unsigned* wam_ = (const unsigned*)(ws + WS_WAMAX) + f * 12032;
#pragma unroll
                  for (int ui_ = 0; ui_ < 6; ++ui_) { pg8::Unit uu; if (S.next(ui_, uu) && t3 < 256) wtab[((uu.pn - pn0) >> 2) * 256 + t3] = __uint_as_float(wam_[uu.pn * 256 + t3]) * (1.0f / 127.0f); }
                  rstd_table_fill(rtab, ssq, u0.pm & ~7, t3, asc); } }
            pg8::EpiUp E{(pg8::bf16_t*)HID, rtab, 44, (pg8::bf16_t*)CKV, ssq_ckv, (pg8::bf16_t*)KR, cos_t, sin_t, wtab, pn0};
            pg8::gemm_phase<pg8::EpiUp, pg8::StaticOrder, true, true>(ldsl + RING_OFF, g, S, E);
#if PROBE_REP == 6
            { pg8::EpiNull E0; pg8::gemm_phase<pg8::EpiNull, pg8::StaticOrder, true, true>(ldsl + RING_OFF, g, S, E0); }
#endif
            __syncthreads(); if (f < 7) STRIP_DRAIN(req_strip_after_up(f), req_strip_after_up(f + 1 < 7 ? f + 1 : 6)); CONV_DRAIN(f < 7 ? req_gu(f + 1) : IT_TOTAL);
        }
        PH_END;
        if (PH_RUN) {
            pg8::Gemm g{(const pg8::bf16_t*)HID, (const pg8::bf16_t*)WD(f), SEQ, DM, FF}; pg8::StaticOrder S; S.init(SEQ, DM, G, (int)blockIdx.x);
            const bool fq_here = fuseq && ((f & 1) ? f < 7 : l < 2);
            if (fuseq && f == 7) { pg8::EpiResT<1, true> E{ws, (LAS float*)(ldsl + RSTD_OFF), args.out, args.in[18], 8u * (qk + 1u)};
                pg8::gemm_phase<pg8::EpiResT<1, true>, pg8::StaticOrder, true, true>(ldsl + RING_OFF, g, S, E); }
            else { pg8::EpiResT<1> E{ws, (LAS float*)(ldsl + RSTD_OFF), nullptr, nullptr, fq_here ? 8u * (qk + 1u) : 0u};
            pg8::gemm_phase<pg8::EpiResT<1>, pg8::StaticOrder, true, true>(ldsl + RING_OFF, g, S, E); }
        }
        PH_END;
        if (fuseq && ((f & 1) ? true : l < 2)) ++qk;
        if (f & 1) continue;
        if (l < 2) {
            if (!fuseq) { if (PH_RUN) { int t4 = threadIdx.x; asm volatile("" : "+v"(t4)); quant_rows(HB, AQ, asc, gw, NGW, t4 & 63); }
            PH_END; }
            if (PH_RUN) {
                pg8::Gemm g{(const pg8::bf16_t*)AQ, (const pg8::bf16_t*)WQKV(l), SEQ, 6144, DM / 2}; pg8::StaticOrder S; S.init(SEQ, 6144, G, (int)blockIdx.x);
                LAS float* rtab = (LAS float*)(ldsl + RSTD_OFF); LAS float* wtab = (LAS float*)(ldsl + WTAB_OFF); int pn0 = 0;
                { pg8::Unit u0; if (S.next(0, u0)) { int t3 = threadIdx.x; asm volatile("" : "+v"(t3)); pn0 = u0.pn; const unsigned* wam_ = (const unsigned*)(ws + WS_WAMAX) + WAMAX_QKV + l * 6144;
                      for (int ui_ = 0; ui_ < 3; ++ui_) { pg8::Unit uu; if (S.next(ui_, uu) && t3 < 256) wtab[((uu.pn - pn0) >> 2) * 256 + t3] = __uint_as_float(wam_[uu.pn * 256 + t3]) * (1.0f / 127.0f); }
                      rstd_table_fill(rtab, ssq, u0.pm & ~7, t3, asc); } }
                pg8::EpiQKV E{(pg8::bf16_t*)QB_, (size_t)(WS_K - WS_Q) / 2, rtab, kmean + (size_t)l * 32 * DM, wtab, pn0};
                pg8::gemm_phase<pg8::EpiQKV, pg8::StaticOrder, true, true>(ldsl + RING_OFF, g, S, E);
            }
            PH_END;
#if MOBA_GATHER
            const att::MobaBufs MB{(unsigned*)(ws + WS_MCNT) + l * 512, (unsigned short*)(ws + WS_LIST), (att::bf16*)(ws + WS_PO), (float*)(ws + WS_PML)};
            if (PH_RUN) att::moba_gate_phase((char*)lds + RING_OFF, (const att::bf16*)QB_, kmean + (size_t)l * 32 * DM, MB);
            PH_END;
            if (PH_RUN) REPS(10) att::moba_sel_phase((char*)lds + RING_OFF, (const att::bf16*)QB_, (const att::bf16*)KB_, (const att::bf16*)VB_, MB);
            PH_END;
            if (PH_RUN) REPS(11) att::moba_own_phase((char*)lds + RING_OFF, (const att::bf16*)QB_, (const att::bf16*)KB_, (const att::bf16*)VB_, (att::bf16*)OB, MB);
            PH_END;
#else
            if (PH_RUN) REPS(2) { const att::Shared GS{(const att::bf16*)KR, kmean + (size_t)l * 32 * DM};
                att::attn_phase<0>((char*)lds + RING_OFF, (const att::bf16*)QB_, (const att::bf16*)QR, (const att::bf16*)KB_, (const att::bf16*)VB_, (att::bf16*)OB, GS); }
            PH_END;
#endif
        } else {
            if (PH_RUN) {
                if (l == 2 && (int)blockIdx.x >= 96 && G == 256) {
                    pg8::Gemm g{(const pg8::bf16_t*)CKV, (const pg8::bf16_t*)WUKV, SEQ, 4096, 512}; pg8::StaticOrder S; S.init(SEQ, 4096, 160, (int)blockIdx.x - 96);
                    pg8::EpiUKV E{(pg8::bf16_t*)KB_, (pg8::bf16_t*)VB_, ssq_ckv};
                    pg8::gemm_phase<pg8::EpiUKV, pg8::StaticOrder, true, true>(ldsl + RING_OFF, g, S, E);
                } else {
                    pg8::Gemm g{(const pg8::bf16_t*)HB, (const pg8::bf16_t*)WDQ(l - 2), SEQ, 768, DM}; pg8::StaticOrder S; S.init(SEQ, 768, G, (int)blockIdx.x);
                    LAS float* rtab = (LAS float*)(ldsl + RSTD_OFF); { pg8::Unit u0; if (S.next(0, u0)) { int t3 = threadIdx.x; asm volatile("" : "+v"(t3)); rstd_table_fill(rtab, ssq, u0.pm & ~7, t3); } }
                    pg8::EpiScaled E{(pg8::bf16_t*)CQ, 768, rtab, ssq_cq};
                    pg8::gemm_phase<pg8::EpiScaled, pg8::StaticOrder, true, true>(ldsl + RING_OFF, g, S, E);
                    { pg8::Unit u1; if (!S.next(0, u1) && l == 3) { __syncthreads(); CONV_DRAIN_W(IT_TOTAL, 2); } }
                    if (l == 2 && G != 256) {
                        pg8::Gemm g2{(const pg8::bf16_t*)CKV, (const pg8::bf16_t*)WUKV, SEQ, 4096, 512}; pg8::StaticOrder S2; S2.init(SEQ, 4096, G, (int)blockIdx.x);
                        pg8::EpiUKV E2{(pg8::bf16_t*)KB_, (pg8::bf16_t*)VB_, ssq_ckv};
                        pg8::gemm_phase<pg8::EpiUKV, pg8::StaticOrder, true, true>(ldsl + RING_OFF, g2, S2, E2); }
                }
            }
            PH_END;
            if (PH_RUN) {
                pg8::Gemm g{(const pg8::bf16_t*)CQ, (const pg8::bf16_t*)WUQ(l - 2), SEQ, 3072, 768}; pg8::StaticOrder S; S.init(SEQ, 3072, G, (int)blockIdx.x);
                pg8::EpiUQ E{(pg8::bf16_t*)QB_, (pg8::bf16_t*)QR, ssq_cq, cos_t, sin_t};
                pg8::gemm_phase<pg8::EpiUQ, pg8::StaticOrder, true, true>(ldsl + RING_OFF, g, S, E);
            }
            PH_END;
            if (PH_RUN) REPS(3) { const att::Shared GS{(const att::bf16*)KR, kmean};
                att::attn_phase<1>((char*)lds + RING_OFF, (const att::bf16*)QB_, (const att::bf16*)QR, (const att::bf16*)KB_, (const att::bf16*)VB_, (att::bf16*)OB, GS); }
            PH_END;
        }
        if (PH_RUN) {
            pg8::Gemm g{(const pg8::bf16_t*)OB, (const pg8::bf16_t*)WO(l), SEQ, DM, DM}; pg8::StaticOrder S; S.init(SEQ, DM, G, (int)blockIdx.x);
            pg8::EpiResT<0> E{ws, (LAS float*)(ldsl + RSTD_OFF), nullptr, nullptr, fuseq ? 8u * (qk + 1u) : 0u};
            pg8::gemm_phase<pg8::EpiResT<0>, pg8::StaticOrder, true, true>(ldsl + RING_OFF, g, S, E);
        }
        PH_END;
        if (fuseq) ++qk;
    }
    if (PH_RUN) {
        const bool bad = xb_ld((unsigned*)(ctl + CW_BAR) + XB_TMO) != 0u; const float poison = bad ? __builtin_nanf("") : 1.0f;
        int t2 = threadIdx.x; asm volatile("" : "+v"(t2)); const int ln = t2 & 63;
        const GAS f32x4* fn = (const GAS f32x4*)args.in[18] + ln;
        int gw2 = gw; asm volatile("" : "+s"(gw2));
        for (int m = gw2; m < SEQ; m += NGW) { const float rs = pg8::row_rstd<8>(ssq, m, 1.0f / 2048.0f) * poison; GAS f32x4* o = (GAS f32x4*)(out + (size_t)m * DM) + ln;
            const GAS unsigned long long* hb8 = (const GAS unsigned long long*)(HB + (size_t)m * DM) + ln;
#pragma unroll
            for (int j = 0; j < 8; ++j) { const unsigned long long hv = hb8[64 * j]; const unsigned lo = (unsigned)hv, hi2 = (unsigned)(hv >> 32); const f32x4 gn = fn[64 * j];
                const f32x4 v = {__uint_as_float(lo << 16), __uint_as_float(lo & 0xffff0000u), __uint_as_float(hi2 << 16), __uint_as_float(hi2 & 0xffff0000u)}; __builtin_nontemporal_store(v * rs * gn, o + 64 * j); } }
    }
#undef PH_RUN
#undef PH_END
}

extern "C" void kernel_launch(void* const* d_in, const int* in_sizes, int n_in, void* d_out, int out_size, void* d_ws, size_t ws_size, hipStream_t stream) {
    static int grid = 0;
    if (grid == 0) {
        if (n_in != 19 || in_sizes[0] != SEQ * DM || out_size != SEQ * DM || ws_size < WS_END2) { fprintf(stderr, "kernel_launch: unexpected shapes (n_in %d, in0 %d, out %d, ws %zu)\n", n_in, n_in > 0 ? in_sizes[0] : -1, out_size, ws_size); grid = -1; return; }
        int dev = 0, cus = 0, per_cu = 0;
        if (hipGetDevice(&dev) != hipSuccess || hipDeviceGetAttribute(&cus, hipDeviceAttributeMultiprocessorCount, dev) != hipSuccess) { grid = -1; return; }
        if (hipFuncSetAttribute((const void*)yoco_fwd, hipFuncAttributeMaxDynamicSharedMemorySize, LDS_BYTES) != hipSuccess) { fprintf(stderr, "kernel_launch: hipFuncSetAttribute failed\n"); grid = -1; return; }
        if (hipOccupancyMaxActiveBlocksPerMultiprocessor(&per_cu, (const void*)yoco_fwd, NWAVES * 64, LDS_BYTES) != hipSuccess || per_cu < 1) { fprintf(stderr, "kernel_launch: occupancy query reports %d workgroups per CU\n", per_cu); per_cu = 1; }
        (void)hipGetLastError();
        grid = cus;
    }
    if (grid < 0) return;
    if (hipMemsetAsync((char*)d_ws + WS_CTL, 0, ZERO_BYTES, stream) != hipSuccess) return;
    Args a{};
    for (int i = 0; i < 19; ++i) a.in[i] = (const float*)d_in[i];
    a.out = (float*)d_out; a.ws = (unsigned char*)d_ws;
#if MK_MULTI
    for (int k = 0; k < NPHASES; ++k) { a.ph_lo = k; a.ph_hi = k + 1; hipLaunchKernelGGL(yoco_fwd, dim3(grid), dim3(NWAVES * 64), LDS_BYTES, stream, a); }
#else
    a.ph_lo = 0; a.ph_hi = (FUSED_QUANT && grid == 256) ? NPHASES - 10 : NPHASES;
    hipLaunchKernelGGL(yoco_fwd, dim3(grid), dim3(NWAVES * 64), LDS_BYTES, stream, a);
#endif
    const hipError_t le = hipPeekAtLastError();
    if (le != hipSuccess) fprintf(stderr, "kernel_launch: launch failed: %s\n", hipGetErrorName(le));
}
```
